# Optimizing an MI355X kernel written in HIP

```python
import jax, jax.numpy as jnp
from jax import lax
import numpy as np

D_MODEL = 1024
BATCH = 32
SEQ = 2048
DEPTH = 4

HEAD_DIM = 64
MIX_W = D_MODEL
A_HEADS = MIX_W // 2 // HEAD_DIM
A_KV_HEADS = A_HEADS // 4
B_HEADS = MIX_W // 2 // HEAD_DIM
C_WIDTH = MIX_W // 2
D_WIDTH = MIX_W // 2
C_CONV = 3
D_CONV = 31
D_FF = 2816
GRID_W = 64
NA_ROWS = 8
NA_COLS = 16
Q_BLOCK = 128
ROPE_THETA = 10000.0
EPS = 1e-6
NEG_INF = -1e30
N_EVEN = (DEPTH + 1) // 2
N_ODD = DEPTH // 2
A_Q = A_HEADS * HEAD_DIM
A_KV = A_KV_HEADS * HEAD_DIM
B_W = B_HEADS * HEAD_DIM
AB_IN = A_Q + 2 * A_KV + 3 * B_W
AB_OUT = A_Q + B_W
CD_IN = 3 * C_WIDTH + 2 * D_WIDTH
CD_OUT = C_WIDTH + D_WIDTH

kernel_name = "hybrid_gqa_natten_shortconv_conformer_encoder"


def rms_norm(x, g):
    xf = x.astype(jnp.float32)
    y = xf * lax.rsqrt(jnp.mean(xf * xf, axis=-1, keepdims=True) + EPS)
    return (y * g.astype(jnp.float32)).astype(x.dtype)


def layer_norm(x, g, b):
    xf = x.astype(jnp.float32)
    mu = jnp.mean(xf, axis=-1, keepdims=True)
    var = jnp.mean(jnp.square(xf - mu), axis=-1, keepdims=True)
    y = (xf - mu) * lax.rsqrt(var + EPS)
    return (y * g.astype(jnp.float32) + b.astype(jnp.float32)).astype(x.dtype)


def swiglu(x, w_gate, w_up, w_down):
    return (jax.nn.silu(x @ w_gate) * (x @ w_up)) @ w_down


def axial_rope(seq):
    t = jnp.arange(seq)
    row = (t // GRID_W).astype(jnp.float32)
    col = (t % GRID_W).astype(jnp.float32)
    half = HEAD_DIM // 2
    freqs = ROPE_THETA ** (-jnp.arange(0, half, 2, dtype=jnp.float32) / half)
    ang = jnp.concatenate([row[:, None] * freqs, col[:, None] * freqs], axis=-1)
    return jnp.cos(ang), jnp.sin(ang)


def apply_rope(x, cos, sin):
    xf = x.astype(jnp.float32).reshape(*x.shape[:-1], x.shape[-1] // 2, 2)
    x0, x1 = xf[..., 0], xf[..., 1]
    c = cos[None, :, None, :]
    s = sin[None, :, None, :]
    out = jnp.stack([x0 * c - x1 * s, x0 * s + x1 * c], axis=-1)
    return out.reshape(x.shape).astype(x.dtype)


def depthwise_conv(u, w):
    k = w.shape[0]
    return lax.conv_general_dilated(
        u, w[:, None, :].astype(u.dtype), window_strides=(1,),
        padding=[(k // 2, k // 2)], dimension_numbers=("NWC", "WIO", "NWC"),
        feature_group_count=u.shape[-1])


def global_gqa(q, k, v):
    b, s, ha, d = q.shape
    kv = k.shape[2]
    g = ha // kv
    nqb = s // Q_BLOCK
    scale = d ** -0.5
    qb = q.reshape(b, nqb, Q_BLOCK, kv, g, d).transpose(1, 0, 2, 3, 4, 5)

    def block(qi):
        sc = jnp.einsum("bqkgd,bskd->bkgqs", qi, k).astype(jnp.float32) * scale
        p = jax.nn.softmax(sc, axis=-1).astype(v.dtype)
        return jnp.einsum("bkgqs,bskd->bqkgd", p, v)

    o = lax.map(block, qb)
    return o.transpose(1, 0, 2, 3, 4, 5).reshape(b, s, ha * d)


def neighborhood_attention(q, k, v, rpb):
    b, s, h, d = q.shape
    rows = s // GRID_W
    wr = min(NA_ROWS, rows)
    wc = NA_COLS
    kw = 2 * wc
    ncb = GRID_W // wc
    scale = d ** -0.5
    qg = q.reshape(b, rows, GRID_W, h, d)
    kg = k.reshape(b, rows, GRID_W, h, d)
    vg = v.reshape(b, rows, GRID_W, h, d)
    qcol = jnp.arange(GRID_W).reshape(ncb, wc)
    kcol = jnp.clip(jnp.arange(ncb) * wc - wc // 2, 0, GRID_W - kw)[:, None] + jnp.arange(kw)
    wcs = jnp.clip(qcol - wc // 2, 0, GRID_W - wc)
    kc = kcol[:, None, :]
    col_mask = (kc >= wcs[..., None]) & (kc < wcs[..., None] + wc)
    col_off = jnp.clip(kc - qcol[..., None], -(NA_COLS - 1), NA_COLS - 1) + NA_COLS - 1
    rpb_f = rpb.astype(jnp.float32)

    def row_block(r):
        rs = jnp.clip(r - wr // 2, 0, rows - wr)
        kb = lax.dynamic_slice_in_dim(kg, rs, wr, axis=1)[:, :, kcol]
        vb = lax.dynamic_slice_in_dim(vg, rs, wr, axis=1)[:, :, kcol]
        qr = lax.dynamic_index_in_dim(qg, r, axis=1, keepdims=False).reshape(b, ncb, wc, h, d)
        sc = jnp.einsum("bnqhd,bwnkhd->bhnqwk", qr, kb).astype(jnp.float32) * scale
        row_off = rs + jnp.arange(wr) - r + NA_ROWS - 1
        bias = rpb_f[:, row_off[None, None, :, None], col_off[:, :, None, :]]
        sc = jnp.where(col_mask[:, :, None, :], sc + bias, NEG_INF)
        p = jax.nn.softmax(sc.reshape(b, h, ncb, wc, wr * kw), axis=-1)
        p = p.reshape(sc.shape).astype(v.dtype)
        return jnp.einsum("bhnqwk,bwnkhd->bnqhd", p, vb).reshape(b, GRID_W, h, d)

    o = lax.map(row_block, jnp.arange(rows))
    return o.transpose(1, 0, 2, 3, 4).reshape(b, s, h * d)


def mixer_ab(hx, w_in, w_out, q_norm, k_norm, rpb, cos, sin):
    b, s, _ = hx.shape
    u = hx @ w_in
    aq, ak, av, bq, bk, bv = jnp.split(
        u, [A_Q, A_Q + A_KV, A_Q + 2 * A_KV, A_Q + 2 * A_KV + B_W, A_Q + 2 * A_KV + 2 * B_W], axis=-1)
    aq = apply_rope(rms_norm(aq.reshape(b, s, A_HEADS, HEAD_DIM), q_norm), cos, sin)
    ak = apply_rope(rms_norm(ak.reshape(b, s, A_KV_HEADS, HEAD_DIM), k_norm), cos, sin)
    ya = global_gqa(aq, ak, av.reshape(b, s, A_KV_HEADS, HEAD_DIM))
    yb = neighborhood_attention(bq.reshape(b, s, B_HEADS, HEAD_DIM),
                                bk.reshape(b, s, B_HEADS, HEAD_DIM),
                                bv.reshape(b, s, B_HEADS, HEAD_DIM), rpb)
    return jnp.concatenate([ya, yb], axis=-1) @ w_out


def mixer_cd(hx, w_in, w_out, c_conv_w, d_conv_w, d_norm_g, d_norm_b):
    u = hx @ w_in
    c_h, c_b, c_c, d_a, d_g = jnp.split(
        u, [C_WIDTH, 2 * C_WIDTH, 3 * C_WIDTH, 3 * C_WIDTH + D_WIDTH], axis=-1)
    yc = c_b * depthwise_conv(c_c * c_h, c_conv_w)
    yd = depthwise_conv(d_a * jax.nn.sigmoid(d_g), d_conv_w)
    yd = jax.nn.silu(layer_norm(yd, d_norm_g, d_norm_b))
    return jnp.concatenate([yc, yd], axis=-1) @ w_out


def setup_inputs(seed: int = 0) -> dict:
    key = jax.random.key(seed)
    ks = jax.random.split(key, 20)
    f32 = jnp.float32

    def nrm(k, shape, fan_in):
        return jax.random.normal(k, shape, f32) * (fan_in ** -0.5)

    def gain(k, shape):
        return 1.0 + 0.02 * jax.random.normal(k, shape, f32)

    return {
        "x": jax.random.normal(ks[0], (BATCH, SEQ, D_MODEL), f32),
        "ffn_norm": gain(ks[1], (DEPTH, 2, D_MODEL)),
        "mix_norm": gain(ks[2], (DEPTH, D_MODEL)),
        "ffn_w_gate": nrm(ks[3], (DEPTH, 2, D_MODEL, D_FF), D_MODEL),
        "ffn_w_up": nrm(ks[4], (DEPTH, 2, D_MODEL, D_FF), D_MODEL),
        "ffn_w_down": nrm(ks[5], (DEPTH, 2, D_FF, D_MODEL), D_FF),
        "ab_w_in": nrm(ks[6], (N_EVEN, D_MODEL, AB_IN), D_MODEL),
        "ab_w_out": nrm(ks[7], (N_EVEN, AB_OUT, D_MODEL), AB_OUT),
        "a_q_norm": gain(ks[8], (N_EVEN, HEAD_DIM)),
        "a_k_norm": gain(ks[9], (N_EVEN, HEAD_DIM)),
        "b_rpb": 0.1 * jax.random.normal(ks[10], (N_EVEN, B_HEADS, 2 * NA_ROWS - 1, 2 * NA_COLS - 1), f32),
        "cd_w_in": nrm(ks[11], (N_ODD, D_MODEL, CD_IN), D_MODEL),
        "cd_w_out": nrm(ks[12], (N_ODD, CD_OUT, D_MODEL), CD_OUT),
        "c_conv_w": nrm(ks[13], (N_ODD, C_CONV, C_WIDTH), C_CONV),
        "d_conv_w": nrm(ks[14], (N_ODD, D_CONV, D_WIDTH), D_CONV),
        "d_norm_g": gain(ks[15], (N_ODD, D_WIDTH)),
        "d_norm_b": 0.02 * jax.random.normal(ks[16], (N_ODD, D_WIDTH), f32),
        "final_norm": gain(ks[17], (D_MODEL,)),
    }


def reference(x, ffn_norm, mix_norm, ffn_w_gate, ffn_w_up, ffn_w_down, ab_w_in, ab_w_out,
              a_q_norm, a_k_norm, b_rpb, cd_w_in, cd_w_out, c_conv_w, d_conv_w,
              d_norm_g, d_norm_b, final_norm):
    cos, sin = axial_rope(x.shape[1])
    for i in range(DEPTH):
        x = x + 0.5 * swiglu(rms_norm(x, ffn_norm[i, 0]), ffn_w_gate[i, 0], ffn_w_up[i, 0], ffn_w_down[i, 0])
        hx = rms_norm(x, mix_norm[i])
        j = i // 2
        if i % 2 == 0:
            x = x + mixer_ab(hx, ab_w_in[j], ab_w_out[j], a_q_norm[j], a_k_norm[j], b_rpb[j], cos, sin)
        else:
            x = x + mixer_cd(hx, cd_w_in[j], cd_w_out[j], c_conv_w[j], d_conv_w[j], d_norm_g[j], d_norm_b[j])
        x = x + 0.5 * swiglu(rms_norm(x, ffn_norm[i, 1]), ffn_w_gate[i, 1], ffn_w_up[i, 1], ffn_w_down[i, 1])
    return rms_norm(x, final_norm)
```

```cpp
#include <hip/hip_runtime.h>
#include <hip/hip_cooperative_groups.h>
#include <cstdio>
#include <cstdint>
#include <utility>
namespace cg = cooperative_groups;
#ifndef PG8_WGM
#define PG8_WGM 8
#endif
namespace pg8 {
#define PG8_LAS __attribute__((address_space(3)))
typedef unsigned short bf16_t;
typedef short bf16x8 __attribute__((ext_vector_type(8)));
typedef float f32x4 __attribute__((ext_vector_type(4)));
typedef unsigned u32x4 __attribute__((ext_vector_type(4)));
constexpr int BM = 256, BK = 64, HALF = 128, HTB = HALF * BK * 2  , STAGE_BYTES = 8 * HTB, NXCD = 8, WGM = PG8_WGM;

__host__ __device__ __forceinline__ int lds_byte(int r, int c) { const int st = (r >> 4) * 2 + (c >> 5), rr = r & 15, cc = c & 31, ob = rr * 64 + cc * 2; return st * 1024 + (ob ^ (((ob >> 9) & 1) << 5)); }
__host__ __device__ __forceinline__ void stage_rc(int b, int& R, int& C) { const int st = b / 1024, sb = b % 1024, swz = sb ^ (((sb >> 9) & 1) << 5); R = (st >> 1) * 16 + swz / 64; C = (st & 1) * 32 + (swz % 64) / 2; }
__host__ __device__ __forceinline__ int perm32(int rho) { const int n = rho >> 4, i = rho & 15; return 8 * (i >> 2) + 4 * n + (i & 3); }

struct Unit { int pm, pn; };
struct Gemm { const bf16_t* A; const bf16_t* Bt; int M, N, K; };

struct StaticOrder {
    int nM, nN, nwg, G, c;
    __host__ __device__ void init(int M, int N, int G_, int c_) { nM = M / BM; nN = N / BM; nwg = nM * nN; G = G_; c = c_; }
    __host__ __device__ bool next(int i, Unit& u) const {
        const long L = (long)i * G + c; if (L >= nwg) return false;
        int wgid = (int)L; { const int q = nwg / NXCD, r = nwg % NXCD, xcd = wgid % NXCD, off = wgid / NXCD; wgid = (xcd < r ? xcd * (q + 1) : r * (q + 1) + (xcd - r) * q) + off; }
        const int nig = WGM * nN, gid = wgid / nig, fm = gid * WGM, gsz = (nM - fm) < WGM ? (nM - fm) : WGM;
        u.pm = fm + ((wgid % nig) % gsz); u.pn = (wgid % nig) / gsz; return true;
    }
    __device__ __forceinline__ void a_ready(const Unit&) const {}
    __device__ __forceinline__ void done(const Unit&) const {}
};

__device__ __forceinline__ unsigned cvt_pk_bf16(float lo, float hi) { unsigned r; asm volatile("v_cvt_pk_bf16_f32 %0, %1, %2" : "=v"(r) : "v"(lo), "v"(hi)); return r; }
typedef float f32x2 __attribute__((ext_vector_type(2)));
template <class Epi, class Sched, bool ALIGN_EPI = false, bool SP2 = false>
__device__ __forceinline__ void gemm_phase(PG8_LAS unsigned char* lds, const Gemm g, const Sched& S, const Epi& E, int wave_s) {
    int tid_; asm volatile("v_mbcnt_lo_u32_b32 %0, -1, 0\n\tv_mbcnt_hi_u32_b32 %0, -1, %0" : "=v"(tid_)); tid_ += wave_s * 64;
    const int tid = tid_, wid = __builtin_amdgcn_readfirstlane(tid >> 6), lane = tid & 63, wr = wid >> 2, wc = wid & 3, fr = lane & 15, fq = lane >> 4;
    const int K = g.K, nt = K / BK;
    unsigned voffA[2], voffB[2];
#pragma unroll
    for (int i = 0; i < 2; ++i) { int R, C; stage_rc(tid * 16 + i * 8192, R, C); const int Rb = Epi::PERM ? ((R & ~31) + perm32(R & 31)) : R;
        voffA[i] = (unsigned)(R * K + C) * 2u; voffB[i] = (unsigned)(Rb * K + C) * 2u; }
    const size_t kstep = (size_t)(BK * 2);
    const size_t hstep = (size_t)HALF * K * 2;
    const size_t tstep = 2 * hstep;
    const unsigned ldsw = (unsigned)wid * 1024u;
    const int aoff = lds_byte(wr * 64 + fr, fq * 8), boff = lds_byte(wc * 32 + fr, fq * 8);
#define PG8_SA(b, h) (((b) * 2 + (h)) * HTB)
#define PG8_SB(b, h) ((4 + (b) * 2 + (h)) * HTB)
#define PG8_STAGE(bufoff, gbase, voff) do { _Pragma("unroll") for (int _i = 0; _i < 2; ++_i) \
        __builtin_amdgcn_global_load_lds((const unsigned*)((const char*)(gbase) + (voff)[_i]), (PG8_LAS unsigned*)(lds + (bufoff) + ldsw + _i * 8192), 16, 0, 0); } while (0)
#define PG8_LDA(dst, b, h) do { _Pragma("unroll") for (int m = 0; m < 4; ++m) _Pragma("unroll") for (int k = 0; k < 2; ++k) dst[m][k] = *(const PG8_LAS bf16x8*)(lds + PG8_SA(b, h) + aoff + m * 2048 + k * 1024); } while (0)
#define PG8_LDB(dst, b, h) do { _Pragma("unroll") for (int n = 0; n < 2; ++n) _Pragma("unroll") for (int k = 0; k < 2; ++k) dst[n][k] = *(const PG8_LAS bf16x8*)(lds + PG8_SB(b, h) + boff + n * 2048 + k * 1024); } while (0)
#define PG8_MMA(ai, bj, At, Bt) do { __builtin_amdgcn_s_setprio(1); _Pragma("unroll") for (int m = 0; m < 4; ++m) _Pragma("unroll") for (int n = 0; n < 2; ++n) _Pragma("unroll") for (int k = 0; k < 2; ++k) \
        acc[ai][bj][m][n] = __builtin_amdgcn_mfma_f32_16x16x32_bf16(Bt[n][k], At[m][k], acc[ai][bj][m][n], 0, 0, 0); __builtin_amdgcn_s_setprio(0); } while (0)
#define PG8_WAIT_V(n) asm volatile("s_waitcnt vmcnt(" #n ")" ::: "memory")
#define PG8_WAIT_L(n) asm volatile("s_waitcnt lgkmcnt(" #n ")" ::: "memory")
#define PG8_BAR __builtin_amdgcn_s_barrier()
#define PG8_SCHED __builtin_amdgcn_sched_barrier(0)
    Unit cur, nxt; int ui = 0;
    if (!S.next(0, cur)) return;
    f32x4 acc[2][2][4][2];
#pragma unroll
    for (int a = 0; a < 2; ++a)
#pragma unroll
        for (int b = 0; b < 2; ++b)
#pragma unroll
            for (int m = 0; m < 4; ++m)
#pragma unroll
                for (int n = 0; n < 2; ++n) acc[a][b][m][n] = (f32x4){0.f, 0.f, 0.f, 0.f};
    bf16x8 At[4][2], B0[2][2], B1[2][2];
    const char* cA = (const char*)g.A + (size_t)cur.pm * tstep; const char* cB = (const char*)g.Bt + (size_t)cur.pn * tstep;
    S.a_ready(cur);
    if constexpr (SP2) {
        PG8_STAGE(PG8_SB(0, 0), cB, voffB); PG8_STAGE(PG8_SB(0, 1), cB + hstep, voffB); PG8_STAGE(PG8_SA(0, 0), cA, voffA); PG8_STAGE(PG8_SA(0, 1), cA + hstep, voffA);
        if (wr == 1) PG8_BAR;
        PG8_WAIT_V(2); PG8_BAR;
        PG8_STAGE(PG8_SB(1, 0), cB + kstep, voffB); PG8_STAGE(PG8_SA(1, 0), cA + kstep, voffA); PG8_STAGE(PG8_SB(1, 1), cB + hstep + kstep, voffB);
        PG8_WAIT_V(6); PG8_BAR;
    } else {
        PG8_STAGE(PG8_SB(0, 0), cB, voffB); PG8_STAGE(PG8_SA(0, 0), cA, voffA); PG8_STAGE(PG8_SB(0, 1), cB + hstep, voffB); PG8_STAGE(PG8_SA(0, 1), cA + hstep, voffA);
        if (wr == 1) PG8_BAR;
        PG8_WAIT_V(4); PG8_BAR;
        PG8_STAGE(PG8_SB(1, 0), cB + kstep, voffB); PG8_STAGE(PG8_SA(1, 0), cA + kstep, voffA); PG8_STAGE(PG8_SB(1, 1), cB + hstep + kstep, voffB);
        PG8_WAIT_V(6); PG8_BAR;
    }
    for (;;) {
        const bool has_next = S.next(ui + 1, nxt);
        const char* nA = has_next ? (const char*)g.A + (size_t)nxt.pm * tstep : cA; const char* nB = has_next ? (const char*)g.Bt + (size_t)nxt.pn * tstep : cB;
        for (int t = 0; t < nt; t += 2) {
            const bool last = (t == nt - 2);
            const char* a1 = cA + (size_t)(t + 1) * kstep;
            const char* a2 = last ? nA : cA + (size_t)(t + 2) * kstep; const char* b2 = last ? nB : cB + (size_t)(t + 2) * kstep;
            const char* a3 = a2 + kstep; const char* b3 = b2 + kstep;
            if (last && has_next) S.a_ready(nxt);
            if constexpr (SP2) {
            PG8_LDB(B0, 0, 0); PG8_LDB(B1, 0, 1); PG8_SCHED; PG8_LDA(At, 0, 0); PG8_STAGE(PG8_SA(1, 1), a1 + hstep, voffA);
            PG8_WAIT_V(8); PG8_WAIT_L(0); PG8_BAR; PG8_MMA(0, 0, At, B0); PG8_MMA(0, 1, At, B1); PG8_BAR; PG8_SCHED;
            PG8_LDA(At, 0, 1); PG8_STAGE(PG8_SB(0, 0), b2, voffB); PG8_STAGE(PG8_SB(0, 1), b2 + hstep, voffB); PG8_STAGE(PG8_SA(0, 0), a2, voffA);
            PG8_WAIT_V(8); PG8_WAIT_L(0); PG8_BAR; PG8_MMA(1, 0, At, B0); PG8_MMA(1, 1, At, B1); PG8_BAR; PG8_SCHED;
            PG8_LDB(B0, 1, 0); PG8_LDB(B1, 1, 1); PG8_SCHED; PG8_LDA(At, 1, 0); PG8_STAGE(PG8_SA(0, 1), a2 + hstep, voffA);
            PG8_WAIT_V(8); PG8_WAIT_L(0); PG8_BAR; PG8_MMA(0, 0, At, B0); PG8_MMA(0, 1, At, B1); PG8_BAR; PG8_SCHED;
            PG8_LDA(At, 1, 1); PG8_STAGE(PG8_SB(1, 0), b3, voffB); PG8_STAGE(PG8_SB(1, 1), b3 + hstep, voffB); PG8_STAGE(PG8_SA(1, 0), a3, voffA);
            PG8_WAIT_V(8); PG8_WAIT_L(0); PG8_BAR; PG8_MMA(1, 0, At, B0); PG8_MMA(1, 1, At, B1); PG8_BAR; PG8_SCHED;
            } else {
            PG8_LDB(B0, 0, 0); PG8_SCHED; PG8_LDA(At, 0, 0); PG8_STAGE(PG8_SA(1, 1), a1 + hstep, voffA);
            PG8_WAIT_L(8); PG8_BAR; PG8_WAIT_L(0); PG8_MMA(0, 0, At, B0); PG8_BAR; PG8_SCHED;
            PG8_LDB(B1, 0, 1); PG8_STAGE(PG8_SB(0, 0), b2, voffB);
            PG8_BAR; PG8_WAIT_L(0); PG8_MMA(0, 1, At, B1); PG8_BAR;
            PG8_LDA(At, 0, 1); PG8_STAGE(PG8_SA(0, 0), a2, voffA);
            PG8_BAR; PG8_WAIT_L(0); PG8_MMA(1, 0, At, B0); PG8_BAR; PG8_SCHED;
            PG8_STAGE(PG8_SB(0, 1), b2 + hstep, voffB);
            PG8_WAIT_V(6); PG8_BAR; PG8_MMA(1, 1, At, B1); PG8_BAR;
            PG8_LDB(B0, 1, 0); PG8_SCHED; PG8_LDA(At, 1, 0); PG8_STAGE(PG8_SA(0, 1), a2 + hstep, voffA);
            PG8_WAIT_L(8); PG8_BAR; PG8_WAIT_L(0); PG8_MMA(0, 0, At, B0); PG8_BAR; PG8_SCHED;
            PG8_LDB(B1, 1, 1); PG8_STAGE(PG8_SB(1, 0), b3, voffB);
            PG8_BAR; PG8_WAIT_L(0); PG8_MMA(0, 1, At, B1); PG8_BAR;
            PG8_LDA(At, 1, 1); PG8_STAGE(PG8_SA(1, 0), a3, voffA);
            PG8_BAR; PG8_WAIT_L(0); PG8_MMA(1, 0, At, B0); PG8_BAR; PG8_SCHED;
            PG8_STAGE(PG8_SB(1, 1), b3 + hstep, voffB);
            PG8_WAIT_V(6); PG8_BAR; PG8_MMA(1, 1, At, B1); PG8_BAR;
            }
        }
        if constexpr (ALIGN_EPI) { if (wr == 0) PG8_BAR; }
        if constexpr (!Epi::AFTER_DRAIN) { E(acc, cur, wr, wc, fr, fq); S.done(cur); }
        if (!has_next) break;
#pragma unroll
        for (int a = 0; a < 2; ++a)
#pragma unroll
            for (int b = 0; b < 2; ++b)
#pragma unroll
                for (int m = 0; m < 4; ++m)
#pragma unroll
                    for (int n = 0; n < 2; ++n) acc[a][b][m][n] = (f32x4){0.f, 0.f, 0.f, 0.f};
        cur = nxt; cA = nA; cB = nB; ++ui;
        if constexpr (ALIGN_EPI) { if (wr == 1) PG8_BAR; }
    }
    PG8_WAIT_V(0);
    if constexpr (!ALIGN_EPI) { if (wr == 0) PG8_BAR; }
    PG8_BAR;
    if constexpr (Epi::AFTER_DRAIN) { E.fused(acc, cur, wr, wc, fr, fq, lds, wid, lane); S.done(cur); }
#undef PG8_SA
#undef PG8_SB
#undef PG8_STAGE
#undef PG8_LDA
#undef PG8_LDB
#undef PG8_MMA
#undef PG8_WAIT_V
#undef PG8_WAIT_L
#undef PG8_BAR
#undef PG8_SCHED
}
}

#define LAS __attribute__((address_space(3)))
using pg8::bf16_t; using pg8::bf16x8; using pg8::f32x4; using pg8::u32x4; using pg8::Unit; using pg8::cvt_pk_bf16;
typedef float f32x16 __attribute__((ext_vector_type(16)));
typedef float f32x2 __attribute__((ext_vector_type(2)));
typedef unsigned u32x2 __attribute__((ext_vector_type(2)));

constexpr int NTOK = 65536, DM = 1024, SEQ = 2048, DFF = 2816, NGU = 2 * DFF, ABIN = 2304, CDIN = 2560;
constexpr float EPS = 1e-6f, LOG2E = 1.4426950408889634f;
constexpr size_t MiB = 1u << 20;
constexpr size_t WS_SS = 0;
constexpr size_t WS_ROPE = 7 * MiB;
constexpr size_t WS_BAR = 7 * MiB + 512 * 1024;
constexpr size_t WS_W = 8 * MiB;
constexpr size_t SZ_GU = (size_t)NGU * DM * 2, SZ_DN = (size_t)DM * DFF * 2, SZ_ABIN = (size_t)ABIN * DM * 2, SZ_SQ = (size_t)DM * DM * 2, SZ_CDIN = (size_t)CDIN * DM * 2;
constexpr size_t WS_WGU = WS_W, WS_WDN = WS_WGU + 8 * SZ_GU, WS_WABIN = WS_WDN + 8 * SZ_DN, WS_WABOUT = WS_WABIN + 2 * SZ_ABIN,
                 WS_WCDIN = WS_WABOUT + 2 * SZ_SQ, WS_WCDOUT = WS_WCDIN + 2 * SZ_CDIN, WS_WEND = WS_WCDOUT + 2 * SZ_SQ;
static_assert(WS_WEND <= 176 * MiB, "weights");
constexpr size_t WS_XB = 176 * MiB;
constexpr size_t WS_Y = 304 * MiB;
constexpr size_t WS_ACT = 432 * MiB;
constexpr size_t WS_XLO = 784 * MiB;
constexpr size_t WS_END = 912 * MiB;
constexpr size_t U_QA = 0, U_KA = U_QA + (size_t)NTOK * 512, U_VTA = U_KA + (size_t)NTOK * 128, U_QB = U_VTA + (size_t)NTOK * 128,
                 U_KB = U_QB + (size_t)NTOK * 512, U_VTB = U_KB + (size_t)NTOK * 512;
constexpr size_t U_E = 0, U_P = (size_t)NTOK * 512, U_BC = 2 * (size_t)NTOK * 512;

__device__ __forceinline__ float fast_rcp(float x) { return __builtin_amdgcn_rcpf(x); }
__device__ __forceinline__ float fast_exp2(float x) { return __builtin_amdgcn_exp2f(x); }
#ifdef NO_SS
__device__ __forceinline__ float fast_rsq(float x) { return x > 1e30f ? 0.f : 1.0f; }
#else
__device__ __forceinline__ float fast_rsq(float x) { return __builtin_amdgcn_rsqf(x); }
#endif
typedef unsigned long long ss_t;
constexpr float SS_SCALE = 65536.0f, SS_INV = 1.0f / (65536.0f * 1024.0f);
__device__ __forceinline__ ss_t ss_fix(float q) { return (ss_t)(q * SS_SCALE); }
__device__ __forceinline__ float ss_rstd(ss_t v) { return fast_rsq((float)v * SS_INV + 1e-6f); }
__device__ __forceinline__ float sigmoidf_(float v) { return fast_rcp(1.0f + fast_exp2(-v * LOG2E)); }
__device__ __forceinline__ float siluf_(float v) { return v * sigmoidf_(v); }
__device__ __forceinline__ float bf2f(unsigned short b) { return __uint_as_float(((unsigned)b) << 16); }
__device__ __forceinline__ unsigned short f2bf(float f) { return (unsigned short)(cvt_pk_bf16(f, 0.f) & 0xffffu); }
__device__ __forceinline__ u32x4 pack8(f32x4 a, f32x4 b) { u32x4 w; w.x = cvt_pk_bf16(a[0], a[1]); w.y = cvt_pk_bf16(a[2], a[3]); w.z = cvt_pk_bf16(b[0], b[1]); w.w = cvt_pk_bf16(b[2], b[3]); return w; }

#define EPI_ROW(ai, m) (u.pm * 256 + wr * 64 + fr + (ai) * 128 + (m) * 16)

constexpr int RS_OFF = 131072;
__device__ __forceinline__ void fill_rstd_table(LAS unsigned char* lds, const ss_t* ss, int bx, int wave_s) {
    int tid_; asm volatile("v_mbcnt_lo_u32_b32 %0, -1, 0\n\tv_mbcnt_hi_u32_b32 %0, -1, %0" : "=v"(tid_)); tid_ += wave_s * 64;
    LAS float* tab = (LAS float*)(lds + RS_OFF);
    constexpr int NPAN = 32 / pg8::WGM;
#pragma unroll
    for (int k = 0; k < NPAN / 2; ++k) {
        const int idx = tid_ + 512 * k, j = idx >> 8, rr = idx & 255, pm = pg8::WGM * (NPAN * (bx & 7) + j) + ((bx >> 3) & (pg8::WGM - 1));
        tab[idx] = ss_rstd(ss[pm * 256 + rr]);
    }
    __syncthreads();
}
#define EPI_RS(ai, m) (rs[((u.pm / pg8::WGM) & (32 / pg8::WGM - 1)) * 256 + wr * 64 + fr + (ai) * 128 + (m) * 16])

struct EpiUp {
    static constexpr bool PERM = true, AFTER_DRAIN = false;
    bf16_t* act; const LAS float* rs;
    __device__ __forceinline__ void operator()(const f32x4 (&acc)[2][2][4][2], const Unit& u, int wr, int wc, int fr, int fq) const {
        const unsigned e0 = (unsigned)(u.pm * 256 + wr * 64 + fr) * (unsigned)DFF + (unsigned)(u.pn * 128 + wc * 32 + 8 * fq);
        char* pa = (char*)act;
#pragma unroll
        for (int ai = 0; ai < 2; ++ai)
#pragma unroll
            for (int m = 0; m < 4; ++m) {
                const float r = EPI_RS(ai, m), c1 = -r * LOG2E, r2 = r * r;
                f32x4 h[2];
#pragma unroll
                for (int n = 0; n < 2; ++n) {
                    const f32x4 g = acc[ai][0][m][n], up = acc[ai][1][m][n];
                    const f32x4 ea = g * c1, gu = (g * up) * r2;
                    f32x4 d;
#pragma unroll
                    for (int i = 0; i < 4; ++i) d[i] = fast_exp2(ea[i]);
                    d = d + 1.0f;
#pragma unroll
                    for (int i = 0; i < 4; ++i) d[i] = fast_rcp(d[i]);
                    h[n] = gu * d;
                }
#ifdef ACT_SC1
                { const u32x4 hv = pack8(h[0], h[1]); const char* ap = pa + (size_t)((e0 + (unsigned)((ai * 128 + m * 16) * DFF)) * 2u);
                  asm volatile("global_store_dwordx4 %0, %1, off sc1" :: "v"(ap), "v"(hv) : "memory"); }
#else
                *(u32x4*)(pa + (e0 + (unsigned)((ai * 128 + m * 16) * DFF)) * 2u) = pack8(h[0], h[1]);
#endif
            }
    }
};

__device__ __forceinline__ void unpack8(u32x4 h, u32x4 l, f32x4& a, f32x4& b) {
    a[0] = __uint_as_float(h.x << 16) + __uint_as_float(l.x << 16); a[1] = __uint_as_float(h.x & 0xffff0000u) + __uint_as_float(l.x & 0xffff0000u);
    a[2] = __uint_as_float(h.y << 16) + __uint_as_float(l.y << 16); a[3] = __uint_as_float(h.y & 0xffff0000u) + __uint_as_float(l.y & 0xffff0000u);
    b[0] = __uint_as_float(h.z << 16) + __uint_as_float(l.z << 16); b[1] = __uint_as_float(h.z & 0xffff0000u) + __uint_as_float(l.z & 0xffff0000u);
    b[2] = __uint_as_float(h.w << 16) + __uint_as_float(l.w << 16); b[3] = __uint_as_float(h.w & 0xffff0000u) + __uint_as_float(l.w & 0xffff0000u);
}
__device__ __forceinline__ void split8(f32x4 a, f32x4 b, u32x4& h, u32x4& l) {
    h = pack8(a, b);
    f32x4 ra, rb;
    ra[0] = a[0] - __uint_as_float(h.x << 16); ra[1] = a[1] - __uint_as_float(h.x & 0xffff0000u); ra[2] = a[2] - __uint_as_float(h.y << 16); ra[3] = a[3] - __uint_as_float(h.y & 0xffff0000u);
    rb[0] = b[0] - __uint_as_float(h.z << 16); rb[1] = b[1] - __uint_as_float(h.z & 0xffff0000u); rb[2] = b[2] - __uint_as_float(h.w << 16); rb[3] = b[3] - __uint_as_float(h.w & 0xffff0000u);
    l = pack8(ra, rb);
}
struct EpiRes {
    static constexpr bool PERM = true, AFTER_DRAIN = false;
    bf16_t* xb; ss_t* ss; float alpha;
    __device__ __forceinline__ void operator()(const f32x4 (&acc)[2][2][4][2], const Unit& u, int wr, int wc, int fr, int fq) const {
        const unsigned row0 = (unsigned)(u.pm * 256 + wr * 64 + fr);
        const unsigned e0 = row0 * (unsigned)DM + (unsigned)(u.pn * 256 + wc * 64 + 8 * fq);
        char* ph = (char*)xb;
        u32x4 ch[2], nh[2];
        float qs[8];
#define RES_LOAD(dh, g) do { _Pragma("unroll") for (int bj = 0; bj < 2; ++bj) { const unsigned eo = e0 + (unsigned)((((g) >> 2) * 128 + ((g) & 3) * 16) * DM + bj * 32); \
            dh[bj] = *(const u32x4*)(ph + eo * 2u); } } while (0)
        RES_LOAD(ch, 0);
#pragma unroll
        for (int g = 0; g < 8; ++g) {
            const int ai = g >> 2, m = g & 3;
            if (g < 7) RES_LOAD(nh, g + 1);
            float q = 0.f;
#pragma unroll
            for (int bj = 0; bj < 2; ++bj) {
                const unsigned eo = e0 + (unsigned)((ai * 128 + m * 16) * DM + bj * 32);
                f32x4 x0, x1; unpack8(ch[bj], (u32x4){0u, 0u, 0u, 0u}, x0, x1);
                const f32x4 o0 = x0 + acc[ai][bj][m][0] * alpha, o1 = x1 + acc[ai][bj][m][1] * alpha;
                *(u32x4*)(ph + eo * 2u) = pack8(o0, o1);
                q += (o0[0] * o0[0] + o0[1] * o0[1]) + (o0[2] * o0[2] + o0[3] * o0[3]) + (o1[0] * o1[0] + o1[1] * o1[1]) + (o1[2] * o1[2] + o1[3] * o1[3]);
            }
            q += __shfl_xor(q, 16); q += __shfl_xor(q, 32);
            qs[g] = q;
            asm volatile("" ::: "memory");
#pragma unroll
            for (int bj = 0; bj < 2; ++bj) ch[bj] = nh[bj];
        }
#undef RES_LOAD
        if (fq == 0) {
#pragma unroll
            for (int g = 0; g < 8; ++g) atomicAdd((ss_t*)((char*)ss + (row0 + (unsigned)((g >> 2) * 128 + (g & 3) * 16)) * 8u), ss_fix(qs[g]));
        }
    }
};

struct EpiNull {
    static constexpr bool PERM = true, AFTER_DRAIN = false;
    float* sink;
    __device__ __forceinline__ void operator()(const f32x4 (&acc)[2][2][4][2], const Unit& u, int wr, int wc, int fr, int fq) const {
        float t = 0.f;
#pragma unroll
        for (int ai = 0; ai < 2; ++ai)
#pragma unroll
            for (int bj = 0; bj < 2; ++bj)
#pragma unroll
                for (int m = 0; m < 4; ++m)
#pragma unroll
                    for (int n = 0; n < 2; ++n) t += acc[ai][bj][m][n][0] + acc[ai][bj][m][n][1] + acc[ai][bj][m][n][2] + acc[ai][bj][m][n][3];
        if (t == 1.2345e-30f) sink[0] = t;
    }
};

struct EpiAB {
    static constexpr bool PERM = true, AFTER_DRAIN = false;
    const LAS float* rs; const float* qg; const float* kg; const float* rope; bf16_t* ub;
    __device__ __forceinline__ void operator()(const f32x4 (&acc)[2][2][4][2], const Unit& u, int wr, int wc, int fr, int fq) const {
        const int pn = u.pn;
        int kind, head;
        if (pn < 2) { kind = 0; head = 4 * pn + wc; }
        else if (pn == 2) { if (wc < 2) { kind = 1; head = wc; } else { kind = 2; head = wc - 2; } }
        else if (pn < 5) { kind = 3; head = 4 * (pn - 3) + wc; }
        else if (pn < 7) { kind = 4; head = 4 * (pn - 5) + wc; }
        else { kind = 5; head = 4 * (pn - 7) + wc; }
        if (kind <= 1) {
            const float* g = kind == 0 ? qg : kg;
            f32x4 gv[2][2];
#pragma unroll
            for (int bj = 0; bj < 2; ++bj)
#pragma unroll
                for (int n = 0; n < 2; ++n) gv[bj][n] = *(const f32x4*)(g + 32 * bj + 8 * fq + 4 * n);
            const float osc = kind == 0 ? 0.125f * LOG2E : 1.0f;
            bf16_t* dst = ub + (kind == 0 ? U_QA : U_KA);
            const int ldo = kind == 0 ? 512 : 128;
#pragma unroll
            for (int ai = 0; ai < 2; ++ai)
#pragma unroll
                for (int m = 0; m < 4; ++m) {
                    const int row = EPI_ROW(ai, m);
                    const float r = EPI_RS(ai, m);
                    f32x4 v[2][2]; float q = 0.f;
#pragma unroll
                    for (int bj = 0; bj < 2; ++bj)
#pragma unroll
                        for (int n = 0; n < 2; ++n) { v[bj][n] = acc[ai][bj][m][n] * r; const f32x4 t = v[bj][n]; q += (t[0] * t[0] + t[1] * t[1]) + (t[2] * t[2] + t[3] * t[3]); }
                    q += __shfl_xor(q, 16); q += __shfl_xor(q, 32);
                    const float rn = fast_rsq(q * (1.0f / 64.0f) + EPS) * osc;
                    const int pos = row & (SEQ - 1);
#pragma unroll
                    for (int bj = 0; bj < 2; ++bj) {
                        f32x4 o[2];
#pragma unroll
                        for (int n = 0; n < 2; ++n) {
                            const f32x4 t = v[bj][n] * gv[bj][n] * rn;
                            const f32x4 cs = *(const f32x4*)(rope + ((size_t)pos * 32 + 16 * bj + 4 * fq + 2 * n) * 2);
                            o[n][0] = t[0] * cs[0] - t[1] * cs[1]; o[n][1] = t[0] * cs[1] + t[1] * cs[0];
                            o[n][2] = t[2] * cs[2] - t[3] * cs[3]; o[n][3] = t[2] * cs[3] + t[3] * cs[2];
                        }
                        *(u32x4*)(dst + (size_t)row * ldo + head * 64 + 32 * bj + 8 * fq) = pack8(o[0], o[1]);
                    }
                    asm volatile("" ::: "memory");
                }
        } else if (kind == 3 || kind == 4) {
            const float osc = kind == 3 ? 0.125f * LOG2E : 1.0f;
            bf16_t* dst = ub + (kind == 3 ? U_QB : U_KB);
#pragma unroll
            for (int ai = 0; ai < 2; ++ai)
#pragma unroll
                for (int m = 0; m < 4; ++m) {
                    const int row = EPI_ROW(ai, m);
                    const float r = EPI_RS(ai, m) * osc;
#pragma unroll
                    for (int bj = 0; bj < 2; ++bj)
                        *(u32x4*)(dst + (size_t)row * 512 + head * 64 + 32 * bj + 8 * fq) = pack8(acc[ai][bj][m][0] * r, acc[ai][bj][m][1] * r);
                }
        } else {
            const int nh = kind == 2 ? 2 : 8;
            bf16_t* dst = ub + (kind == 2 ? U_VTA : U_VTB);
#pragma unroll
            for (int ai = 0; ai < 2; ++ai)
#pragma unroll
                for (int m = 0; m < 4; ++m) {
                    const int row = EPI_ROW(ai, m);
                    const float r = EPI_RS(ai, m);
                    const int b = row >> 11, pos = row & (SEQ - 1);
                    bf16_t* base = dst + ((size_t)(b * nh + head) * 64) * SEQ + pos;
#pragma unroll
                    for (int bj = 0; bj < 2; ++bj)
#pragma unroll
                        for (int n = 0; n < 2; ++n) {
                            const f32x4 t = acc[ai][bj][m][n] * r;
                            const unsigned w0 = cvt_pk_bf16(t[0], t[1]), w1 = cvt_pk_bf16(t[2], t[3]);
                            const int d = 32 * bj + 8 * fq + 4 * n;
                            base[(size_t)(d + 0) * SEQ] = (bf16_t)(w0 & 0xffffu); base[(size_t)(d + 1) * SEQ] = (bf16_t)(w0 >> 16);
                            base[(size_t)(d + 2) * SEQ] = (bf16_t)(w1 & 0xffffu); base[(size_t)(d + 3) * SEQ] = (bf16_t)(w1 >> 16);
                        }
                }
        }
    }
};

struct EpiCD {
    static constexpr bool PERM = true, AFTER_DRAIN = false;
    const LAS float* rs; bf16_t* ub;
    __device__ __forceinline__ void operator()(const f32x4 (&acc)[2][2][4][2], const Unit& u, int wr, int wc, int fr, int fq) const {
        const int pn = u.pn;
        const unsigned row0 = (unsigned)(u.pm * 256 + wr * 64 + fr);
        if (pn < 8) {
            char* dst = (char*)(ub + (pn < 4 ? U_E : U_P));
            const unsigned e0 = row0 * 512u + (unsigned)((pn & 3) * 128 + wc * 32 + 8 * fq);
            const bool gate = pn < 4;
#pragma unroll
            for (int ai = 0; ai < 2; ++ai)
#pragma unroll
                for (int m = 0; m < 4; ++m) {
                    const float r = EPI_RS(ai, m);
                    f32x4 h[2];
#pragma unroll
                    for (int n = 0; n < 2; ++n) {
                        const f32x4 a = acc[ai][0][m][n] * r, g = acc[ai][1][m][n] * r;
#pragma unroll
                        for (int i = 0; i < 4; ++i) h[n][i] = a[i] * (gate ? sigmoidf_(g[i]) : g[i]);
                    }
                    *(u32x4*)(dst + (e0 + (unsigned)((ai * 128 + m * 16) * 512)) * 2u) = pack8(h[0], h[1]);
                    asm volatile("" ::: "memory");
                }
        } else {
            char* dst = (char*)(ub + U_BC);
            const unsigned e0 = row0 * 512u + (unsigned)((pn - 8) * 256 + wc * 32 + 8 * fq);
#pragma unroll
            for (int ai = 0; ai < 2; ++ai)
#pragma unroll
                for (int m = 0; m < 4; ++m) {
                    const float r = EPI_RS(ai, m);
#pragma unroll
                    for (int bj = 0; bj < 2; ++bj)
                        *(u32x4*)(dst + (e0 + (unsigned)((ai * 128 + m * 16) * 512 + bj * 128)) * 2u) = pack8(acc[ai][bj][m][0] * r, acc[ai][bj][m][1] * r);
                    asm volatile("" ::: "memory");
                }
        }
    }
};

__device__ __forceinline__ float wave_sum(float v) {
#pragma unroll
    for (int o = 1; o < 64; o <<= 1) v += __shfl_xor(v, o);
    return v;
}
__device__ __forceinline__ void transpose_item(const float* src, int ldw, const float* gain, bf16_t* dst, int K, int k0, LAS float* scr, int lane) {
    float tv[32];
#pragma unroll
    for (int i = 0; i < 32; ++i) { const int kk = 2 * i + (lane >> 5); tv[i] = src[(size_t)(k0 + kk) * ldw + (lane & 31)]; }
#pragma unroll
    for (int i = 0; i < 32; ++i) { const int kk = 2 * i + (lane >> 5); float v = tv[i]; if (gain) v *= gain[k0 + kk]; scr[kk * 33 + (lane & 31)] = v; }
    asm volatile("s_waitcnt lgkmcnt(0)" ::: "memory");
    const int c = lane & 7;
#pragma unroll
    for (int j = 0; j < 4; ++j) { const int n = (lane >> 3) + 8 * j; const LAS float* s = scr + (8 * c) * 33 + n;
        u32x4 o; o.x = cvt_pk_bf16(s[0 * 33], s[1 * 33]); o.y = cvt_pk_bf16(s[2 * 33], s[3 * 33]); o.z = cvt_pk_bf16(s[4 * 33], s[5 * 33]); o.w = cvt_pk_bf16(s[6 * 33], s[7 * 33]);
        *(u32x4*)(dst + (size_t)n * K + k0 + 8 * c) = o; }
    asm volatile("s_waitcnt lgkmcnt(0)" ::: "memory");
}

struct Params {
    const float* in[18];
    float* out; unsigned char* ws;
    int ph_lo, ph_hi;
};
enum { I_X = 0, I_FFN_NORM, I_MIX_NORM, I_WG, I_WU, I_WD, I_ABIN, I_ABOUT, I_QN, I_KN, I_RPB, I_CDIN, I_CDOUT, I_CCW, I_DCW, I_DNG, I_DNB, I_FINAL };

#define RESCOL(nb) (256 * ((nb) >> 3) + 64 * ((nb) & 3) + 32 * (((nb) >> 2) & 1))
__device__ __forceinline__ void prologue_phase(const Params& p, LAS unsigned char* lds, int vcu, int NGW, int wave_s) {
    int tid_; asm volatile("v_mbcnt_lo_u32_b32 %0, -1, 0\n\tv_mbcnt_hi_u32_b32 %0, -1, %0" : "=v"(tid_)); tid_ += wave_s * 64;
    const int lane = tid_ & 63, wave = __builtin_amdgcn_readfirstlane(tid_ >> 6), gw = vcu * 8 + wave;
    unsigned char* ws = p.ws;
    ss_t* ss = (ss_t*)(ws + WS_SS);
    {
        const float* x = p.in[I_X]; bf16_t* xb = (bf16_t*)(ws + WS_XB);
        for (int row0 = gw; row0 < NTOK; row0 += 2 * NGW) {
            f32x4 v[2][4]; float sq[2];
#pragma unroll
            for (int k = 0; k < 2; ++k) { const f32x4* xr = (const f32x4*)(x + (size_t)(row0 + k * NGW) * DM) + lane;
#pragma unroll
                for (int j = 0; j < 4; ++j) v[k][j] = xr[64 * j]; }
#pragma unroll
            for (int k = 0; k < 2; ++k) {
                const int row = row0 + k * NGW; float s = 0.f;
#pragma unroll
                for (int j = 0; j < 4; ++j) s += (v[k][j][0] * v[k][j][0] + v[k][j][1] * v[k][j][1]) + (v[k][j][2] * v[k][j][2] + v[k][j][3] * v[k][j][3]);
                sq[k] = wave_sum(s);
                u32x2* o = (u32x2*)(xb + (size_t)row * DM) + lane;
#pragma unroll
                for (int j = 0; j < 4; ++j) { u32x2 w; w.x = cvt_pk_bf16(v[k][j][0], v[k][j][1]); w.y = cvt_pk_bf16(v[k][j][2], v[k][j][3]); o[64 * j] = w; }
                if (lane == 0) ss[row] = ss_fix(sq[k]);
                if (lane < 12) ss[(size_t)(lane + 1) * NTOK + row] = 0ull;
            }
        }
    }
    {
        float* rope = (float*)(ws + WS_ROPE);
        for (int idx = gw * 64 + lane; idx < SEQ * 32; idx += NGW * 64) {
            const int pos = idx >> 5, pr = idx & 31, j = pr & 15;
            const float coord = pr < 16 ? (float)(pos >> 6) : (float)(pos & 63);
            const float freq = fast_exp2(-(float)(2 * j) * (1.0f / 32.0f) * 13.287712379549449f);
            const float ang = coord * freq;
            float sn, cs; __sincosf(ang, &sn, &cs);
            rope[2 * idx] = cs; rope[2 * idx + 1] = sn;
        }
    }
    {
        LAS float* scr = (LAS float*)(lds + wave * 16384);
        constexpr int IT_GU = 16 * (NGU / 32), IT_DN = (DFF / 64) * 32, IT_ABIN = 16 * (ABIN / 32), IT_SQ = 16 * 32, IT_CDIN = 16 * (CDIN / 32);
        constexpr int IT_FFN = IT_GU + IT_DN, IT_AB = IT_ABIN + IT_SQ, IT_CD = IT_CDIN + IT_SQ;
        constexpr int NITEMS = 8 * IT_FFN + 2 * IT_AB + 2 * IT_CD;
        for (int it = gw; it < NITEMS; it += NGW) {
            int r = it;
            if (r < 8 * IT_FFN) {
                const int f = r / IT_FFN; r -= f * IT_FFN;
                if (r < IT_GU) {
                    const int nb = r % (NGU / 32), kb = r / (NGU / 32);
                    const int pn = nb >> 3, bj = (nb >> 2) & 1, j0 = 32 * (nb & 3);
                    const float* W = (bj ? p.in[I_WU] : p.in[I_WG]) + (size_t)f * DM * DFF + 128 * pn + j0;
                    transpose_item(W, DFF, p.in[I_FFN_NORM] + f * DM, (bf16_t*)(ws + WS_WGU + f * SZ_GU) + (size_t)(32 * nb) * DM, DM, 64 * kb, scr, lane);
                } else {
                    r -= IT_GU; const int nb = r % 32, kb = r / 32;
                    transpose_item(p.in[I_WD] + (size_t)f * DFF * DM + RESCOL(nb), DM, nullptr, (bf16_t*)(ws + WS_WDN + f * SZ_DN) + (size_t)(32 * nb) * DFF, DFF, 64 * kb, scr, lane);
                }
                continue;
            }
            r -= 8 * IT_FFN;
            if (r < 2 * IT_AB) {
                const int e = r / IT_AB; r -= e * IT_AB;
                if (r < IT_ABIN) {
                    const int nb = r % (ABIN / 32), kb = r / (ABIN / 32);
                    const int pn = nb >> 3, bj = (nb >> 2) & 1, wc = nb & 3;
                    transpose_item(p.in[I_ABIN] + (size_t)e * DM * ABIN + 256 * pn + 64 * wc + 32 * bj, ABIN, p.in[I_MIX_NORM] + (2 * e) * DM,
                                   (bf16_t*)(ws + WS_WABIN + e * SZ_ABIN) + (size_t)(32 * nb) * DM, DM, 64 * kb, scr, lane);
                } else {
                    r -= IT_ABIN; const int nb = r % 32, kb = r / 32;
                    transpose_item(p.in[I_ABOUT] + (size_t)e * DM * DM + RESCOL(nb), DM, nullptr, (bf16_t*)(ws + WS_WABOUT + e * SZ_SQ) + (size_t)(32 * nb) * DM, DM, 64 * kb, scr, lane);
                }
                continue;
            }
            r -= 2 * IT_AB;
            {
                const int e = r / IT_CD; r -= e * IT_CD;
                if (r < IT_CDIN) {
                    const int nb = r % (CDIN / 32), kb = r / (CDIN / 32);
                    const int pn = nb >> 3, bj = (nb >> 2) & 1, j0 = 32 * (nb & 3);
                    int scol;
                    if (pn < 4) scol = (bj ? 2048 : 1536) + 128 * pn + j0;
                    else if (pn < 8) scol = (bj ? 0 : 1024) + 128 * (pn - 4) + j0;
                    else scol = 512 + 256 * (pn - 8) + 128 * bj + j0;
                    transpose_item(p.in[I_CDIN] + (size_t)e * DM * CDIN + scol, CDIN, p.in[I_MIX_NORM] + (2 * e + 1) * DM,
                                   (bf16_t*)(ws + WS_WCDIN + e * SZ_CDIN) + (size_t)(32 * nb) * DM, DM, 64 * kb, scr, lane);
                } else {
                    r -= IT_CDIN; const int nb = r % 32, kb = r / 32;
                    transpose_item(p.in[I_CDOUT] + (size_t)e * DM * DM + RESCOL(nb), DM, nullptr, (bf16_t*)(ws + WS_WCDOUT + e * SZ_SQ) + (size_t)(32 * nb) * DM, DM, 64 * kb, scr, lane);
                }
            }
        }
    }
}

__device__ __forceinline__ void attn_global_phase(LAS unsigned char* lds, const bf16_t* Qa, const bf16_t* Ka, const bf16_t* Vta, const float* qg, const float* kg, bf16_t* y, int vcu, int G, int wave_s) {
    constexpr int PITCH = 144, TILEB = 64 * PITCH, BUFB = 2 * TILEB;
    float negCB;
    {
        int l_; asm volatile("v_mbcnt_lo_u32_b32 %0, -1, 0\n\tv_mbcnt_hi_u32_b32 %0, -1, %0" : "=v"(l_));
        float gq = fabsf(qg[l_]), gk = fabsf(kg[l_]);
#pragma unroll
        for (int o = 1; o < 64; o <<= 1) { gq = fmaxf(gq, __shfl_xor(gq, o)); gk = fmaxf(gk, __shfl_xor(gk, o)); }
        negCB = -(64.0f * 0.125f * LOG2E * 1.01f * gq * gk + 0.125f);
    }
    for (int un = vcu; un < 32 * 8 * 4; un += G) {
        int tid_; asm volatile("v_mbcnt_lo_u32_b32 %0, -1, 0\n\tv_mbcnt_hi_u32_b32 %0, -1, %0" : "=v"(tid_)); tid_ += wave_s * 64;
        const int tid = tid_, lane = tid & 63, wid = __builtin_amdgcn_readfirstlane(tid >> 6), ql = lane & 31, hi = lane >> 5;
        const int srow = tid >> 3, sch = tid & 7;
        const int pik = (ql & 19) | ((ql & 4) << 1) | ((ql & 8) >> 1);
        const int qb = un & 3, h4 = (un >> 2) & 3, kvh = (un >> 4) & 1, b = un >> 5, h = kvh * 4 + h4;
        const int tok0 = b * SEQ + qb * 512 + wid * 64 + ql;
        const bf16_t* qp = Qa + (size_t)tok0 * 512 + h * 64 + hi * 8;
        bf16x8 qf[2][4];
#pragma unroll
        for (int t = 0; t < 2; ++t)
#pragma unroll
            for (int dc = 0; dc < 4; ++dc) qf[t][dc] = *(const bf16x8*)(qp + (size_t)t * 32 * 512 + dc * 16);
        const bf16_t* kg_ = Ka + (size_t)(b * SEQ + srow) * 128 + kvh * 64 + sch * 8;
        const bf16_t* vg_ = Vta + ((size_t)(b * 2 + kvh) * 64 + srow) * SEQ + sch * 8;
        f32x16 o[2][2];
#pragma unroll
        for (int t = 0; t < 2; ++t)
#pragma unroll
            for (int r = 0; r < 16; ++r) { o[t][0][r] = 0.f; o[t][1][r] = 0.f; }
        float lrun[2] = {0.f, 0.f};
        u32x4 kreg = *(const u32x4*)kg_, vreg = *(const u32x4*)vg_;
        __syncthreads();
        *(LAS u32x4*)(lds + srow * PITCH + sch * 16) = kreg; *(LAS u32x4*)(lds + TILEB + srow * PITCH + sch * 16) = vreg;
        __syncthreads();
        for (int kt = 0; kt < SEQ / 64; ++kt) {
            if (kt + 1 < SEQ / 64) { kreg = *(const u32x4*)(kg_ + (size_t)(kt + 1) * 64 * 128); vreg = *(const u32x4*)(vg_ + (kt + 1) * 64); }
            const LAS unsigned char* Kb_ = lds + (kt & 1) * BUFB; const LAS unsigned char* Vb_ = Kb_ + TILEB;
            f32x16 p[2][2];
#pragma unroll
            for (int t = 0; t < 2; ++t)
#pragma unroll
                for (int r = 0; r < 16; ++r) { p[t][0][r] = negCB; p[t][1][r] = negCB; }
#pragma unroll
            for (int dc = 0; dc < 4; ++dc) {
                const bf16x8 a0 = *(const LAS bf16x8*)(Kb_ + pik * PITCH + dc * 32 + hi * 16);
                const bf16x8 a1 = *(const LAS bf16x8*)(Kb_ + (32 + pik) * PITCH + dc * 32 + hi * 16);
#pragma unroll
                for (int t = 0; t < 2; ++t) {
                    p[t][0] = __builtin_amdgcn_mfma_f32_32x32x16_bf16(a0, qf[t][dc], p[t][0], 0, 0, 0);
                    p[t][1] = __builtin_amdgcn_mfma_f32_32x32x16_bf16(a1, qf[t][dc], p[t][1], 0, 0, 0);
                }
            }
            __builtin_amdgcn_sched_barrier(0);
            u32x4 pw[2][2][2];
#pragma unroll
            for (int t = 0; t < 2; ++t) {
                float sum = 0.f;
#pragma unroll
                for (int r = 0; r < 16; ++r) { p[t][0][r] = fast_exp2(p[t][0][r]); p[t][1][r] = fast_exp2(p[t][1][r]); sum += p[t][0][r] + p[t][1][r]; }
                lrun[t] += sum;
#pragma unroll
                for (int kb = 0; kb < 2; ++kb)
#pragma unroll
                    for (int c = 0; c < 2; ++c) {
                        pw[t][kb][c].x = cvt_pk_bf16(p[t][kb][8 * c + 0], p[t][kb][8 * c + 1]); pw[t][kb][c].y = cvt_pk_bf16(p[t][kb][8 * c + 2], p[t][kb][8 * c + 3]);
                        pw[t][kb][c].z = cvt_pk_bf16(p[t][kb][8 * c + 4], p[t][kb][8 * c + 5]); pw[t][kb][c].w = cvt_pk_bf16(p[t][kb][8 * c + 6], p[t][kb][8 * c + 7]);
                    }
            }
            __builtin_amdgcn_sched_barrier(0);
#pragma unroll
            for (int kb = 0; kb < 2; ++kb)
#pragma unroll
                for (int c = 0; c < 2; ++c) {
                    const bf16x8 v0 = *(const LAS bf16x8*)(Vb_ + ql * PITCH + (32 * kb + 16 * c + 8 * hi) * 2);
                    const bf16x8 v1 = *(const LAS bf16x8*)(Vb_ + (32 + ql) * PITCH + (32 * kb + 16 * c + 8 * hi) * 2);
#pragma unroll
                    for (int t = 0; t < 2; ++t) {
                        const bf16x8 pb = __builtin_bit_cast(bf16x8, pw[t][kb][c]);
                        o[t][0] = __builtin_amdgcn_mfma_f32_32x32x16_bf16(v0, pb, o[t][0], 0, 0, 0);
                        o[t][1] = __builtin_amdgcn_mfma_f32_32x32x16_bf16(v1, pb, o[t][1], 0, 0, 0);
                    }
                }
            if (kt + 1 < SEQ / 64) {
                LAS unsigned char* nb = lds + ((kt + 1) & 1) * BUFB;
                *(LAS u32x4*)(nb + srow * PITCH + sch * 16) = kreg; *(LAS u32x4*)(nb + TILEB + srow * PITCH + sch * 16) = vreg;
            }
            __syncthreads();
        }
#pragma unroll
        for (int t = 0; t < 2; ++t) {
            float l = lrun[t]; l += __shfl_xor(l, 32);
            const float inv = fast_rcp(l);
            bf16_t* yp = y + (size_t)(tok0 + 32 * t) * DM + h * 64 + 4 * hi;
#pragma unroll
            for (int g = 0; g < 4; ++g) {
                u32x2 w0, w1;
                w0.x = cvt_pk_bf16(o[t][0][4 * g] * inv, o[t][0][4 * g + 1] * inv); w0.y = cvt_pk_bf16(o[t][0][4 * g + 2] * inv, o[t][0][4 * g + 3] * inv);
                w1.x = cvt_pk_bf16(o[t][1][4 * g] * inv, o[t][1][4 * g + 1] * inv); w1.y = cvt_pk_bf16(o[t][1][4 * g + 2] * inv, o[t][1][4 * g + 3] * inv);
                *(u32x2*)(yp + 8 * g) = w0; *(u32x2*)(yp + 32 + 8 * g) = w1;
            }
        }
    }
}

constexpr int NA_TAB = 0, NA_K = 2048, NA_KP = 144, NA_V = NA_K + 576 * NA_KP, NA_VP = 1168, NA_END = NA_V + 64 * NA_VP;
__device__ __forceinline__ void attn_na_phase(LAS unsigned char* lds, const bf16_t* Qb, const bf16_t* Kb, const bf16_t* Vtb, const float* rpb, bf16_t* y, int vcu, int G, int wave_s) {
    int tid_; asm volatile("v_mbcnt_lo_u32_b32 %0, -1, 0\n\tv_mbcnt_hi_u32_b32 %0, -1, %0" : "=v"(tid_)); tid_ += wave_s * 64;
    const int tid = tid_, lane = tid & 63, wid = __builtin_amdgcn_readfirstlane(tid >> 6), ql = lane & 15, quad = lane >> 4;
    LAS float* tab = (LAS float*)(lds + NA_TAB);
    const int srow = tid >> 3, sch = tid & 7;
    u32x4 kreg[9], vreg[9];
#define NA_FETCH(unx) do { const int rp_ = (unx) & 15, h_ = ((unx) >> 4) & 7, b_ = (unx) >> 7; \
        const int rs0_ = min(max(2 * rp_ - 4, 0), 24), rs1_ = min(max(2 * rp_ - 3, 0), 24), nrows_ = rs1_ + 8 - rs0_; \
        const bf16_t* kg = Kb + (size_t)(b_ * SEQ + rs0_ * 64 + srow) * 512 + h_ * 64 + sch * 8; \
        const bf16_t* vg = Vtb + ((size_t)(b_ * 8 + h_) * 64 + srow) * SEQ + rs0_ * 64 + sch * 8; \
        _Pragma("unroll") for (int i = 0; i < 8; ++i) { kreg[i] = *(const u32x4*)(kg + (size_t)i * 64 * 512); vreg[i] = *(const u32x4*)(vg + i * 64); } \
        if (nrows_ > 8) { kreg[8] = *(const u32x4*)(kg + (size_t)8 * 64 * 512); vreg[8] = *(const u32x4*)(vg + 8 * 64); } \
        else { kreg[8] = (u32x4){0u, 0u, 0u, 0u}; vreg[8] = kreg[8]; } } while (0)
    if (vcu < 32 * 8 * 16) NA_FETCH(vcu);
    for (int un = vcu; un < 32 * 8 * 16; un += G) {
        const int rp = un & 15, h = (un >> 4) & 7, b = un >> 7;
        const int rs0 = min(max(2 * rp - 4, 0), 24);
        const int r = rp * 2 + (wid >> 2), n = wid & 3;
        const int rs = min(max(r - 4, 0), 24), kcol0 = min(max(16 * n - 8, 0), 32), ro = rs - rs0;
        const int qcol = 16 * n + ql, wcs = min(max(qcol - 8, 0), 48);
        const int tokq = b * SEQ + r * 64 + qcol;
        bf16x8 qf[2];
#pragma unroll
        for (int dc = 0; dc < 2; ++dc) qf[dc] = *(const bf16x8*)(Qb + (size_t)tokq * 512 + h * 64 + 32 * dc + 8 * quad);
        __syncthreads();
        for (int i = tid; i < 465; i += 512) tab[i] = rpb[h * 465 + i] * LOG2E;
#pragma unroll
        for (int i = 0; i < 9; ++i) {
            *(LAS u32x4*)(lds + NA_K + (i * 64 + srow) * NA_KP + sch * 16) = kreg[i];
            *(LAS u32x4*)(lds + NA_V + srow * NA_VP + (i * 64 + sch * 8) * 2) = vreg[i];
        }
        __syncthreads();
        if (un + G < 32 * 8 * 16) NA_FETCH(un + G);
        int co[2][4]; bool val[2][4];
#pragma unroll
        for (int ch = 0; ch < 2; ++ch)
#pragma unroll
            for (int i = 0; i < 4; ++i) { const int kc = kcol0 + 16 * ch + 4 * quad + i; val[ch][i] = (kc >= wcs) && (kc < wcs + 16); co[ch][i] = min(max(kc - qcol + 15, 0), 30); }
        const LAS unsigned char* kbase = lds + NA_K + ((ro * 64 + kcol0 + ql) * NA_KP) + quad * 16;
        const LAS unsigned char* vbase = lds + NA_V + ql * NA_VP + (ro * 64 + kcol0 + 4 * quad) * 2;
        f32x4 s[8][2];
        float mx = -1e30f;
#pragma unroll
        for (int w = 0; w < 8; ++w) {
            const int rowoff = (rs + w - r + 7) * 31;
#pragma unroll
            for (int ch = 0; ch < 2; ++ch) {
                const bf16x8 k0 = *(const LAS bf16x8*)(kbase + (w * 64 + 16 * ch) * NA_KP), k1 = *(const LAS bf16x8*)(kbase + (w * 64 + 16 * ch) * NA_KP + 64);
                f32x4 a = {0.f, 0.f, 0.f, 0.f};
                a = __builtin_amdgcn_mfma_f32_16x16x32_bf16(k0, qf[0], a, 0, 0, 0);
                a = __builtin_amdgcn_mfma_f32_16x16x32_bf16(k1, qf[1], a, 0, 0, 0);
#pragma unroll
                for (int i = 0; i < 4; ++i) { const float v = val[ch][i] ? a[i] + tab[rowoff + co[ch][i]] : -1e30f; s[w][ch][i] = v; mx = fmaxf(mx, v); }
            }
        }
        mx = fmaxf(mx, __shfl_xor(mx, 16)); mx = fmaxf(mx, __shfl_xor(mx, 32));
        float l = 0.f;
#pragma unroll
        for (int w = 0; w < 8; ++w)
#pragma unroll
            for (int ch = 0; ch < 2; ++ch)
#pragma unroll
                for (int i = 0; i < 4; ++i) { const float e = fast_exp2(s[w][ch][i] - mx); s[w][ch][i] = e; l += e; }
        l += __shfl_xor(l, 16); l += __shfl_xor(l, 32);
        f32x4 o[4];
#pragma unroll
        for (int dt = 0; dt < 4; ++dt) o[dt] = (f32x4){0.f, 0.f, 0.f, 0.f};
#pragma unroll
        for (int w = 0; w < 8; ++w) {
            const bf16x8 pb = __builtin_bit_cast(bf16x8, pack8(s[w][0], s[w][1]));
#pragma unroll
            for (int dt = 0; dt < 4; ++dt) {
                const u32x2 lo = *(const LAS u32x2*)(vbase + (16 * dt) * NA_VP + w * 128), hi2 = *(const LAS u32x2*)(vbase + (16 * dt) * NA_VP + w * 128 + 32);
                const u32x4 av = {lo.x, lo.y, hi2.x, hi2.y};
                o[dt] = __builtin_amdgcn_mfma_f32_16x16x32_bf16(__builtin_bit_cast(bf16x8, av), pb, o[dt], 0, 0, 0);
            }
        }
        const float inv = fast_rcp(l);
        bf16_t* yp = y + (size_t)tokq * DM + 512 + h * 64 + 4 * quad;
#pragma unroll
        for (int dt = 0; dt < 4; ++dt) { u32x2 w2; w2.x = cvt_pk_bf16(o[dt][0] * inv, o[dt][1] * inv); w2.y = cvt_pk_bf16(o[dt][2] * inv, o[dt][3] * inv); *(u32x2*)(yp + 16 * dt) = w2; }
    }
}

__device__ __forceinline__ float dpp_add(float v, float acc, const int ctrl, const int row_mask) { return acc; }
#define DPP_STEP(v, ctrl, rmask) (v) += __builtin_bit_cast(float, __builtin_amdgcn_update_dpp(0, __builtin_bit_cast(int, (v)), (ctrl), (rmask), 0xf, false))
__device__ __forceinline__ float wave_sum63(float v) {
    DPP_STEP(v, 0xB1, 0xf);
    DPP_STEP(v, 0x4E, 0xf);
    DPP_STEP(v, 0x114, 0xf);
    DPP_STEP(v, 0x118, 0xf);
    DPP_STEP(v, 0x142, 0xa);
    DPP_STEP(v, 0x143, 0xc);
    return v;
}
#undef NA_FETCH
template <int I> __device__ __forceinline__ void conv31_step(f32x2 (&acc)[32], const f32x2 (&wd)[31], const LAS unsigned char* base) {
    const unsigned raw = *(const LAS unsigned*)(base + I * 1024);
    const f32x2 v = {__uint_as_float(raw << 16), __uint_as_float(raw & 0xffff0000u)};
    constexpr int TLO = I - 30 > 0 ? I - 30 : 0, THI = I < 31 ? I : 31;
#pragma unroll
    for (int t = TLO; t <= THI; ++t) acc[t] += v * wd[I - t];
}
template <int... Is> __device__ __forceinline__ void conv31_all(f32x2 (&acc)[32], const f32x2 (&wd)[31], const LAS unsigned char* base, std::integer_sequence<int, Is...>) {
    (conv31_step<Is>(acc, wd, base), ...);
}
__device__ __forceinline__ void cd_core_phase(LAS unsigned char* lds, const bf16_t* E, const bf16_t* P, const bf16_t* Bc, const float* ccw, const float* dcw,
                                              const float* lng, const float* lnb, bf16_t* y, int vcu, int G, int wave_s) {
    constexpr int ROWS = 94, ROWB = 1024, PART_OFF = 96 * ROWB;
    LAS f32x2* part = (LAS f32x2*)(lds + PART_OFF);
    for (int un = vcu; un < NTOK / 64; un += G) {
        int tid_; asm volatile("v_mbcnt_lo_u32_b32 %0, -1, 0\n\tv_mbcnt_hi_u32_b32 %0, -1, %0" : "=v"(tid_)); tid_ += wave_s * 64;
        const int tid = tid_, lane = tid & 63, wid = __builtin_amdgcn_readfirstlane(tid >> 6), cp = tid & 255, th = tid >> 8, c0 = 2 * cp;
        const int t0 = un * 64, p0 = t0 & (SEQ - 1);
        __syncthreads();
        {
            u32x4 ev[12];
#pragma unroll
            for (int j = 0; j < 12; ++j) {
                const int c = tid + 512 * j, i = c >> 6, cc = c & 63, pos = p0 - 15 + i;
                ev[j] = (u32x4){0u, 0u, 0u, 0u};
                if (i < ROWS && pos >= 0 && pos < SEQ) ev[j] = *(const u32x4*)(E + (size_t)(t0 - 15 + i) * 512 + cc * 8);
            }
#pragma unroll
            for (int j = 0; j < 12; ++j) { const int c = tid + 512 * j, i = c >> 6, cc = c & 63; if (i < ROWS) *(LAS u32x4*)(lds + i * ROWB + cc * 16) = ev[j]; }
        }
        __syncthreads();
        f32x2 acc[32];
        {
            f32x2 wd[31];
#pragma unroll
            for (int k = 0; k < 31; ++k) wd[k] = *(const f32x2*)(dcw + k * 512 + c0);
#pragma unroll
            for (int t = 0; t < 32; ++t) acc[t] = (f32x2){0.f, 0.f};
            conv31_all(acc, wd, lds + (32 * th) * ROWB + cp * 4, std::make_integer_sequence<int, 62>{});
        }
        unsigned pr[34], br[32];
#pragma unroll
        for (int t = 0; t < 32; ++t) asm volatile("" : "+v"(acc[t]));
        {
            const int tokb = t0 + 32 * th, posb = p0 + 32 * th;
#pragma unroll
            for (int j = 0; j < 34; ++j) {
                const int pos = posb - 1 + j; const bool ok = (pos >= 0 && pos < SEQ);
                const unsigned v = *(const unsigned*)(P + (size_t)(ok ? tokb - 1 + j : tokb) * 512 + c0);
                pr[j] = ok ? v : 0u;
            }
#pragma unroll
            for (int j = 0; j < 32; ++j) br[j] = *(const unsigned*)(Bc + (size_t)(tokb + j) * 512 + c0);
        }
#ifdef REP_STATS
        for (int rep = 0; rep < REP_STATS; ++rep)
#endif
#pragma unroll
        for (int t = 0; t < 32; ++t) {
            float s1 = acc[t][0] + acc[t][1], s2 = acc[t][0] * acc[t][0] + acc[t][1] * acc[t][1];
            s1 = wave_sum63(s1); s2 = wave_sum63(s2);
            if (lane == 63) part[(32 * th + t) * 4 + (wid & 3)] = (f32x2){s1, s2};
        }
        __syncthreads();
        const f32x2 w0 = *(const f32x2*)(ccw + c0), w1 = *(const f32x2*)(ccw + 512 + c0), w2 = *(const f32x2*)(ccw + 1024 + c0);
        const f32x2 gg = *(const f32x2*)(lng + c0), bb = *(const f32x2*)(lnb + c0);
#pragma unroll
        for (int t = 0; t < 32; ++t) {
            const int tok = t0 + 32 * th + t;
            const f32x2 a = part[(32 * th + t) * 4 + 0], b2 = part[(32 * th + t) * 4 + 1], c2 = part[(32 * th + t) * 4 + 2], d2 = part[(32 * th + t) * 4 + 3];
            const float mean = ((a[0] + b2[0]) + (c2[0] + d2[0])) * (1.0f / 512.0f);
            const float var = ((a[1] + b2[1]) + (c2[1] + d2[1])) * (1.0f / 512.0f) - mean * mean;
            const float rstd = fast_rsq(fmaxf(var, 0.f) + EPS);
            const float z0 = (acc[t][0] - mean) * rstd * gg[0] + bb[0], z1 = (acc[t][1] - mean) * rstd * gg[1] + bb[1];
            *(unsigned*)(y + (size_t)tok * DM + 512 + c0) = cvt_pk_bf16(siluf_(z0), siluf_(z1));
            const unsigned rm = pr[t], rc = pr[t + 1], rp = pr[t + 2], rb = br[t];
            const float y0 = __uint_as_float(rb << 16) * (__uint_as_float(rm << 16) * w0[0] + __uint_as_float(rc << 16) * w1[0] + __uint_as_float(rp << 16) * w2[0]);
            const float y1 = __uint_as_float(rb & 0xffff0000u) * (__uint_as_float(rm & 0xffff0000u) * w0[1] + __uint_as_float(rc & 0xffff0000u) * w1[1] + __uint_as_float(rp & 0xffff0000u) * w2[1]);
            *(unsigned*)(y + (size_t)tok * DM + c0) = cvt_pk_bf16(y0, y1);
        }
    }
}

__device__ __forceinline__ void final_phase(float* out, const bf16_t* xb, const ss_t* ss, const float* g, int vcu, int NGW, int wave_s) {
    int tid_; asm volatile("v_mbcnt_lo_u32_b32 %0, -1, 0\n\tv_mbcnt_hi_u32_b32 %0, -1, %0" : "=v"(tid_)); tid_ += wave_s * 64;
    const int lane = tid_ & 63, gw = vcu * 8 + __builtin_amdgcn_readfirstlane(tid_ >> 6);
    f32x4 gv[2][2];
#pragma unroll
    for (int j = 0; j < 2; ++j) { gv[j][0] = *(const f32x4*)(g + 512 * j + 8 * lane); gv[j][1] = *(const f32x4*)(g + 512 * j + 8 * lane + 4); }
    for (int row0 = gw; row0 < NTOK; row0 += 2 * NGW) {
        u32x4 xv[2][2]; float r[2];
#pragma unroll
        for (int k = 0; k < 2; ++k) { const int row = row0 + k * NGW; r[k] = ss_rstd(ss[row]);
#pragma unroll
            for (int j = 0; j < 2; ++j) xv[k][j] = *(const u32x4*)(xb + (size_t)row * DM + 512 * j + 8 * lane); }
#pragma unroll
        for (int k = 0; k < 2; ++k)
#pragma unroll
            for (int j = 0; j < 2; ++j) {
                const size_t off = (size_t)(row0 + k * NGW) * DM + 512 * j + 8 * lane;
                f32x4 a, b; unpack8(xv[k][j], (u32x4){0u, 0u, 0u, 0u}, a, b);
                *(f32x4*)(out + off) = a * r[k] * gv[j][0]; *(f32x4*)(out + off + 4) = b * r[k] * gv[j][1];
            }
    }
}

#ifndef GEMM_SP2
#define GEMM_SP2 true
#endif
#ifndef RES_SP2
#define RES_SP2 true
#endif
#ifndef RES_ALIGN
#define RES_ALIGN true
#endif
#ifndef REP_UP
#define REP_UP 1
#endif
#ifndef REP_ABIN
#define REP_ABIN 1
#endif
#ifndef REP_CDIN
#define REP_CDIN 1
#endif
#ifndef REP_AG
#define REP_AG 1
#endif
#ifndef REP_NA
#define REP_NA 1
#endif
#ifndef REP_CDC
#define REP_CDC 1
#endif
#ifndef REP_PRO
#define REP_PRO 1
#endif
#define XB_TMO      128
#define XB_XCNT(j)  (256  + 64 * (j))
#define XB_XSUB(j)  (1280 + 64 * (j))
#define XB_XGEN(j)  (2304 + 64 * (j))
#define XB_TOP      3328
#define XB_TOPGEN   3392
#define XCD_BAR_WORDS 3456
#define XB_SPIN_CAP (1u << 18)

__device__ __forceinline__ unsigned xb_ld(unsigned* p)              { return __hip_atomic_load(p, __ATOMIC_RELAXED, __HIP_MEMORY_SCOPE_AGENT); }
__device__ __forceinline__ unsigned xb_add(unsigned* p, unsigned v) { return __hip_atomic_fetch_add(p, v, __ATOMIC_RELAXED, __HIP_MEMORY_SCOPE_AGENT); }
__device__ __forceinline__ unsigned xb_xcc_id() { return (unsigned)__builtin_amdgcn_s_getreg((3 << 11) | 20) & 0xFu; }
#define XB_SPIN(cond, bar) do { unsigned _sp = 0; while (cond) { __builtin_amdgcn_s_sleep(1); \
    if ((++_sp & 255u) == 0u) { if (xb_ld(&(bar)[XB_TMO])) break; if (_sp > XB_SPIN_CAP) { atomicAdd(&(bar)[XB_TMO], 1u); break; } } } } while (0)

struct XcdBarrier {
    unsigned* bar; unsigned x;
    volatile LAS unsigned* st;
};

__device__ __forceinline__ XcdBarrier xcd_barrier_post(unsigned* bar, volatile LAS unsigned* st) {
    XcdBarrier b; b.bar = bar; b.x = xb_xcc_id(); b.st = st;
    if (threadIdx.x == 0) (void)xb_add(&bar[XB_XCNT(b.x)], 1u);
    return b;
}
__device__ __forceinline__ void xcd_barrier_complete(unsigned* bar, unsigned x, unsigned& nloc, unsigned& nx) {
    const unsigned G = gridDim.x * gridDim.y * gridDim.z;
    unsigned sum, cnt, mine, sp = 0u;
    for (;;) {
        sum = 0u; cnt = 0u; mine = 0u;
#pragma unroll
        for (unsigned j = 0; j < 16; ++j) { const unsigned c = xb_ld(&bar[XB_XCNT(j)]); sum += c; cnt += (c > 0u) ? 1u : 0u; mine = (j == x) ? c : mine; }
        if (sum == G) break;
        __builtin_amdgcn_s_sleep(1);
        if ((++sp & 255u) == 0u) { if (xb_ld(&bar[XB_TMO])) break; if (sp > XB_SPIN_CAP) { atomicAdd(&bar[XB_TMO], 1u); break; } }
    }
    nloc = mine > 0u ? mine : 1u; nx = cnt > 0u ? cnt : 1u;
}

__device__ __forceinline__ void xcd_barrier(const XcdBarrier& b) {
    asm volatile("s_waitcnt vmcnt(0)" ::: "memory");
    __syncthreads();
    if (threadIdx.x == 0) {
        unsigned* bar = b.bar;
        __builtin_amdgcn_s_waitcnt(0);
        unsigned nloc = b.st[0], nx = b.st[1];
        if (nloc == 0u) { xcd_barrier_complete(bar, b.x, nloc, nx); b.st[0] = nloc; b.st[1] = nx; }
        const unsigned old = xb_add(&bar[XB_XSUB(b.x)], 1u);
        const unsigned gen = old / nloc;
        if (old + 1u == (gen + 1u) * nloc) {
            __builtin_amdgcn_fence(__ATOMIC_RELEASE, "agent");
            asm volatile("s_waitcnt vmcnt(0)" ::: "memory");
            const unsigned og = xb_add(&bar[XB_TOP], 1u);
            const unsigned tg = og / nx;
            if (og + 1u == (tg + 1u) * nx) xb_add(&bar[XB_TOPGEN], 1u);
            else XB_SPIN(xb_ld(&bar[XB_TOPGEN]) == tg, bar);
            __builtin_amdgcn_fence(__ATOMIC_ACQUIRE, "agent");
            xb_add(&bar[XB_XGEN(b.x)], 1u);
            asm volatile("s_waitcnt vmcnt(0)" ::: "memory");
        } else {
            XB_SPIN(xb_ld(&bar[XB_XGEN(b.x)]) == gen, bar);
            __builtin_amdgcn_fence(__ATOMIC_ACQUIRE, "agent");
            asm volatile("s_waitcnt vmcnt(0)" ::: "memory");
        }
    }
    __syncthreads();
}

constexpr int LDS_BYTES = 163840;
static_assert(NA_END <= LDS_BYTES - 64, "NA tiles vs LDS");
__global__ void __launch_bounds__(512, 2) mega_fwd(Params p) {
    extern __shared__ __attribute__((aligned(16))) unsigned char lds_raw[];
    LAS unsigned char* lds = (LAS unsigned char*)lds_raw;
    cg::grid_group grid = cg::this_grid();
    const int G = gridDim.x, bx = blockIdx.x;
    const int wave_s = __builtin_amdgcn_readfirstlane((int)threadIdx.x >> 6);
    const int vcu = (G % 8 == 0) ? (bx % 8) * (G / 8) + bx / 8 : bx;
    const int NGW = G * 8;
    unsigned char* ws = p.ws;
    ss_t* ss = (ss_t*)(ws + WS_SS);
    bf16_t* xb = (bf16_t*)(ws + WS_XB); bf16_t* yb = (bf16_t*)(ws + WS_Y); bf16_t* act = (bf16_t*)(ws + WS_ACT);
    const float* rope = (const float*)(ws + WS_ROPE);
    volatile LAS unsigned* bst = (volatile LAS unsigned*)(lds + LDS_BYTES - 64);
    if (threadIdx.x < 2) bst[threadIdx.x] = 0u;
    __syncthreads();
    XcdBarrier xbar = xcd_barrier_post((unsigned*)(ws + WS_BAR), bst);
    int ph = 0;
#define PHASE_BEGIN if (ph >= p.ph_lo && ph < p.ph_hi) {
#define PHASE_END   if (ph + 1 < p.ph_hi) { if (ph == 0) { asm volatile("s_waitcnt vmcnt(0)" ::: "memory"); grid.sync(); __builtin_amdgcn_fence(__ATOMIC_ACQUIRE, "agent"); asm volatile("s_waitcnt vmcnt(0)" ::: "memory"); } else xcd_barrier(xbar); } } ++ph;

    PHASE_BEGIN
#ifndef NO_PRO
    for (int rep = 0; rep < REP_PRO; ++rep)
    prologue_phase(p, lds, vcu, NGW, wave_s);
#endif
    PHASE_END

    for (int l = 0; l < 4; ++l) {
        for (int half = 0; half < 2; ++half) {
            const int f = 2 * l + half;
            const ss_t* ssin = ss + (size_t)(3 * l + 2 * half) * NTOK;
            ss_t* ssmid = ss + (size_t)(3 * l + 2 * half + 1) * NTOK;
            PHASE_BEGIN {
                pg8::Gemm g{xb, (const bf16_t*)(ws + WS_WGU + f * SZ_GU), NTOK, NGU, DM}; pg8::StaticOrder S; S.init(NTOK, NGU, G, bx);
                fill_rstd_table(lds, ssin, bx, wave_s);
                EpiUp E{act, (const LAS float*)(lds + RS_OFF)};

#ifndef NO_UP
                for (int rep = 0; rep < REP_UP; ++rep)
                pg8::gemm_phase<EpiUp, pg8::StaticOrder, true, GEMM_SP2>(lds, g, S, E, wave_s);
#endif

            } PHASE_END
            PHASE_BEGIN {
                pg8::Gemm g{act, (const bf16_t*)(ws + WS_WDN + f * SZ_DN), NTOK, DM, DFF}; pg8::StaticOrder S; S.init(NTOK, DM, G, bx);
#ifdef REP_DNULL
                { EpiNull EN{(float*)(ws + WS_ROPE)}; pg8::gemm_phase<EpiNull, pg8::StaticOrder, true, true>(lds, g, S, EN, wave_s); }
#endif
                EpiRes E{xb, ssmid, 0.5f};

#ifndef NO_RES
                pg8::gemm_phase<EpiRes, pg8::StaticOrder, RES_ALIGN, RES_SP2>(lds, g, S, E, wave_s);
#endif

            } PHASE_END
#ifdef SKIP_MIX
            if (false) {
#else
            if (half == 0) {
#endif
                const int e = l >> 1;
                const ss_t* ssmix = ssmid;
                ss_t* ssout = ss + (size_t)(3 * l + 2) * NTOK;
                if ((l & 1) == 0) {
                    PHASE_BEGIN {
                        pg8::Gemm g{xb, (const bf16_t*)(ws + WS_WABIN + e * SZ_ABIN), NTOK, ABIN, DM}; pg8::StaticOrder S; S.init(NTOK, ABIN, G, bx);
                        fill_rstd_table(lds, ssmix, bx, wave_s);
                        EpiAB E{(const LAS float*)(lds + RS_OFF), p.in[I_QN] + e * 64, p.in[I_KN] + e * 64, rope, act};

#ifndef NO_AB
                for (int rep = 0; rep < REP_ABIN; ++rep)
                pg8::gemm_phase<EpiAB, pg8::StaticOrder, true, GEMM_SP2>(lds, g, S, E, wave_s);
#endif

                    } PHASE_END
                    PHASE_BEGIN {

#ifndef NO_AG
                        for (int rep = 0; rep < REP_AG; ++rep)
                        attn_global_phase(lds, act + U_QA, act + U_KA, act + U_VTA, p.in[I_QN] + e * 64, p.in[I_KN] + e * 64, yb, vcu, G, wave_s);
#endif
#ifndef NO_NA
                        for (int rep = 0; rep < REP_NA; ++rep)
                        attn_na_phase(lds, act + U_QB, act + U_KB, act + U_VTB, p.in[I_RPB] + (size_t)e * 8 * 465, yb, vcu, G, wave_s);
#endif

                    } PHASE_END
                } else {
                    PHASE_BEGIN {
                        pg8::Gemm g{xb, (const bf16_t*)(ws + WS_WCDIN + e * SZ_CDIN), NTOK, CDIN, DM}; pg8::StaticOrder S; S.init(NTOK, CDIN, G, bx);
                        fill_rstd_table(lds, ssmix, bx, wave_s);
                        EpiCD E{(const LAS float*)(lds + RS_OFF), act};

#ifndef NO_CDG
                for (int rep = 0; rep < REP_CDIN; ++rep)
                pg8::gemm_phase<EpiCD, pg8::StaticOrder, true, GEMM_SP2>(lds, g, S, E, wave_s);
#endif

                    } PHASE_END
                    PHASE_BEGIN {

#ifndef NO_CD
                        for (int rep = 0; rep < REP_CDC; ++rep)
                        cd_core_phase(lds, act + U_E, act + U_P, act + U_BC, p.in[I_CCW] + (size_t)e * 3 * 512, p.in[I_DCW] + (size_t)e * 31 * 512,
                                      p.in[I_DNG] + e * 512, p.in[I_DNB] + e * 512, yb, vcu, G, wave_s);
#endif

                    } PHASE_END
                }
                PHASE_BEGIN {
                    const size_t woff = (l & 1) ? (WS_WCDOUT + e * SZ_SQ) : (WS_WABOUT + e * SZ_SQ);
                    pg8::Gemm g{yb, (const bf16_t*)(ws + woff), NTOK, DM, DM}; pg8::StaticOrder S; S.init(NTOK, DM, G, bx);
#ifdef REP_OUTFAKE
                    { EpiRes EF{xb, ss + (size_t)13 * NTOK, 1.0f}; pg8::gemm_phase<EpiRes, pg8::StaticOrder, true, true>(lds, g, S, EF, wave_s); }
#endif
                    EpiRes E{xb, ssout, 1.0f};

#ifndef NO_RES
                pg8::gemm_phase<EpiRes, pg8::StaticOrder, RES_ALIGN, RES_SP2>(lds, g, S, E, wave_s);
#endif

                } PHASE_END
            }
        }
    }
#ifdef REP_SYNC
    for (int rep = 0; rep < REP_SYNC; ++rep) xcd_barrier(xbar);
#endif
    PHASE_BEGIN final_phase(p.out, xb, ss + (size_t)12 * NTOK, p.in[I_FINAL], vcu, NGW, wave_s); PHASE_END
#undef PHASE_BEGIN
#undef PHASE_END
}

extern "C" void kernel_launch(void* const* d_in, const int* in_sizes, int n_in, void* d_out, int out_size, void* d_ws, size_t ws_size, hipStream_t stream) {
    static int grid = 0;
    if (grid == 0) {
        if (n_in != 18 || in_sizes[0] != NTOK * DM || out_size != NTOK * DM || ws_size < WS_END) {
            fprintf(stderr, "kernel_launch: unexpected shapes (n_in %d, in0 %d, out %d, ws %zu); nothing launched\n", n_in, n_in > 0 ? in_sizes[0] : -1, out_size, ws_size); grid = -1; return; }
        int dev = 0, cus = 0, per_cu = 0;
        hipGetDevice(&dev);
        hipDeviceGetAttribute(&cus, hipDeviceAttributeMultiprocessorCount, dev);
        hipFuncSetAttribute((const void*)mega_fwd, hipFuncAttributeMaxDynamicSharedMemorySize, LDS_BYTES);
        hipOccupancyMaxActiveBlocksPerMultiprocessor(&per_cu, (const void*)mega_fwd, 512, LDS_BYTES);
        if (per_cu < 1) per_cu = 1;
        grid = cus * (per_cu > 1 ? 1 : per_cu);
        if (grid != 256) { fprintf(stderr, "kernel_launch: built for a 256-CU device (got %d workgroups); nothing launched\n", grid); grid = -1; return; }
        (void)hipGetLastError();
    }
    if (grid < 0) return;
    Params p{};
    for (int i = 0; i < 18; ++i) p.in[i] = (const float*)d_in[i];
    p.out = (float*)d_out; p.ws = (unsigned char*)d_ws; p.ph_lo = 0; p.ph_hi = 1000;
    if (hipMemsetAsync((char*)d_ws + WS_BAR, 0, 16384, stream) != hipSuccess) { fprintf(stderr, "kernel_launch: memset of the barrier words failed\n"); return; }
    void* args[] = {&p};
    hipError_t e = hipLaunchCooperativeKernel((const void*)mega_fwd, dim3(grid), dim3(512), args, LDS_BYTES, stream);
    if (e != hipSuccess) fprintf(stderr, "cooperative launch failed: %s (grid %d)\n", hipGetErrorString(e), grid);
}
```

```cpp
#include <hip/hip_runtime.h>
#include <hip/hip_cooperative_groups.h>
#include <cstdio>
#include <cstdint>
#include <utility>
namespace cg = cooperative_groups;
#ifndef PG8_WGM
#define PG8_WGM 8
#endif
namespace pg8 {
#define PG8_LAS __attribute__((address_space(3)))
typedef unsigned short bf16_t;
typedef short bf16x8 __attribute__((ext_vector_type(8)));
typedef float f32x4 __attribute__((ext_vector_type(4)));
typedef unsigned u32x4 __attribute__((ext_vector_type(4)));
constexpr int BM = 256, BK = 64, HALF = 128, HTB = HALF * BK * 2  , STAGE_BYTES = 8 * HTB, NXCD = 8, WGM = PG8_WGM;

__host__ __device__ __forceinline__ int lds_byte(int r, int c) { const int st = (r >> 4) * 2 + (c >> 5), rr = r & 15, cc = c & 31, ob = rr * 64 + cc * 2; return st * 1024 + (ob ^ (((ob >> 9) & 1) << 5)); }
__host__ __device__ __forceinline__ void stage_rc(int b, int& R, int& C) { const int st = b / 1024, sb = b % 1024, swz = sb ^ (((sb >> 9) & 1) << 5); R = (st >> 1) * 16 + swz / 64; C = (st & 1) * 32 + (swz % 64) / 2; }
__host__ __device__ __forceinline__ int perm32(int rho) { const int n = rho >> 4, i = rho & 15; return 8 * (i >> 2) + 4 * n + (i & 3); }

struct Unit { int pm, pn; };
struct Gemm { const bf16_t* A; const bf16_t* Bt; int M, N, K; };

struct StaticOrder {
    int nM, nN, nwg, G, c;
    __host__ __device__ void init(int M, int N, int G_, int c_) { nM = M / BM; nN = N / BM; nwg = nM * nN; G = G_; c = c_; }
    __host__ __device__ bool next(int i, Unit& u) const {
        const long L = (long)i * G + c; if (L >= nwg) return false;
        int wgid = (int)L; { const int q = nwg / NXCD, r = nwg % NXCD, xcd = wgid % NXCD, off = wgid / NXCD; wgid = (xcd < r ? xcd * (q + 1) : r * (q + 1) + (xcd - r) * q) + off; }
        const int nig = WGM * nN, gid = wgid / nig, fm = gid * WGM, gsz = (nM - fm) < WGM ? (nM - fm) : WGM;
        u.pm = fm + ((wgid % nig) % gsz); u.pn = (wgid % nig) / gsz; return true;
    }
    __device__ __forceinline__ void a_ready(const Unit&) const {}
    __device__ __forceinline__ void done(const Unit&) const {}
};

__device__ __forceinline__ unsigned cvt_pk_bf16(float lo, float hi) { unsigned r; asm volatile("v_cvt_pk_bf16_f32 %0, %1, %2" : "=v"(r) : "v"(lo), "v"(hi)); return r; }
typedef float f32x2 __attribute__((ext_vector_type(2)));
template <class Epi, class Sched, bool ALIGN_EPI = false, bool SP2 = false>
__device__ __forceinline__ void gemm_phase(PG8_LAS unsigned char* lds, const Gemm g, const Sched& S, const Epi& E, int wave_s) {
    int tid_; asm volatile("v_mbcnt_lo_u32_b32 %0, -1, 0\n\tv_mbcnt_hi_u32_b32 %0, -1, %0" : "=v"(tid_)); tid_ += wave_s * 64;
    const int tid = tid_, wid = __builtin_amdgcn_readfirstlane(tid >> 6), lane = tid & 63, wr = wid >> 2, wc = wid & 3, fr = lane & 15, fq = lane >> 4;
    const int K = g.K, nt = K / BK;
    unsigned voffA[2], voffB[2];
#pragma unroll
    for (int i = 0; i < 2; ++i) { int R, C; stage_rc(tid * 16 + i * 8192, R, C); const int Rb = Epi::PERM ? ((R & ~31) + perm32(R & 31)) : R;
        voffA[i] = (unsigned)(R * K + C) * 2u; voffB[i] = (unsigned)(Rb * K + C) * 2u; }
    const size_t kstep = (size_t)(BK * 2);
    const size_t hstep = (size_t)HALF * K * 2;
    const size_t tstep = 2 * hstep;
    const unsigned ldsw = (unsigned)wid * 1024u;
    const int aoff = lds_byte(wr * 64 + fr, fq * 8), boff = lds_byte(wc * 32 + fr, fq * 8);
#define PG8_SA(b, h) (((b) * 2 + (h)) * HTB)
#define PG8_SB(b, h) ((4 + (b) * 2 + (h)) * HTB)
#define PG8_STAGE(bufoff, gbase, voff) do { _Pragma("unroll") for (int _i = 0; _i < 2; ++_i) \
        __builtin_amdgcn_global_load_lds((const unsigned*)((const char*)(gbase) + (voff)[_i]), (PG8_LAS unsigned*)(lds + (bufoff) + ldsw + _i * 8192), 16, 0, 0); } while (0)
#define PG8_LDA(dst, b, h) do { _Pragma("unroll") for (int m = 0; m < 4; ++m) _Pragma("unroll") for (int k = 0; k < 2; ++k) dst[m][k] = *(const PG8_LAS bf16x8*)(lds + PG8_SA(b, h) + aoff + m * 2048 + k * 1024); } while (0)
#define PG8_LDB(dst, b, h) do { _Pragma("unroll") for (int n = 0; n < 2; ++n) _Pragma("unroll") for (int k = 0; k < 2; ++k) dst[n][k] = *(const PG8_LAS bf16x8*)(lds + PG8_SB(b, h) + boff + n * 2048 + k * 1024); } while (0)
#define PG8_MMA(ai, bj, At, Bt) do { __builtin_amdgcn_s_setprio(1); _Pragma("unroll") for (int m = 0; m < 4; ++m) _Pragma("unroll") for (int n = 0; n < 2; ++n) _Pragma("unroll") for (int k = 0; k < 2; ++k) \
        acc[ai][bj][m][n] = __builtin_amdgcn_mfma_f32_16x16x32_bf16(Bt[n][k], At[m][k], acc[ai][bj][m][n], 0, 0, 0); __builtin_amdgcn_s_setprio(0); } while (0)
#define PG8_WAIT_V(n) asm volatile("s_waitcnt vmcnt(" #n ")" ::: "memory")
#define PG8_WAIT_L(n) asm volatile("s_waitcnt lgkmcnt(" #n ")" ::: "memory")
#define PG8_BAR __builtin_amdgcn_s_barrier()
#define PG8_SCHED __builtin_amdgcn_sched_barrier(0)
    Unit cur, nxt; int ui = 0;
    if (!S.next(0, cur)) return;
    f32x4 acc[2][2][4][2];
#pragma unroll
    for (int a = 0; a < 2; ++a)
#pragma unroll
        for (int b = 0; b < 2; ++b)
#pragma unroll
            for (int m = 0; m < 4; ++m)
#pragma unroll
                for (int n = 0; n < 2; ++n) acc[a][b][m][n] = (f32x4){0.f, 0.f, 0.f, 0.f};
    bf16x8 At[4][2], B0[2][2], B1[2][2];
    const char* cA = (const char*)g.A + (size_t)cur.pm * tstep; const char* cB = (const char*)g.Bt + (size_t)cur.pn * tstep;
    S.a_ready(cur);
    if constexpr (SP2) {
        PG8_STAGE(PG8_SB(0, 0), cB, voffB); PG8_STAGE(PG8_SB(0, 1), cB + hstep, voffB); PG8_STAGE(PG8_SA(0, 0), cA, voffA); PG8_STAGE(PG8_SA(0, 1), cA + hstep, voffA);
        if (wr == 1) PG8_BAR;
        PG8_WAIT_V(2); PG8_BAR;
        PG8_STAGE(PG8_SB(1, 0), cB + kstep, voffB); PG8_STAGE(PG8_SA(1, 0), cA + kstep, voffA); PG8_STAGE(PG8_SB(1, 1), cB + hstep + kstep, voffB);
        PG8_WAIT_V(6); PG8_BAR;
    } else {
        PG8_STAGE(PG8_SB(0, 0), cB, voffB); PG8_STAGE(PG8_SA(0, 0), cA, voffA); PG8_STAGE(PG8_SB(0, 1), cB + hstep, voffB); PG8_STAGE(PG8_SA(0, 1), cA + hstep, voffA);
        if (wr == 1) PG8_BAR;
        PG8_WAIT_V(4); PG8_BAR;
        PG8_STAGE(PG8_SB(1, 0), cB + kstep, voffB); PG8_STAGE(PG8_SA(1, 0), cA + kstep, voffA); PG8_STAGE(PG8_SB(1, 1), cB + hstep + kstep, voffB);
        PG8_WAIT_V(6); PG8_BAR;
    }
    for (;;) {
        const bool has_next = S.next(ui + 1, nxt);
        const char* nA = has_next ? (const char*)g.A + (size_t)nxt.pm * tstep : cA; const char* nB = has_next ? (const char*)g.Bt + (size_t)nxt.pn * tstep : cB;
        for (int t = 0; t < nt; t += 2) {
            const bool last = (t == nt - 2);
            const char* a1 = cA + (size_t)(t + 1) * kstep;
            const char* a2 = last ? nA : cA + (size_t)(t + 2) * kstep; const char* b2 = last ? nB : cB + (size_t)(t + 2) * kstep;
            const char* a3 = a2 + kstep; const char* b3 = b2 + kstep;
            if (last && has_next) S.a_ready(nxt);
            if constexpr (SP2) {
            PG8_LDB(B0, 0, 0); PG8_LDB(B1, 0, 1); PG8_SCHED; PG8_LDA(At, 0, 0); PG8_STAGE(PG8_SA(1, 1), a1 + hstep, voffA);
            PG8_WAIT_V(8); PG8_WAIT_L(0); PG8_BAR; PG8_MMA(0, 0, At, B0); PG8_MMA(0, 1, At, B1); PG8_BAR; PG8_SCHED;
            PG8_LDA(At, 0, 1); PG8_STAGE(PG8_SB(0, 0), b2, voffB); PG8_STAGE(PG8_SB(0, 1), b2 + hstep, voffB); PG8_STAGE(PG8_SA(0, 0), a2, voffA);
            PG8_WAIT_V(8); PG8_WAIT_L(0); PG8_BAR; PG8_MMA(1, 0, At, B0); PG8_MMA(1, 1, At, B1); PG8_BAR; PG8_SCHED;
            PG8_LDB(B0, 1, 0); PG8_LDB(B1, 1, 1); PG8_SCHED; PG8_LDA(At, 1, 0); PG8_STAGE(PG8_SA(0, 1), a2 + hstep, voffA);
            PG8_WAIT_V(8); PG8_WAIT_L(0); PG8_BAR; PG8_MMA(0, 0, At, B0); PG8_MMA(0, 1, At, B1); PG8_BAR; PG8_SCHED;
            PG8_LDA(At, 1, 1); PG8_STAGE(PG8_SB(1, 0), b3, voffB); PG8_STAGE(PG8_SB(1, 1), b3 + hstep, voffB); PG8_STAGE(PG8_SA(1, 0), a3, voffA);
            PG8_WAIT_V(8); PG8_WAIT_L(0); PG8_BAR; PG8_MMA(1, 0, At, B0); PG8_MMA(1, 1, At, B1); PG8_BAR; PG8_SCHED;
            } else {
            PG8_LDB(B0, 0, 0); PG8_SCHED; PG8_LDA(At, 0, 0); PG8_STAGE(PG8_SA(1, 1), a1 + hstep, voffA);
            PG8_WAIT_L(8); PG8_BAR; PG8_WAIT_L(0); PG8_MMA(0, 0, At, B0); PG8_BAR; PG8_SCHED;
            PG8_LDB(B1, 0, 1); PG8_STAGE(PG8_SB(0, 0), b2, voffB);
            PG8_BAR; PG8_WAIT_L(0); PG8_MMA(0, 1, At, B1); PG8_BAR;
            PG8_LDA(At, 0, 1); PG8_STAGE(PG8_SA(0, 0), a2, voffA);
            PG8_BAR; PG8_WAIT_L(0); PG8_MMA(1, 0, At, B0); PG8_BAR; PG8_SCHED;
            PG8_STAGE(PG8_SB(0, 1), b2 + hstep, voffB);
            PG8_WAIT_V(6); PG8_BAR; PG8_MMA(1, 1, At, B1); PG8_BAR;
            PG8_LDB(B0, 1, 0); PG8_SCHED; PG8_LDA(At, 1, 0); PG8_STAGE(PG8_SA(0, 1), a2 + hstep, voffA);
            PG8_WAIT_L(8); PG8_BAR; PG8_WAIT_L(0); PG8_MMA(0, 0, At, B0); PG8_BAR; PG8_SCHED;
            PG8_LDB(B1, 1, 1); PG8_STAGE(PG8_SB(1, 0), b3, voffB);
            PG8_BAR; PG8_WAIT_L(0); PG8_MMA(0, 1, At, B1); PG8_BAR;
            PG8_LDA(At, 1, 1); PG8_STAGE(PG8_SA(1, 0), a3, voffA);
            PG8_BAR; PG8_WAIT_L(0); PG8_MMA(1, 0, At, B0); PG8_BAR; PG8_SCHED;
            PG8_STAGE(PG8_SB(1, 1), b3 + hstep, voffB);
            PG8_WAIT_V(6); PG8_BAR; PG8_MMA(1, 1, At, B1); PG8_BAR;
            }
        }
        if constexpr (ALIGN_EPI) { if (wr == 0) PG8_BAR; }
        if constexpr (!Epi::AFTER_DRAIN) { E(acc, cur, wr, wc, fr, fq); S.done(cur); }
        if (!has_next) break;
#pragma unroll
        for (int a = 0; a < 2; ++a)
#pragma unroll
            for (int b = 0; b < 2; ++b)
#pragma unroll
                for (int m = 0; m < 4; ++m)
#pragma unroll
                    for (int n = 0; n < 2; ++n) acc[a][b][m][n] = (f32x4){0.f, 0.f, 0.f, 0.f};
        cur = nxt; cA = nA; cB = nB; ++ui;
        if constexpr (ALIGN_EPI) { if (wr == 1) PG8_BAR; }
    }
    PG8_WAIT_V(0);
    if constexpr (!ALIGN_EPI) { if (wr == 0) PG8_BAR; }
    PG8_BAR;
    if constexpr (Epi::AFTER_DRAIN) { E.fused(acc, cur, wr, wc, fr, fq, lds, wid, lane); S.done(cur); }
#undef PG8_SA
#undef PG8_SB
#undef PG8_STAGE
#undef PG8_LDA
#undef PG8_LDB
#undef PG8_MMA
#undef PG8_WAIT_V
#undef PG8_WAIT_L
#undef PG8_BAR
#undef PG8_SCHED
}
}

struct RevOrder {
    pg8::StaticOrder S; int n;
    __device__ bool next(int i, pg8::Unit& u) const { return i < n && S.next(n - 1 - i, u); }
    __device__ __forceinline__ void a_ready(const pg8::Unit&) const {}
    __device__ __forceinline__ void done(const pg8::Unit&) const {}
};

#define LAS __attribute__((address_space(3)))
using pg8::bf16_t; using pg8::bf16x8; using pg8::f32x4; using pg8::u32x4; using pg8::Unit; using pg8::cvt_pk_bf16;
typedef float f32x16 __attribute__((ext_vector_type(16)));
typedef float f32x2 __attribute__((ext_vector_type(2)));
typedef unsigned u32x2 __attribute__((ext_vector_type(2)));

constexpr int NTOK = 65536, DM = 1024, SEQ = 2048, DFF = 2816, NGU = 2 * DFF, ABIN = 2304, CDIN = 2560;
constexpr float EPS = 1e-6f, LOG2E = 1.4426950408889634f;
constexpr size_t MiB = 1u << 20;
constexpr size_t WS_SS = 0;
constexpr size_t WS_ROPE = 7 * MiB;
constexpr size_t WS_BAR = 7 * MiB + 512 * 1024;
constexpr size_t WS_W = 8 * MiB;
constexpr size_t SZ_GU = (size_t)NGU * DM * 2, SZ_DN = (size_t)DM * DFF * 2, SZ_ABIN = (size_t)ABIN * DM * 2, SZ_SQ = (size_t)DM * DM * 2, SZ_CDIN = (size_t)CDIN * DM * 2;
constexpr size_t WS_WGU = WS_W, WS_WDN = WS_WGU + 8 * SZ_GU, WS_WABIN = WS_WDN + 8 * SZ_DN, WS_WABOUT = WS_WABIN + 2 * SZ_ABIN,
                 WS_WCDIN = WS_WABOUT + 2 * SZ_SQ, WS_WCDOUT = WS_WCDIN + 2 * SZ_CDIN, WS_WEND = WS_WCDOUT + 2 * SZ_SQ;
static_assert(WS_WEND <= 176 * MiB, "weights");
constexpr size_t WS_XB = 176 * MiB;
constexpr size_t WS_Y = 304 * MiB;
constexpr size_t WS_ACT = 432 * MiB;
constexpr size_t WS_XLO = 784 * MiB;
constexpr size_t WS_END = 912 * MiB;
constexpr size_t U_QA = 0, U_KA = U_QA + (size_t)NTOK * 512, U_VTA = U_KA + (size_t)NTOK * 128, U_QB = U_VTA + (size_t)NTOK * 128,
                 U_KB = U_QB + (size_t)NTOK * 512, U_VTB = U_KB + (size_t)NTOK * 512;
constexpr size_t U_E = 0, U_P = (size_t)NTOK * 512, U_BC = 2 * (size_t)NTOK * 512;

__device__ __forceinline__ float fast_rcp(float x) { return __builtin_amdgcn_rcpf(x); }
__device__ __forceinline__ float fast_exp2(float x) { return __builtin_amdgcn_exp2f(x); }
#ifdef NO_SS
__device__ __forceinline__ float fast_rsq(float x) { return x > 1e30f ? 0.f : 1.0f; }
#else
__device__ __forceinline__ float fast_rsq(float x) { return __builtin_amdgcn_rsqf(x); }
#endif
typedef unsigned long long ss_t;
constexpr float SS_SCALE = 65536.0f, SS_INV = 1.0f / (65536.0f * 1024.0f);
__device__ __forceinline__ ss_t ss_fix(float q) { return (ss_t)(q * SS_SCALE); }
__device__ __forceinline__ float ss_rstd(ss_t v) { return fast_rsq((float)v * SS_INV + 1e-6f); }
__device__ __forceinline__ float sigmoidf_(float v) { return fast_rcp(1.0f + fast_exp2(-v * LOG2E)); }
__device__ __forceinline__ float siluf_(float v) { return v * sigmoidf_(v); }
__device__ __forceinline__ float bf2f(unsigned short b) { return __uint_as_float(((unsigned)b) << 16); }
__device__ __forceinline__ unsigned short f2bf(float f) { return (unsigned short)(cvt_pk_bf16(f, 0.f) & 0xffffu); }
__device__ __forceinline__ u32x4 pack8(f32x4 a, f32x4 b) { u32x4 w; w.x = cvt_pk_bf16(a[0], a[1]); w.y = cvt_pk_bf16(a[2], a[3]); w.z = cvt_pk_bf16(b[0], b[1]); w.w = cvt_pk_bf16(b[2], b[3]); return w; }

#define EPI_ROW(ai, m) (u.pm * 256 + wr * 64 + fr + (ai) * 128 + (m) * 16)

constexpr int RS_OFF = 131072;
__device__ __forceinline__ void fill_rstd_table(LAS unsigned char* lds, const ss_t* ss, int bx, int wave_s) {
    int tid_; asm volatile("v_mbcnt_lo_u32_b32 %0, -1, 0\n\tv_mbcnt_hi_u32_b32 %0, -1, %0" : "=v"(tid_)); tid_ += wave_s * 64;
    LAS float* tab = (LAS float*)(lds + RS_OFF);
    constexpr int NPAN = 32 / pg8::WGM;
#pragma unroll
    for (int k = 0; k < NPAN / 2; ++k) {
        const int idx = tid_ + 512 * k, j = idx >> 8, rr = idx & 255, pm = pg8::WGM * (NPAN * (bx & 7) + j) + ((bx >> 3) & (pg8::WGM - 1));
        tab[idx] = ss_rstd(ss[pm * 256 + rr]);
    }
    __syncthreads();
}
#define EPI_RS(ai, m) (rs[((u.pm / pg8::WGM) & (32 / pg8::WGM - 1)) * 256 + wr * 64 + fr + (ai) * 128 + (m) * 16])

struct EpiUp {
    static constexpr bool PERM = true, AFTER_DRAIN = false;
    bf16_t* act; const LAS float* rs;
    __device__ __forceinline__ void operator()(const f32x4 (&acc)[2][2][4][2], const Unit& u, int wr, int wc, int fr, int fq) const {
        const unsigned e0 = (unsigned)(u.pm * 256 + wr * 64 + fr) * (unsigned)DFF + (unsigned)(u.pn * 128 + wc * 32 + 8 * fq);
        char* pa = (char*)act;
#pragma unroll
        for (int ai = 0; ai < 2; ++ai)
#pragma unroll
            for (int m = 0; m < 4; ++m) {
                const float r = EPI_RS(ai, m), c1 = -r * LOG2E, r2 = r * r;
                f32x4 h[2];
#pragma unroll
                for (int n = 0; n < 2; ++n) {
                    const f32x4 g = acc[ai][0][m][n], up = acc[ai][1][m][n];
                    const f32x4 ea = g * c1, gu = (g * up) * r2;
                    f32x4 d;
#pragma unroll
                    for (int i = 0; i < 4; ++i) d[i] = fast_exp2(ea[i]);
                    d = d + 1.0f;
#pragma unroll
                    for (int i = 0; i < 4; ++i) d[i] = fast_rcp(d[i]);
                    h[n] = gu * d;
                }
#ifdef ACT_SC1
                { const u32x4 hv = pack8(h[0], h[1]); const char* ap = pa + (size_t)((e0 + (unsigned)((ai * 128 + m * 16) * DFF)) * 2u);
                  asm volatile("global_store_dwordx4 %0, %1, off sc1" :: "v"(ap), "v"(hv) : "memory"); }
#else
                *(u32x4*)(pa + (e0 + (unsigned)((ai * 128 + m * 16) * DFF)) * 2u) = pack8(h[0], h[1]);
#endif
            }
    }
};

__device__ __forceinline__ void unpack8(u32x4 h, u32x4 l, f32x4& a, f32x4& b) {
    a[0] = __uint_as_float(h.x << 16) + __uint_as_float(l.x << 16); a[1] = __uint_as_float(h.x & 0xffff0000u) + __uint_as_float(l.x & 0xffff0000u);
    a[2] = __uint_as_float(h.y << 16) + __uint_as_float(l.y << 16); a[3] = __uint_as_float(h.y & 0xffff0000u) + __uint_as_float(l.y & 0xffff0000u);
    b[0] = __uint_as_float(h.z << 16) + __uint_as_float(l.z << 16); b[1] = __uint_as_float(h.z & 0xffff0000u) + __uint_as_float(l.z & 0xffff0000u);
    b[2] = __uint_as_float(h.w << 16) + __uint_as_float(l.w << 16); b[3] = __uint_as_float(h.w & 0xffff0000u) + __uint_as_float(l.w & 0xffff0000u);
}
__device__ __forceinline__ void split8(f32x4 a, f32x4 b, u32x4& h, u32x4& l) {
    h = pack8(a, b);
    f32x4 ra, rb;
    ra[0] = a[0] - __uint_as_float(h.x << 16); ra[1] = a[1] - __uint_as_float(h.x & 0xffff0000u); ra[2] = a[2] - __uint_as_float(h.y << 16); ra[3] = a[3] - __uint_as_float(h.y & 0xffff0000u);
    rb[0] = b[0] - __uint_as_float(h.z << 16); rb[1] = b[1] - __uint_as_float(h.z & 0xffff0000u); rb[2] = b[2] - __uint_as_float(h.w << 16); rb[3] = b[3] - __uint_as_float(h.w & 0xffff0000u);
    l = pack8(ra, rb);
}
struct EpiRes {
    static constexpr bool PERM = true, AFTER_DRAIN = false;
    bf16_t* xb; ss_t* ss; float alpha;
    __device__ __forceinline__ void operator()(const f32x4 (&acc)[2][2][4][2], const Unit& u, int wr, int wc, int fr, int fq) const {
        const unsigned row0 = (unsigned)(u.pm * 256 + wr * 64 + fr);
        const unsigned e0 = row0 * (unsigned)DM + (unsigned)(u.pn * 256 + wc * 64 + 8 * fq);
        char* ph = (char*)xb;
        u32x4 ch[2], nh[2];
        float qs[8];
#define RES_LOAD(dh, g) do { _Pragma("unroll") for (int bj = 0; bj < 2; ++bj) { const unsigned eo = e0 + (unsigned)((((g) >> 2) * 128 + ((g) & 3) * 16) * DM + bj * 32); \
            dh[bj] = *(const u32x4*)(ph + eo * 2u); } } while (0)
        RES_LOAD(ch, 0);
#pragma unroll
        for (int g = 0; g < 8; ++g) {
            const int ai = g >> 2, m = g & 3;
            if (g < 7) RES_LOAD(nh, g + 1);
            float q = 0.f;
#pragma unroll
            for (int bj = 0; bj < 2; ++bj) {
                const unsigned eo = e0 + (unsigned)((ai * 128 + m * 16) * DM + bj * 32);
                f32x4 x0, x1; unpack8(ch[bj], (u32x4){0u, 0u, 0u, 0u}, x0, x1);
                const f32x4 o0 = x0 + acc[ai][bj][m][0] * alpha, o1 = x1 + acc[ai][bj][m][1] * alpha;
                *(u32x4*)(ph + eo * 2u) = pack8(o0, o1);
                q += (o0[0] * o0[0] + o0[1] * o0[1]) + (o0[2] * o0[2] + o0[3] * o0[3]) + (o1[0] * o1[0] + o1[1] * o1[1]) + (o1[2] * o1[2] + o1[3] * o1[3]);
            }
            q += __shfl_xor(q, 16); q += __shfl_xor(q, 32);
            qs[g] = q;
            asm volatile("" ::: "memory");
#pragma unroll
            for (int bj = 0; bj < 2; ++bj) ch[bj] = nh[bj];
        }
#undef RES_LOAD
        if (fq == 0) {
#pragma unroll
            for (int g = 0; g < 8; ++g) atomicAdd((ss_t*)((char*)ss + (row0 + (unsigned)((g >> 2) * 128 + (g & 3) * 16)) * 8u), ss_fix(qs[g]));
        }
    }
};

struct EpiNull {
    static constexpr bool PERM = true, AFTER_DRAIN = false;
    float* sink;
    __device__ __forceinline__ void operator()(const f32x4 (&acc)[2][2][4][2], const Unit& u, int wr, int wc, int fr, int fq) const {
        float t = 0.f;
#pragma unroll
        for (int ai = 0; ai < 2; ++ai)
#pragma unroll
            for (int bj = 0; bj < 2; ++bj)
#pragma unroll
                for (int m = 0; m < 4; ++m)
#pragma unroll
                    for (int n = 0; n < 2; ++n) t += acc[ai][bj][m][n][0] + acc[ai][bj][m][n][1] + acc[ai][bj][m][n][2] + acc[ai][bj][m][n][3];
        if (t == 1.2345e-30f) sink[0] = t;
    }
};

struct EpiAB {
    static constexpr bool PERM = true, AFTER_DRAIN = false;
    const LAS float* rs; const float* qg; const float* kg; const float* rope; bf16_t* ub;
    __device__ __forceinline__ void operator()(const f32x4 (&acc)[2][2][4][2], const Unit& u, int wr, int wc, int fr, int fq) const {
        const int pn = u.pn;
        int kind, head;
        if (pn < 2) { kind = 0; head = 4 * pn + wc; }
        else if (pn == 2) { if (wc < 2) { kind = 1; head = wc; } else { kind = 2; head = wc - 2; } }
        else if (pn < 5) { kind = 3; head = 4 * (pn - 3) + wc; }
        else if (pn < 7) { kind = 4; head = 4 * (pn - 5) + wc; }
        else { kind = 5; head = 4 * (pn - 7) + wc; }
        if (kind <= 1) {
            const float* g = kind == 0 ? qg : kg;
            f32x4 gv[2][2];
#pragma unroll
            for (int bj = 0; bj < 2; ++bj)
#pragma unroll
                for (int n = 0; n < 2; ++n) gv[bj][n] = *(const f32x4*)(g + 32 * bj + 8 * fq + 4 * n);
            const float osc = kind == 0 ? 0.125f * LOG2E : 1.0f;
            bf16_t* dst = ub + (kind == 0 ? U_QA : U_KA);
            const int ldo = kind == 0 ? 512 : 128;
#pragma unroll
            for (int ai = 0; ai < 2; ++ai)
#pragma unroll
                for (int m = 0; m < 4; ++m) {
                    const int row = EPI_ROW(ai, m);
                    const float r = EPI_RS(ai, m);
                    f32x4 v[2][2]; float q = 0.f;
#pragma unroll
                    for (int bj = 0; bj < 2; ++bj)
#pragma unroll
                        for (int n = 0; n < 2; ++n) { v[bj][n] = acc[ai][bj][m][n] * r; const f32x4 t = v[bj][n]; q += (t[0] * t[0] + t[1] * t[1]) + (t[2] * t[2] + t[3] * t[3]); }
                    q += __shfl_xor(q, 16); q += __shfl_xor(q, 32);
                    const float rn = fast_rsq(q * (1.0f / 64.0f) + EPS) * osc;
                    const int pos = row & (SEQ - 1);
#pragma unroll
                    for (int bj = 0; bj < 2; ++bj) {
                        f32x4 o[2];
#pragma unroll
                        for (int n = 0; n < 2; ++n) {
                            const f32x4 t = v[bj][n] * gv[bj][n] * rn;
                            const f32x4 cs = *(const f32x4*)(rope + ((size_t)pos * 32 + 16 * bj + 4 * fq + 2 * n) * 2);
                            o[n][0] = t[0] * cs[0] - t[1] * cs[1]; o[n][1] = t[0] * cs[1] + t[1] * cs[0];
                            o[n][2] = t[2] * cs[2] - t[3] * cs[3]; o[n][3] = t[2] * cs[3] + t[3] * cs[2];
                        }
                        *(u32x4*)(dst + (size_t)row * ldo + head * 64 + 32 * bj + 8 * fq) = pack8(o[0], o[1]);
                    }
                    asm volatile("" ::: "memory");
                }
        } else if (kind == 3 || kind == 4) {
            const float osc = kind == 3 ? 0.125f * LOG2E : 1.0f;
            bf16_t* dst = ub + (kind == 3 ? U_QB : U_KB);
#pragma unroll
            for (int ai = 0; ai < 2; ++ai)
#pragma unroll
                for (int m = 0; m < 4; ++m) {
                    const int row = EPI_ROW(ai, m);
                    const float r = EPI_RS(ai, m) * osc;
#pragma unroll
                    for (int bj = 0; bj < 2; ++bj)
                        *(u32x4*)(dst + (size_t)row * 512 + head * 64 + 32 * bj + 8 * fq) = pack8(acc[ai][bj][m][0] * r, acc[ai][bj][m][1] * r);
                }
        } else {
            const int nh = kind == 2 ? 2 : 8;
            bf16_t* dst = ub + (kind == 2 ? U_VTA : U_VTB);
#pragma unroll
            for (int ai = 0; ai < 2; ++ai)
#pragma unroll
                for (int m = 0; m < 4; ++m) {
                    const int row = EPI_ROW(ai, m);
                    const float r = EPI_RS(ai, m);
                    const int b = row >> 11, pos = row & (SEQ - 1);
                    bf16_t* base = dst + ((size_t)(b * nh + head) * 64) * SEQ + pos;
#pragma unroll
                    for (int bj = 0; bj < 2; ++bj)
#pragma unroll
                        for (int n = 0; n < 2; ++n) {
                            const f32x4 t = acc[ai][bj][m][n] * r;
                            const unsigned w0 = cvt_pk_bf16(t[0], t[1]), w1 = cvt_pk_bf16(t[2], t[3]);
                            const int d = 32 * bj + 8 * fq + 4 * n;
                            base[(size_t)(d + 0) * SEQ] = (bf16_t)(w0 & 0xffffu); base[(size_t)(d + 1) * SEQ] = (bf16_t)(w0 >> 16);
                            base[(size_t)(d + 2) * SEQ] = (bf16_t)(w1 & 0xffffu); base[(size_t)(d + 3) * SEQ] = (bf16_t)(w1 >> 16);
                        }
                }
        }
    }
};

struct EpiCD {
    static constexpr bool PERM = true, AFTER_DRAIN = false;
    const LAS float* rs; bf16_t* ub;
    __device__ __forceinline__ void operator()(const f32x4 (&acc)[2][2][4][2], const Unit& u, int wr, int wc, int fr, int fq) const {
        const int pn = u.pn;
        const unsigned row0 = (unsigned)(u.pm * 256 + wr * 64 + fr);
        if (pn < 8) {
            char* dst = (char*)(ub + (pn < 4 ? U_E : U_P));
            const unsigned e0 = row0 * 512u + (unsigned)((pn & 3) * 128 + wc * 32 + 8 * fq);
            const bool gate = pn < 4;
#pragma unroll
            for (int ai = 0; ai < 2; ++ai)
#pragma unroll
                for (int m = 0; m < 4; ++m) {
                    const float r = EPI_RS(ai, m);
                    f32x4 h[2];
#pragma unroll
                    for (int n = 0; n < 2; ++n) {
                        const f32x4 a = acc[ai][0][m][n] * r, g = acc[ai][1][m][n] * r;
#pragma unroll
                        for (int i = 0; i < 4; ++i) h[n][i] = a[i] * (gate ? sigmoidf_(g[i]) : g[i]);
                    }
                    *(u32x4*)(dst + (e0 + (unsigned)((ai * 128 + m * 16) * 512)) * 2u) = pack8(h[0], h[1]);
                    asm volatile("" ::: "memory");
                }
        } else {
            char* dst = (char*)(ub + U_BC);
            const unsigned e0 = row0 * 512u + (unsigned)((pn - 8) * 256 + wc * 32 + 8 * fq);
#pragma unroll
            for (int ai = 0; ai < 2; ++ai)
#pragma unroll
                for (int m = 0; m < 4; ++m) {
                    const float r = EPI_RS(ai, m);
#pragma unroll
                    for (int bj = 0; bj < 2; ++bj)
                        *(u32x4*)(dst + (e0 + (unsigned)((ai * 128 + m * 16) * 512 + bj * 128)) * 2u) = pack8(acc[ai][bj][m][0] * r, acc[ai][bj][m][1] * r);
                    asm volatile("" ::: "memory");
                }
        }
    }
};

__device__ __forceinline__ float wave_sum(float v) {
#pragma unroll
    for (int o = 1; o < 64; o <<= 1) v += __shfl_xor(v, o);
    return v;
}
__device__ __forceinline__ void transpose_item(const float* src, int ldw, const float* gain, bf16_t* dst, int K, int k0, LAS float* scr, int lane) {
    float tv[32];
#pragma unroll
    for (int i = 0; i < 32; ++i) { const int kk = 2 * i + (lane >> 5); tv[i] = src[(size_t)(k0 + kk) * ldw + (lane & 31)]; }
#pragma unroll
    for (int i = 0; i < 32; ++i) { const int kk = 2 * i + (lane >> 5); float v = tv[i]; if (gain) v *= gain[k0 + kk]; scr[kk * 33 + (lane & 31)] = v; }
    asm volatile("s_waitcnt lgkmcnt(0)" ::: "memory");
    const int c = lane & 7;
#pragma unroll
    for (int j = 0; j < 4; ++j) { const int n = (lane >> 3) + 8 * j; const LAS float* s = scr + (8 * c) * 33 + n;
        u32x4 o; o.x = cvt_pk_bf16(s[0 * 33], s[1 * 33]); o.y = cvt_pk_bf16(s[2 * 33], s[3 * 33]); o.z = cvt_pk_bf16(s[4 * 33], s[5 * 33]); o.w = cvt_pk_bf16(s[6 * 33], s[7 * 33]);
        *(u32x4*)(dst + (size_t)n * K + k0 + 8 * c) = o; }
    asm volatile("s_waitcnt lgkmcnt(0)" ::: "memory");
}

struct Params {
    const float* in[18];
    float* out; unsigned char* ws;
    int ph_lo, ph_hi;
};
enum { I_X = 0, I_FFN_NORM, I_MIX_NORM, I_WG, I_WU, I_WD, I_ABIN, I_ABOUT, I_QN, I_KN, I_RPB, I_CDIN, I_CDOUT, I_CCW, I_DCW, I_DNG, I_DNB, I_FINAL };

#define RESCOL(nb) (256 * ((nb) >> 3) + 64 * ((nb) & 3) + 32 * (((nb) >> 2) & 1))
__device__ __forceinline__ void prologue_phase(const Params& p, LAS unsigned char* lds, int vcu, int NGW, int wave_s) {
    int tid_; asm volatile("v_mbcnt_lo_u32_b32 %0, -1, 0\n\tv_mbcnt_hi_u32_b32 %0, -1, %0" : "=v"(tid_)); tid_ += wave_s * 64;
    const int lane = tid_ & 63, wave = __builtin_amdgcn_readfirstlane(tid_ >> 6), gw = vcu * 8 + wave;
    unsigned char* ws = p.ws;
    ss_t* ss = (ss_t*)(ws + WS_SS);
    {
        const float* x = p.in[I_X]; bf16_t* xb = (bf16_t*)(ws + WS_XB);
        for (int row0 = gw; row0 < NTOK; row0 += 2 * NGW) {
            f32x4 v[2][4]; float sq[2];
#pragma unroll
            for (int k = 0; k < 2; ++k) { const f32x4* xr = (const f32x4*)(x + (size_t)(row0 + k * NGW) * DM) + lane;
#pragma unroll
                for (int j = 0; j < 4; ++j) v[k][j] = xr[64 * j]; }
#pragma unroll
            for (int k = 0; k < 2; ++k) {
                const int row = row0 + k * NGW; float s = 0.f;
#pragma unroll
                for (int j = 0; j < 4; ++j) s += (v[k][j][0] * v[k][j][0] + v[k][j][1] * v[k][j][1]) + (v[k][j][2] * v[k][j][2] + v[k][j][3] * v[k][j][3]);
                sq[k] = wave_sum(s);
                u32x2* o = (u32x2*)(xb + (size_t)row * DM) + lane;
#pragma unroll
                for (int j = 0; j < 4; ++j) { u32x2 w; w.x = cvt_pk_bf16(v[k][j][0], v[k][j][1]); w.y = cvt_pk_bf16(v[k][j][2], v[k][j][3]); o[64 * j] = w; }
                if (lane == 0) ss[row] = ss_fix(sq[k]);
                if (lane < 12) ss[(size_t)(lane + 1) * NTOK + row] = 0ull;
            }
        }
    }
    {
        float* rope = (float*)(ws + WS_ROPE);
        for (int idx = gw * 64 + lane; idx < SEQ * 32; idx += NGW * 64) {
            const int pos = idx >> 5, pr = idx & 31, j = pr & 15;
            const float coord = pr < 16 ? (float)(pos >> 6) : (float)(pos & 63);
            const float freq = fast_exp2(-(float)(2 * j) * (1.0f / 32.0f) * 13.287712379549449f);
            const float ang = coord * freq;
            float sn, cs; __sincosf(ang, &sn, &cs);
            rope[2 * idx] = cs; rope[2 * idx + 1] = sn;
        }
    }
    {
        LAS float* scr = (LAS float*)(lds + wave * 16384);
        constexpr int IT_GU = 16 * (NGU / 32), IT_DN = (DFF / 64) * 32, IT_ABIN = 16 * (ABIN / 32), IT_SQ = 16 * 32, IT_CDIN = 16 * (CDIN / 32);
        constexpr int IT_FFN = IT_GU + IT_DN, IT_AB = IT_ABIN + IT_SQ, IT_CD = IT_CDIN + IT_SQ;
        constexpr int NITEMS = 8 * IT_FFN + 2 * IT_AB + 2 * IT_CD;
        for (int it = gw; it < NITEMS; it += NGW) {
            int r = it;
            if (r < 8 * IT_FFN) {
                const int f = r / IT_FFN; r -= f * IT_FFN;
                if (r < IT_GU) {
                    const int nb = r % (NGU / 32), kb = r / (NGU / 32);
                    const int pn = nb >> 3, bj = (nb >> 2) & 1, j0 = 32 * (nb & 3);
                    const float* W = (bj ? p.in[I_WU] : p.in[I_WG]) + (size_t)f * DM * DFF + 128 * pn + j0;
                    transpose_item(W, DFF, p.in[I_FFN_NORM] + f * DM, (bf16_t*)(ws + WS_WGU + f * SZ_GU) + (size_t)(32 * nb) * DM, DM, 64 * kb, scr, lane);
                } else {
                    r -= IT_GU; const int nb = r % 32, kb = r / 32;
                    transpose_item(p.in[I_WD] + (size_t)f * DFF * DM + RESCOL(nb), DM, nullptr, (bf16_t*)(ws + WS_WDN + f * SZ_DN) + (size_t)(32 * nb) * DFF, DFF, 64 * kb, scr, lane);
                }
                continue;
            }
            r -= 8 * IT_FFN;
            if (r < 2 * IT_AB) {
                const int e = r / IT_AB; r -= e * IT_AB;
                if (r < IT_ABIN) {
                    const int nb = r % (ABIN / 32), kb = r / (ABIN / 32);
                    const int pn = nb >> 3, bj = (nb >> 2) & 1, wc = nb & 3;
                    transpose_item(p.in[I_ABIN] + (size_t)e * DM * ABIN + 256 * pn + 64 * wc + 32 * bj, ABIN, p.in[I_MIX_NORM] + (2 * e) * DM,
                                   (bf16_t*)(ws + WS_WABIN + e * SZ_ABIN) + (size_t)(32 * nb) * DM, DM, 64 * kb, scr, lane);
                } else {
                    r -= IT_ABIN; const int nb = r % 32, kb = r / 32;
                    transpose_item(p.in[I_ABOUT] + (size_t)e * DM * DM + RESCOL(nb), DM, nullptr, (bf16_t*)(ws + WS_WABOUT + e * SZ_SQ) + (size_t)(32 * nb) * DM, DM, 64 * kb, scr, lane);
                }
                continue;
            }
            r -= 2 * IT_AB;
            {
                const int e = r / IT_CD; r -= e * IT_CD;
                if (r < IT_CDIN) {
                    const int nb = r % (CDIN / 32), kb = r / (CDIN / 32);
                    const int pn = nb >> 3, bj = (nb >> 2) & 1, j0 = 32 * (nb & 3);
                    int scol;
                    if (pn < 4) scol = (bj ? 2048 : 1536) + 128 * pn + j0;
                    else if (pn < 8) scol = (bj ? 0 : 1024) + 128 * (pn - 4) + j0;
                    else scol = 512 + 256 * (pn - 8) + 128 * bj + j0;
                    transpose_item(p.in[I_CDIN] + (size_t)e * DM * CDIN + scol, CDIN, p.in[I_MIX_NORM] + (2 * e + 1) * DM,
                                   (bf16_t*)(ws + WS_WCDIN + e * SZ_CDIN) + (size_t)(32 * nb) * DM, DM, 64 * kb, scr, lane);
                } else {
                    r -= IT_CDIN; const int nb = r % 32, kb = r / 32;
                    transpose_item(p.in[I_CDOUT] + (size_t)e * DM * DM + RESCOL(nb), DM, nullptr, (bf16_t*)(ws + WS_WCDOUT + e * SZ_SQ) + (size_t)(32 * nb) * DM, DM, 64 * kb, scr, lane);
                }
            }
        }
    }
}

__device__ __forceinline__ void attn_global_phase(LAS unsigned char* lds, const bf16_t* Qa, const bf16_t* Ka, const bf16_t* Vta, const float* qg, const float* kg, bf16_t* y, int vcu, int G, int wave_s) {
    constexpr int PITCH = 144, TILEB = 64 * PITCH, BUFB = 2 * TILEB;
    float negCB;
    {
        int l_; asm volatile("v_mbcnt_lo_u32_b32 %0, -1, 0\n\tv_mbcnt_hi_u32_b32 %0, -1, %0" : "=v"(l_));
        float gq = fabsf(qg[l_]), gk = fabsf(kg[l_]);
#pragma unroll
        for (int o = 1; o < 64; o <<= 1) { gq = fmaxf(gq, __shfl_xor(gq, o)); gk = fmaxf(gk, __shfl_xor(gk, o)); }
        negCB = -(64.0f * 0.125f * LOG2E * 1.01f * gq * gk + 0.125f);
    }
    for (int un_ = vcu; un_ < 32 * 8 * 4; un_ += G) {
        const int un = 32 * 8 * 4 - 1 - un_;
        int tid_; asm volatile("v_mbcnt_lo_u32_b32 %0, -1, 0\n\tv_mbcnt_hi_u32_b32 %0, -1, %0" : "=v"(tid_)); tid_ += wave_s * 64;
        const int tid = tid_, lane = tid & 63, wid = __builtin_amdgcn_readfirstlane(tid >> 6), ql = lane & 31, hi = lane >> 5;
        const int srow = tid >> 3, sch = tid & 7;
        const int pik = (ql & 19) | ((ql & 4) << 1) | ((ql & 8) >> 1);
        const int qb = un & 3, h4 = (un >> 2) & 3, kvh = (un >> 4) & 1, b = un >> 5, h = kvh * 4 + h4;
        const int tok0 = b * SEQ + qb * 512 + wid * 64 + ql;
        const bf16_t* qp = Qa + (size_t)tok0 * 512 + h * 64 + hi * 8;
        bf16x8 qf[2][4];
#pragma unroll
        for (int t = 0; t < 2; ++t)
#pragma unroll
            for (int dc = 0; dc < 4; ++dc) qf[t][dc] = *(const bf16x8*)(qp + (size_t)t * 32 * 512 + dc * 16);
        const bf16_t* kg_ = Ka + (size_t)(b * SEQ + srow) * 128 + kvh * 64 + sch * 8;
        const bf16_t* vg_ = Vta + ((size_t)(b * 2 + kvh) * 64 + srow) * SEQ + sch * 8;
        f32x16 o[2][2];
#pragma unroll
        for (int t = 0; t < 2; ++t)
#pragma unroll
            for (int r = 0; r < 16; ++r) { o[t][0][r] = 0.f; o[t][1][r] = 0.f; }
        float lrun[2] = {0.f, 0.f};
        u32x4 kreg = *(const u32x4*)kg_, vreg = *(const u32x4*)vg_;
        __syncthreads();
        *(LAS u32x4*)(lds + srow * PITCH + sch * 16) = kreg; *(LAS u32x4*)(lds + TILEB + srow * PITCH + sch * 16) = vreg;
        __syncthreads();
        for (int kt = 0; kt < SEQ / 64; ++kt) {
            if (kt + 1 < SEQ / 64) { kreg = *(const u32x4*)(kg_ + (size_t)(kt + 1) * 64 * 128); vreg = *(const u32x4*)(vg_ + (kt + 1) * 64); }
            const LAS unsigned char* Kb_ = lds + (kt & 1) * BUFB; const LAS unsigned char* Vb_ = Kb_ + TILEB;
            f32x16 p[2][2];
#pragma unroll
            for (int t = 0; t < 2; ++t)
#pragma unroll
                for (int r = 0; r < 16; ++r) { p[t][0][r] = negCB; p[t][1][r] = negCB; }
#pragma unroll
            for (int dc = 0; dc < 4; ++dc) {
                const bf16x8 a0 = *(const LAS bf16x8*)(Kb_ + pik * PITCH + dc * 32 + hi * 16);
                const bf16x8 a1 = *(const LAS bf16x8*)(Kb_ + (32 + pik) * PITCH + dc * 32 + hi * 16);
#pragma unroll
                for (int t = 0; t < 2; ++t) {
                    p[t][0] = __builtin_amdgcn_mfma_f32_32x32x16_bf16(a0, qf[t][dc], p[t][0], 0, 0, 0);
                    p[t][1] = __builtin_amdgcn_mfma_f32_32x32x16_bf16(a1, qf[t][dc], p[t][1], 0, 0, 0);
                }
            }
            __builtin_amdgcn_sched_barrier(0);
            u32x4 pw[2][2][2];
#pragma unroll
            for (int t = 0; t < 2; ++t) {
                float sum = 0.f;
#pragma unroll
                for (int r = 0; r < 16; ++r) { p[t][0][r] = fast_exp2(p[t][0][r]); p[t][1][r] = fast_exp2(p[t][1][r]); sum += p[t][0][r] + p[t][1][r]; }
                lrun[t] += sum;
#pragma unroll
                for (int kb = 0; kb < 2; ++kb)
#pragma unroll
                    for (int c = 0; c < 2; ++c) {
                        pw[t][kb][c].x = cvt_pk_bf16(p[t][kb][8 * c + 0], p[t][kb][8 * c + 1]); pw[t][kb][c].y = cvt_pk_bf16(p[t][kb][8 * c + 2], p[t][kb][8 * c + 3]);
                        pw[t][kb][c].z = cvt_pk_bf16(p[t][kb][8 * c + 4], p[t][kb][8 * c + 5]); pw[t][kb][c].w = cvt_pk_bf16(p[t][kb][8 * c + 6], p[t][kb][8 * c + 7]);
                    }
            }
            __builtin_amdgcn_sched_barrier(0);
#pragma unroll
            for (int kb = 0; kb < 2; ++kb)
#pragma unroll
                for (int c = 0; c < 2; ++c) {
                    const bf16x8 v0 = *(const LAS bf16x8*)(Vb_ + ql * PITCH + (32 * kb + 16 * c + 8 * hi) * 2);
                    const bf16x8 v1 = *(const LAS bf16x8*)(Vb_ + (32 + ql) * PITCH + (32 * kb + 16 * c + 8 * hi) * 2);
#pragma unroll
                    for (int t = 0; t < 2; ++t) {
                        const bf16x8 pb = __builtin_bit_cast(bf16x8, pw[t][kb][c]);
                        o[t][0] = __builtin_amdgcn_mfma_f32_32x32x16_bf16(v0, pb, o[t][0], 0, 0, 0);
                        o[t][1] = __builtin_amdgcn_mfma_f32_32x32x16_bf16(v1, pb, o[t][1], 0, 0, 0);
                    }
                }
            if (kt + 1 < SEQ / 64) {
                LAS unsigned char* nb = lds + ((kt + 1) & 1) * BUFB;
                *(LAS u32x4*)(nb + srow * PITCH + sch * 16) = kreg; *(LAS u32x4*)(nb + TILEB + srow * PITCH + sch * 16) = vreg;
            }
            __syncthreads();
        }
#pragma unroll
        for (int t = 0; t < 2; ++t) {
            float l = lrun[t]; l += __shfl_xor(l, 32);
            const float inv = fast_rcp(l);
            bf16_t* yp = y + (size_t)(tok0 + 32 * t) * DM + h * 64 + 4 * hi;
#pragma unroll
            for (int g = 0; g < 4; ++g) {
                u32x2 w0, w1;
                w0.x = cvt_pk_bf16(o[t][0][4 * g] * inv, o[t][0][4 * g + 1] * inv); w0.y = cvt_pk_bf16(o[t][0][4 * g + 2] * inv, o[t][0][4 * g + 3] * inv);
                w1.x = cvt_pk_bf16(o[t][1][4 * g] * inv, o[t][1][4 * g + 1] * inv); w1.y = cvt_pk_bf16(o[t][1][4 * g + 2] * inv, o[t][1][4 * g + 3] * inv);
                *(u32x2*)(yp + 8 * g) = w0; *(u32x2*)(yp + 32 + 8 * g) = w1;
            }
        }
    }
}

constexpr int NA_TAB = 0, NA_K = 2048, NA_KP = 144, NA_V = NA_K + 576 * NA_KP, NA_VP = 1168, NA_END = NA_V + 64 * NA_VP;
__device__ __forceinline__ void attn_na_phase(LAS unsigned char* lds, const bf16_t* Qb, const bf16_t* Kb, const bf16_t* Vtb, const float* rpb, bf16_t* y, int vcu, int G, int wave_s) {
    int tid_; asm volatile("v_mbcnt_lo_u32_b32 %0, -1, 0\n\tv_mbcnt_hi_u32_b32 %0, -1, %0" : "=v"(tid_)); tid_ += wave_s * 64;
    const int tid = tid_, lane = tid & 63, wid = __builtin_amdgcn_readfirstlane(tid >> 6), ql = lane & 15, quad = lane >> 4;
    LAS float* tab = (LAS float*)(lds + NA_TAB);
    const int srow = tid >> 3, sch = tid & 7;
    u32x4 kreg[9], vreg[9];
#define NA_FETCH(unx) do { const int rp_ = (unx) & 15, h_ = ((unx) >> 4) & 7, b_ = (unx) >> 7; \
        const int rs0_ = min(max(2 * rp_ - 4, 0), 24), rs1_ = min(max(2 * rp_ - 3, 0), 24), nrows_ = rs1_ + 8 - rs0_; \
        const bf16_t* kg = Kb + (size_t)(b_ * SEQ + rs0_ * 64 + srow) * 512 + h_ * 64 + sch * 8; \
        const bf16_t* vg = Vtb + ((size_t)(b_ * 8 + h_) * 64 + srow) * SEQ + rs0_ * 64 + sch * 8; \
        _Pragma("unroll") for (int i = 0; i < 8; ++i) { kreg[i] = *(const u32x4*)(kg + (size_t)i * 64 * 512); vreg[i] = *(const u32x4*)(vg + i * 64); } \
        if (nrows_ > 8) { kreg[8] = *(const u32x4*)(kg + (size_t)8 * 64 * 512); vreg[8] = *(const u32x4*)(vg + 8 * 64); } \
        else { kreg[8] = (u32x4){0u, 0u, 0u, 0u}; vreg[8] = kreg[8]; } } while (0)
    if (vcu < 32 * 8 * 16) NA_FETCH(32 * 8 * 16 - 1 - vcu);
    for (int un_ = vcu; un_ < 32 * 8 * 16; un_ += G) {
        const int un = 32 * 8 * 16 - 1 - un_;
        const int rp = un & 15, h = (un >> 4) & 7, b = un >> 7;
        const int rs0 = min(max(2 * rp - 4, 0), 24);
        const int r = rp * 2 + (wid >> 2), n = wid & 3;
        const int rs = min(max(r - 4, 0), 24), kcol0 = min(max(16 * n - 8, 0), 32), ro = rs - rs0;
        const int qcol = 16 * n + ql, wcs = min(max(qcol - 8, 0), 48);
        const int tokq = b * SEQ + r * 64 + qcol;
        bf16x8 qf[2];
#pragma unroll
        for (int dc = 0; dc < 2; ++dc) qf[dc] = *(const bf16x8*)(Qb + (size_t)tokq * 512 + h * 64 + 32 * dc + 8 * quad);
        __syncthreads();
        for (int i = tid; i < 465; i += 512) tab[i] = rpb[h * 465 + i] * LOG2E;
#pragma unroll
        for (int i = 0; i < 9; ++i) {
            *(LAS u32x4*)(lds + NA_K + (i * 64 + srow) * NA_KP + sch * 16) = kreg[i];
            *(LAS u32x4*)(lds + NA_V + srow * NA_VP + (i * 64 + sch * 8) * 2) = vreg[i];
        }
        __syncthreads();
        if (un_ + G < 32 * 8 * 16) NA_FETCH(32 * 8 * 16 - 1 - (un_ + G));
        int co[2][4]; bool val[2][4];
#pragma unroll
        for (int ch = 0; ch < 2; ++ch)
#pragma unroll
            for (int i = 0; i < 4; ++i) { const int kc = kcol0 + 16 * ch + 4 * quad + i; val[ch][i] = (kc >= wcs) && (kc < wcs + 16); co[ch][i] = min(max(kc - qcol + 15, 0), 30); }
        const LAS unsigned char* kbase = lds + NA_K + ((ro * 64 + kcol0 + ql) * NA_KP) + quad * 16;
        const LAS unsigned char* vbase = lds + NA_V + ql * NA_VP + (ro * 64 + kcol0 + 4 * quad) * 2;
        f32x4 s[8][2];
        float mx = -1e30f;
#pragma unroll
        for (int w = 0; w < 8; ++w) {
            const int rowoff = (rs + w - r + 7) * 31;
#pragma unroll
            for (int ch = 0; ch < 2; ++ch) {
                const bf16x8 k0 = *(const LAS bf16x8*)(kbase + (w * 64 + 16 * ch) * NA_KP), k1 = *(const LAS bf16x8*)(kbase + (w * 64 + 16 * ch) * NA_KP + 64);
                f32x4 a = {0.f, 0.f, 0.f, 0.f};
                a = __builtin_amdgcn_mfma_f32_16x16x32_bf16(k0, qf[0], a, 0, 0, 0);
                a = __builtin_amdgcn_mfma_f32_16x16x32_bf16(k1, qf[1], a, 0, 0, 0);
#pragma unroll
                for (int i = 0; i < 4; ++i) { const float v = val[ch][i] ? a[i] + tab[rowoff + co[ch][i]] : -1e30f; s[w][ch][i] = v; mx = fmaxf(mx, v); }
            }
        }
        mx = fmaxf(mx, __shfl_xor(mx, 16)); mx = fmaxf(mx, __shfl_xor(mx, 32));
        float l = 0.f;
#pragma unroll
        for (int w = 0; w < 8; ++w)
#pragma unroll
            for (int ch = 0; ch < 2; ++ch)
#pragma unroll
                for (int i = 0; i < 4; ++i) { const float e = fast_exp2(s[w][ch][i] - mx); s[w][ch][i] = e; l += e; }
        l += __shfl_xor(l, 16); l += __shfl_xor(l, 32);
        f32x4 o[4];
#pragma unroll
        for (int dt = 0; dt < 4; ++dt) o[dt] = (f32x4){0.f, 0.f, 0.f, 0.f};
#pragma unroll
        for (int w = 0; w < 8; ++w) {
            const bf16x8 pb = __builtin_bit_cast(bf16x8, pack8(s[w][0], s[w][1]));
#pragma unroll
            for (int dt = 0; dt < 4; ++dt) {
                const u32x2 lo = *(const LAS u32x2*)(vbase + (16 * dt) * NA_VP + w * 128), hi2 = *(const LAS u32x2*)(vbase + (16 * dt) * NA_VP + w * 128 + 32);
                const u32x4 av = {lo.x, lo.y, hi2.x, hi2.y};
                o[dt] = __builtin_amdgcn_mfma_f32_16x16x32_bf16(__builtin_bit_cast(bf16x8, av), pb, o[dt], 0, 0, 0);
            }
        }
        const float inv = fast_rcp(l);
        bf16_t* yp = y + (size_t)tokq * DM + 512 + h * 64 + 4 * quad;
#pragma unroll
        for (int dt = 0; dt < 4; ++dt) { u32x2 w2; w2.x = cvt_pk_bf16(o[dt][0] * inv, o[dt][1] * inv); w2.y = cvt_pk_bf16(o[dt][2] * inv, o[dt][3] * inv); *(u32x2*)(yp + 16 * dt) = w2; }
    }
}

__device__ __forceinline__ float dpp_add(float v, float acc, const int ctrl, const int row_mask) { return acc; }
#define DPP_STEP(v, ctrl, rmask) (v) += __builtin_bit_cast(float, __builtin_amdgcn_update_dpp(0, __builtin_bit_cast(int, (v)), (ctrl), (rmask), 0xf, false))
__device__ __forceinline__ float wave_sum63(float v) {
    DPP_STEP(v, 0xB1, 0xf);
    DPP_STEP(v, 0x4E, 0xf);
    DPP_STEP(v, 0x114, 0xf);
    DPP_STEP(v, 0x118, 0xf);
    DPP_STEP(v, 0x142, 0xa);
    DPP_STEP(v, 0x143, 0xc);
    return v;
}
#undef NA_FETCH
template <int I> __device__ __forceinline__ void conv31_step(f32x2 (&acc)[32], const f32x2 (&wd)[31], const LAS unsigned char* base) {
    const unsigned raw = *(const LAS unsigned*)(base + I * 1024);
    const f32x2 v = {__uint_as_float(raw << 16), __uint_as_float(raw & 0xffff0000u)};
    constexpr int TLO = I - 30 > 0 ? I - 30 : 0, THI = I < 31 ? I : 31;
#pragma unroll
    for (int t = TLO; t <= THI; ++t) acc[t] += v * wd[I - t];
}
template <int... Is> __device__ __forceinline__ void conv31_all(f32x2 (&acc)[32], const f32x2 (&wd)[31], const LAS unsigned char* base, std::integer_sequence<int, Is...>) {
    (conv31_step<Is>(acc, wd, base), ...);
}
__device__ __forceinline__ void cd_core_phase(LAS unsigned char* lds, const bf16_t* E, const bf16_t* P, const bf16_t* Bc, const float* ccw, const float* dcw,
                                              const float* lng, const float* lnb, bf16_t* y, int vcu, int G, int wave_s) {
    constexpr int ROWS = 94, ROWB = 1024, PART_OFF = 96 * ROWB;
    LAS f32x2* part = (LAS f32x2*)(lds + PART_OFF);
    for (int un_ = vcu; un_ < NTOK / 64; un_ += G) {
        const int un = NTOK / 64 - 1 - un_;
        int tid_; asm volatile("v_mbcnt_lo_u32_b32 %0, -1, 0\n\tv_mbcnt_hi_u32_b32 %0, -1, %0" : "=v"(tid_)); tid_ += wave_s * 64;
        const int tid = tid_, lane = tid & 63, wid = __builtin_amdgcn_readfirstlane(tid >> 6), cp = tid & 255, th = tid >> 8, c0 = 2 * cp;
        const int t0 = un * 64, p0 = t0 & (SEQ - 1);
        __syncthreads();
        {
            u32x4 ev[12];
#pragma unroll
            for (int j = 0; j < 12; ++j) {
                const int c = tid + 512 * j, i = c >> 6, cc = c & 63, pos = p0 - 15 + i;
                ev[j] = (u32x4){0u, 0u, 0u, 0u};
                if (i < ROWS && pos >= 0 && pos < SEQ) ev[j] = *(const u32x4*)(E + (size_t)(t0 - 15 + i) * 512 + cc * 8);
            }
#pragma unroll
            for (int j = 0; j < 12; ++j) { const int c = tid + 512 * j, i = c >> 6, cc = c & 63; if (i < ROWS) *(LAS u32x4*)(lds + i * ROWB + cc * 16) = ev[j]; }
        }
        __syncthreads();
        f32x2 acc[32];
        {
            f32x2 wd[31];
#pragma unroll
            for (int k = 0; k < 31; ++k) wd[k] = *(const f32x2*)(dcw + k * 512 + c0);
#pragma unroll
            for (int t = 0; t < 32; ++t) acc[t] = (f32x2){0.f, 0.f};
            conv31_all(acc, wd, lds + (32 * th) * ROWB + cp * 4, std::make_integer_sequence<int, 62>{});
        }
        unsigned pr[34], br[32];
#pragma unroll
        for (int t = 0; t < 32; ++t) asm volatile("" : "+v"(acc[t]));
        {
            const int tokb = t0 + 32 * th, posb = p0 + 32 * th;
#pragma unroll
            for (int j = 0; j < 34; ++j) {
                const int pos = posb - 1 + j; const bool ok = (pos >= 0 && pos < SEQ);
                const unsigned v = *(const unsigned*)(P + (size_t)(ok ? tokb - 1 + j : tokb) * 512 + c0);
                pr[j] = ok ? v : 0u;
            }
#pragma unroll
            for (int j = 0; j < 32; ++j) br[j] = *(const unsigned*)(Bc + (size_t)(tokb + j) * 512 + c0);
        }
#ifdef REP_STATS
        for (int rep = 0; rep < REP_STATS; ++rep)
#endif
#pragma unroll
        for (int t = 0; t < 32; ++t) {
            float s1 = acc[t][0] + acc[t][1], s2 = acc[t][0] * acc[t][0] + acc[t][1] * acc[t][1];
            s1 = wave_sum63(s1); s2 = wave_sum63(s2);
            if (lane == 63) part[(32 * th + t) * 4 + (wid & 3)] = (f32x2){s1, s2};
        }
        __syncthreads();
        const f32x2 w0 = *(const f32x2*)(ccw + c0), w1 = *(const f32x2*)(ccw + 512 + c0), w2 = *(const f32x2*)(ccw + 1024 + c0);
        const f32x2 gg = *(const f32x2*)(lng + c0), bb = *(const f32x2*)(lnb + c0);
#pragma unroll
        for (int t = 0; t < 32; ++t) {
            const int tok = t0 + 32 * th + t;
            const f32x2 a = part[(32 * th + t) * 4 + 0], b2 = part[(32 * th + t) * 4 + 1], c2 = part[(32 * th + t) * 4 + 2], d2 = part[(32 * th + t) * 4 + 3];
            const float mean = ((a[0] + b2[0]) + (c2[0] + d2[0])) * (1.0f / 512.0f);
            const float var = ((a[1] + b2[1]) + (c2[1] + d2[1])) * (1.0f / 512.0f) - mean * mean;
            const float rstd = fast_rsq(fmaxf(var, 0.f) + EPS);
            const float z0 = (acc[t][0] - mean) * rstd * gg[0] + bb[0], z1 = (acc[t][1] - mean) * rstd * gg[1] + bb[1];
            *(unsigned*)(y + (size_t)tok * DM + 512 + c0) = cvt_pk_bf16(siluf_(z0), siluf_(z1));
            const unsigned rm = pr[t], rc = pr[t + 1], rp = pr[t + 2], rb = br[t];
            const float y0 = __uint_as_float(rb << 16) * (__uint_as_float(rm << 16) * w0[0] + __uint_as_float(rc << 16) * w1[0] + __uint_as_float(rp << 16) * w2[0]);
            const float y1 = __uint_as_float(rb & 0xffff0000u) * (__uint_as_float(rm & 0xffff0000u) * w0[1] + __uint_as_float(rc & 0xffff0000u) * w1[1] + __uint_as_float(rp & 0xffff0000u) * w2[1]);
            *(unsigned*)(y + (size_t)tok * DM + c0) = cvt_pk_bf16(y0, y1);
        }
    }
}

__device__ __forceinline__ void final_phase(float* out, const bf16_t* xb, const ss_t* ss, const float* g, int vcu, int NGW, int wave_s) {
    int tid_; asm volatile("v_mbcnt_lo_u32_b32 %0, -1, 0\n\tv_mbcnt_hi_u32_b32 %0, -1, %0" : "=v"(tid_)); tid_ += wave_s * 64;
    const int lane = tid_ & 63, gw = vcu * 8 + __builtin_amdgcn_readfirstlane(tid_ >> 6);
    f32x4 gv[2][2];
#pragma unroll
    for (int j = 0; j < 2; ++j) { gv[j][0] = *(const f32x4*)(g + 512 * j + 8 * lane); gv[j][1] = *(const f32x4*)(g + 512 * j + 8 * lane + 4); }
    for (int row0 = gw; row0 < NTOK; row0 += 2 * NGW) {
        u32x4 xv[2][2]; float r[2];
#pragma unroll
        for (int k = 0; k < 2; ++k) { const int row = row0 + k * NGW; r[k] = ss_rstd(ss[row]);
#pragma unroll
            for (int j = 0; j < 2; ++j) xv[k][j] = *(const u32x4*)(xb + (size_t)row * DM + 512 * j + 8 * lane); }
#pragma unroll
        for (int k = 0; k < 2; ++k)
#pragma unroll
            for (int j = 0; j < 2; ++j) {
                const size_t off = (size_t)(row0 + k * NGW) * DM + 512 * j + 8 * lane;
                f32x4 a, b; unpack8(xv[k][j], (u32x4){0u, 0u, 0u, 0u}, a, b);
                *(f32x4*)(out + off) = a * r[k] * gv[j][0]; *(f32x4*)(out + off + 4) = b * r[k] * gv[j][1];
            }
    }
}

#ifndef GEMM_SP2
#define GEMM_SP2 true
#endif
#ifndef RES_SP2
#define RES_SP2 true
#endif
#ifndef RES_ALIGN
#define RES_ALIGN true
#endif
#ifndef REP_UP
#define REP_UP 1
#endif
#ifndef REP_ABIN
#define REP_ABIN 1
#endif
#ifndef REP_CDIN
#define REP_CDIN 1
#endif
#ifndef REP_AG
#define REP_AG 1
#endif
#ifndef REP_NA
#define REP_NA 1
#endif
#ifndef REP_CDC
#define REP_CDC 1
#endif
#ifndef REP_PRO
#define REP_PRO 1
#endif
#define XB_TMO      128
#define XB_XCNT(j)  (256  + 64 * (j))
#define XB_XSUB(j)  (1280 + 64 * (j))
#define XB_XGEN(j)  (2304 + 64 * (j))
#define XB_TOP      3328
#define XB_TOPGEN   3392
#define XCD_BAR_WORDS 3456
#define XB_SPIN_CAP (1u << 18)

__device__ __forceinline__ unsigned xb_ld(unsigned* p)              { return __hip_atomic_load(p, __ATOMIC_RELAXED, __HIP_MEMORY_SCOPE_AGENT); }
__device__ __forceinline__ unsigned xb_add(unsigned* p, unsigned v) { return __hip_atomic_fetch_add(p, v, __ATOMIC_RELAXED, __HIP_MEMORY_SCOPE_AGENT); }
__device__ __forceinline__ unsigned xb_xcc_id() { return (unsigned)__builtin_amdgcn_s_getreg((3 << 11) | 20) & 0xFu; }
#define XB_SPIN(cond, bar) do { unsigned _sp = 0; while (cond) { __builtin_amdgcn_s_sleep(1); \
    if ((++_sp & 255u) == 0u) { if (xb_ld(&(bar)[XB_TMO])) break; if (_sp > XB_SPIN_CAP) { atomicAdd(&(bar)[XB_TMO], 1u); break; } } } } while (0)

struct XcdBarrier {
    unsigned* bar; unsigned x;
    volatile LAS unsigned* st;
};

__device__ __forceinline__ XcdBarrier xcd_barrier_post(unsigned* bar, volatile LAS unsigned* st) {
    XcdBarrier b; b.bar = bar; b.x = xb_xcc_id(); b.st = st;
    if (threadIdx.x == 0) (void)xb_add(&bar[XB_XCNT(b.x)], 1u);
    return b;
}
__device__ __forceinline__ void xcd_barrier_complete(unsigned* bar, unsigned x, unsigned& nloc, unsigned& nx) {
    const unsigned G = gridDim.x * gridDim.y * gridDim.z;
    unsigned sum, cnt, mine, sp = 0u;
    for (;;) {
        sum = 0u; cnt = 0u; mine = 0u;
#pragma unroll
        for (unsigned j = 0; j < 16; ++j) { const unsigned c = xb_ld(&bar[XB_XCNT(j)]); sum += c; cnt += (c > 0u) ? 1u : 0u; mine = (j == x) ? c : mine; }
        if (sum == G) break;
        __builtin_amdgcn_s_sleep(1);
        if ((++sp & 255u) == 0u) { if (xb_ld(&bar[XB_TMO])) break; if (sp > XB_SPIN_CAP) { atomicAdd(&bar[XB_TMO], 1u); break; } }
    }
    nloc = mine > 0u ? mine : 1u; nx = cnt > 0u ? cnt : 1u;
}

__device__ __forceinline__ void xcd_barrier(const XcdBarrier& b) {
    asm volatile("s_waitcnt vmcnt(0)" ::: "memory");
    __syncthreads();
    if (threadIdx.x == 0) {
        unsigned* bar = b.bar;
        __builtin_amdgcn_s_waitcnt(0);
        unsigned nloc = b.st[0], nx = b.st[1];
        if (nloc == 0u) { xcd_barrier_complete(bar, b.x, nloc, nx); b.st[0] = nloc; b.st[1] = nx; }
        const unsigned old = xb_add(&bar[XB_XSUB(b.x)], 1u);
        const unsigned gen = old / nloc;
        if (old + 1u == (gen + 1u) * nloc) {
            __builtin_amdgcn_fence(__ATOMIC_RELEASE, "agent");
            asm volatile("s_waitcnt vmcnt(0)" ::: "memory");
            const unsigned og = xb_add(&bar[XB_TOP], 1u);
            const unsigned tg = og / nx;
            if (og + 1u == (tg + 1u) * nx) xb_add(&bar[XB_TOPGEN], 1u);
            else XB_SPIN(xb_ld(&bar[XB_TOPGEN]) == tg, bar);
            __builtin_amdgcn_fence(__ATOMIC_ACQUIRE, "agent");
            xb_add(&bar[XB_XGEN(b.x)], 1u);
            asm volatile("s_waitcnt vmcnt(0)" ::: "memory");
        } else {
            XB_SPIN(xb_ld(&bar[XB_XGEN(b.x)]) == gen, bar);
            __builtin_amdgcn_fence(__ATOMIC_ACQUIRE, "agent");
            asm volatile("s_waitcnt vmcnt(0)" ::: "memory");
        }
    }
    __syncthreads();
}

constexpr int LDS_BYTES = 163840;
static_assert(NA_END <= LDS_BYTES - 64, "NA tiles vs LDS");
__global__ void __launch_bounds__(512, 2) mega_fwd(Params p) {
    extern __shared__ __attribute__((aligned(16))) unsigned char lds_raw[];
    LAS unsigned char* lds = (LAS unsigned char*)lds_raw;
    cg::grid_group grid = cg::this_grid();
    const int G = gridDim.x, bx = blockIdx.x;
    const int wave_s = __builtin_amdgcn_readfirstlane((int)threadIdx.x >> 6);
    const int vcu = (G % 8 == 0) ? (bx % 8) * (G / 8) + bx / 8 : bx;
    const int NGW = G * 8;
    unsigned char* ws = p.ws;
    ss_t* ss = (ss_t*)(ws + WS_SS);
    bf16_t* xb = (bf16_t*)(ws + WS_XB); bf16_t* yb = (bf16_t*)(ws + WS_Y); bf16_t* act = (bf16_t*)(ws + WS_ACT);
    const float* rope = (const float*)(ws + WS_ROPE);
    volatile LAS unsigned* bst = (volatile LAS unsigned*)(lds + LDS_BYTES - 64);
    if (threadIdx.x < 2) bst[threadIdx.x] = 0u;
    __syncthreads();
    XcdBarrier xbar = xcd_barrier_post((unsigned*)(ws + WS_BAR), bst);
    int ph = 0;
#define PHASE_BEGIN if (ph >= p.ph_lo && ph < p.ph_hi) {
#define PHASE_END   if (ph + 1 < p.ph_hi) { if (ph == 0) { asm volatile("s_waitcnt vmcnt(0)" ::: "memory"); grid.sync(); __builtin_amdgcn_fence(__ATOMIC_ACQUIRE, "agent"); asm volatile("s_waitcnt vmcnt(0)" ::: "memory"); } else xcd_barrier(xbar); } } ++ph;

    PHASE_BEGIN
#ifndef NO_PRO
    for (int rep = 0; rep < REP_PRO; ++rep)
    prologue_phase(p, lds, vcu, NGW, wave_s);
#endif
    PHASE_END

    for (int l = 0; l < 4; ++l) {
        for (int half = 0; half < 2; ++half) {
            const int f = 2 * l + half;
            const ss_t* ssin = ss + (size_t)(3 * l + 2 * half) * NTOK;
            ss_t* ssmid = ss + (size_t)(3 * l + 2 * half + 1) * NTOK;
            PHASE_BEGIN {
                pg8::Gemm g{xb, (const bf16_t*)(ws + WS_WGU + f * SZ_GU), NTOK, NGU, DM}; pg8::StaticOrder S; S.init(NTOK, NGU, G, bx);
                fill_rstd_table(lds, ssin, bx, wave_s);
                EpiUp E{act, (const LAS float*)(lds + RS_OFF)};

#ifndef NO_UP
                for (int rep = 0; rep < REP_UP; ++rep)
                pg8::gemm_phase<EpiUp, pg8::StaticOrder, true, GEMM_SP2>(lds, g, S, E, wave_s);
#endif

            } PHASE_END
            PHASE_BEGIN {
                pg8::Gemm g{act, (const bf16_t*)(ws + WS_WDN + f * SZ_DN), NTOK, DM, DFF}; RevOrder S; S.S.init(NTOK, DM, G, bx); S.n = (NTOK / 256) * (DM / 256) / G;
#ifdef REP_DNULL
                { EpiNull EN{(float*)(ws + WS_ROPE)}; pg8::gemm_phase<EpiNull, pg8::StaticOrder, true, true>(lds, g, S, EN, wave_s); }
#endif
                EpiRes E{xb, ssmid, 0.5f};

#ifndef NO_RES
                pg8::gemm_phase<EpiRes, RevOrder, RES_ALIGN, RES_SP2>(lds, g, S, E, wave_s);
#endif

            } PHASE_END
#ifdef SKIP_MIX
            if (false) {
#else
            if (half == 0) {
#endif
                const int e = l >> 1;
                const ss_t* ssmix = ssmid;
                ss_t* ssout = ss + (size_t)(3 * l + 2) * NTOK;
                if ((l & 1) == 0) {
                    PHASE_BEGIN {
                        pg8::Gemm g{xb, (const bf16_t*)(ws + WS_WABIN + e * SZ_ABIN), NTOK, ABIN, DM}; pg8::StaticOrder S; S.init(NTOK, ABIN, G, bx);
                        fill_rstd_table(lds, ssmix, bx, wave_s);
                        EpiAB E{(const LAS float*)(lds + RS_OFF), p.in[I_QN] + e * 64, p.in[I_KN] + e * 64, rope, act};

#ifndef NO_AB
                for (int rep = 0; rep < REP_ABIN; ++rep)
                pg8::gemm_phase<EpiAB, pg8::StaticOrder, true, GEMM_SP2>(lds, g, S, E, wave_s);
#endif

                    } PHASE_END
                    PHASE_BEGIN {

#ifndef NO_AG
                        for (int rep = 0; rep < REP_AG; ++rep)
                        attn_global_phase(lds, act + U_QA, act + U_KA, act + U_VTA, p.in[I_QN] + e * 64, p.in[I_KN] + e * 64, yb, vcu, G, wave_s);
#endif
#ifndef NO_NA
                        for (int rep = 0; rep < REP_NA; ++rep)
                        attn_na_phase(lds, act + U_QB, act + U_KB, act + U_VTB, p.in[I_RPB] + (size_t)e * 8 * 465, yb, vcu, G, wave_s);
#endif

                    } PHASE_END
                } else {
                    PHASE_BEGIN {
                        pg8::Gemm g{xb, (const bf16_t*)(ws + WS_WCDIN + e * SZ_CDIN), NTOK, CDIN, DM}; pg8::StaticOrder S; S.init(NTOK, CDIN, G, bx);
                        fill_rstd_table(lds, ssmix, bx, wave_s);
                        EpiCD E{(const LAS float*)(lds + RS_OFF), act};

#ifndef NO_CDG
                for (int rep = 0; rep < REP_CDIN; ++rep)
                pg8::gemm_phase<EpiCD, pg8::StaticOrder, true, GEMM_SP2>(lds, g, S, E, wave_s);
#endif

                    } PHASE_END
                    PHASE_BEGIN {

#ifndef NO_CD
                        for (int rep = 0; rep < REP_CDC; ++rep)
                        cd_core_phase(lds, act + U_E, act + U_P, act + U_BC, p.in[I_CCW] + (size_t)e * 3 * 512, p.in[I_DCW] + (size_t)e * 31 * 512,
                                      p.in[I_DNG] + e * 512, p.in[I_DNB] + e * 512, yb, vcu, G, wave_s);
#endif

                    } PHASE_END
                }
                PHASE_BEGIN {
                    const size_t woff = (l & 1) ? (WS_WCDOUT + e * SZ_SQ) : (WS_WABOUT + e * SZ_SQ);
                    pg8::Gemm g{yb, (const bf16_t*)(ws + woff), NTOK, DM, DM}; RevOrder S; S.S.init(NTOK, DM, G, bx); S.n = (NTOK / 256) * (DM / 256) / G;
#ifdef REP_OUTFAKE
                    { EpiRes EF{xb, ss + (size_t)13 * NTOK, 1.0f}; pg8::gemm_phase<EpiRes, RevOrder, true, true>(lds, g, S, EF, wave_s); }
#endif
                    EpiRes E{xb, ssout, 1.0f};

#ifndef NO_RES
                pg8::gemm_phase<EpiRes, RevOrder, RES_ALIGN, RES_SP2>(lds, g, S, E, wave_s);
#endif

                } PHASE_END
            }
        }
    }
#ifdef REP_SYNC
    for (int rep = 0; rep < REP_SYNC; ++rep) xcd_barrier(xbar);
#endif
    PHASE_BEGIN final_phase(p.out, xb, ss + (size_t)12 * NTOK, p.in[I_FINAL], vcu, NGW, wave_s); PHASE_END
#undef PHASE_BEGIN
#undef PHASE_END
}

extern "C" void kernel_launch(void* const* d_in, const int* in_sizes, int n_in, void* d_out, int out_size, void* d_ws, size_t ws_size, hipStream_t stream) {
    static int grid = 0;
    if (grid == 0) {
        if (n_in != 18 || in_sizes[0] != NTOK * DM || out_size != NTOK * DM || ws_size < WS_END) {
            fprintf(stderr, "kernel_launch: unexpected shapes (n_in %d, in0 %d, out %d, ws %zu); nothing launched\n", n_in, n_in > 0 ? in_sizes[0] : -1, out_size, ws_size); grid = -1; return; }
        int dev = 0, cus = 0, per_cu = 0;
        hipGetDevice(&dev);
        hipDeviceGetAttribute(&cus, hipDeviceAttributeMultiprocessorCount, dev);
        hipFuncSetAttribute((const void*)mega_fwd, hipFuncAttributeMaxDynamicSharedMemorySize, LDS_BYTES);
        hipOccupancyMaxActiveBlocksPerMultiprocessor(&per_cu, (const void*)mega_fwd, 512, LDS_BYTES);
        if (per_cu < 1) per_cu = 1;
        grid = cus * (per_cu > 1 ? 1 : per_cu);
        if (grid != 256) { fprintf(stderr, "kernel_launch: built for a 256-CU device (got %d workgroups); nothing launched\n", grid); grid = -1; return; }
        (void)hipGetLastError();
    }
    if (grid < 0) return;
    Params p{};
    for (int i = 0; i < 18; ++i) p.in[i] = (const float*)d_in[i];
    p.out = (float*)d_out; p.ws = (unsigned char*)d_ws; p.ph_lo = 0; p.ph_hi = 1000;
    if (hipMemsetAsync((char*)d_ws + WS_BAR, 0, 16384, stream) != hipSuccess) { fprintf(stderr, "kernel_launch: memset of the barrier words failed\n"); return; }
    void* args[] = {&p};
    hipError_t e = hipLaunchCooperativeKernel((const void*)mega_fwd, dim3(grid), dim3(512), args, LDS_BYTES, stream);
    if (e != hipSuccess) fprintf(stderr, "cooperative launch failed: %s (grid %d)\n", hipGetErrorString(e), grid);
}
```

```cpp
#include <hip/hip_runtime.h>
#include <hip/hip_cooperative_groups.h>
#include <cstdio>
#include <cstdint>
#include <utility>
namespace cg = cooperative_groups;
#ifndef PG8_WGM
#define PG8_WGM 8
#endif
namespace pg8 {
#define PG8_LAS __attribute__((address_space(3)))
typedef unsigned short bf16_t;
typedef short bf16x8 __attribute__((ext_vector_type(8)));
typedef float f32x4 __attribute__((ext_vector_type(4)));
typedef unsigned u32x4 __attribute__((ext_vector_type(4)));
constexpr int BM = 256, BK = 64, HALF = 128, HTB = HALF * BK * 2  , STAGE_BYTES = 8 * HTB, NXCD = 8, WGM = PG8_WGM;

__host__ __device__ __forceinline__ int lds_byte(int r, int c) { const int st = (r >> 4) * 2 + (c >> 5), rr = r & 15, cc = c & 31, ob = rr * 64 + cc * 2; return st * 1024 + (ob ^ (((ob >> 9) & 1) << 5)); }
__host__ __device__ __forceinline__ void stage_rc(int b, int& R, int& C) { const int st = b / 1024, sb = b % 1024, swz = sb ^ (((sb >> 9) & 1) << 5); R = (st >> 1) * 16 + swz / 64; C = (st & 1) * 32 + (swz % 64) / 2; }
__host__ __device__ __forceinline__ int perm32(int rho) { const int n = rho >> 4, i = rho & 15; return 8 * (i >> 2) + 4 * n + (i & 3); }

struct Unit { int pm, pn; };
struct Gemm { const bf16_t* A; const bf16_t* Bt; int M, N, K; };

struct StaticOrder {
    int nM, nN, nwg, G, c;
    __host__ __device__ void init(int M, int N, int G_, int c_) { nM = M / BM; nN = N / BM; nwg = nM * nN; G = G_; c = c_; }
    __host__ __device__ bool next(int i, Unit& u) const {
        const long L = (long)i * G + c; if (L >= nwg) return false;
        int wgid = (int)L; { const int q = nwg / NXCD, r = nwg % NXCD, xcd = wgid % NXCD, off = wgid / NXCD; wgid = (xcd < r ? xcd * (q + 1) : r * (q + 1) + (xcd - r) * q) + off; }
        const int nig = WGM * nN, gid = wgid / nig, fm = gid * WGM, gsz = (nM - fm) < WGM ? (nM - fm) : WGM;
        u.pm = fm + ((wgid % nig) % gsz); u.pn = (wgid % nig) / gsz; return true;
    }
    __device__ __forceinline__ void a_ready(const Unit&) const {}
    __device__ __forceinline__ void done(const Unit&) const {}
};

__device__ __forceinline__ unsigned cvt_pk_bf16(float lo, float hi) { unsigned r; asm volatile("v_cvt_pk_bf16_f32 %0, %1, %2" : "=v"(r) : "v"(lo), "v"(hi)); return r; }
typedef float f32x2 __attribute__((ext_vector_type(2)));
template <class Epi, class Sched, bool ALIGN_EPI = false, bool SP2 = false>
__device__ __forceinline__ void gemm_phase(PG8_LAS unsigned char* lds, const Gemm g, const Sched& S, const Epi& E, int wave_s) {
    int tid_; asm volatile("v_mbcnt_lo_u32_b32 %0, -1, 0\n\tv_mbcnt_hi_u32_b32 %0, -1, %0" : "=v"(tid_)); tid_ += wave_s * 64;
    const int tid = tid_, wid = __builtin_amdgcn_readfirstlane(tid >> 6), lane = tid & 63, wr = wid >> 2, wc = wid & 3, fr = lane & 15, fq = lane >> 4;
    const int K = g.K, nt = K / BK;
    unsigned voffA[2], voffB[2];
#pragma unroll
    for (int i = 0; i < 2; ++i) { int R, C; stage_rc(tid * 16 + i * 8192, R, C); const int Rb = Epi::PERM ? ((R & ~31) + perm32(R & 31)) : R;
        voffA[i] = (unsigned)(R * K + C) * 2u; voffB[i] = (unsigned)(Rb * K + C) * 2u; }
    const size_t kstep = (size_t)(BK * 2);
    const size_t hstep = (size_t)HALF * K * 2;
    const size_t tstep = 2 * hstep;
    const unsigned ldsw = (unsigned)wid * 1024u;
    const int aoff = lds_byte(wr * 64 + fr, fq * 8), boff = lds_byte(wc * 32 + fr, fq * 8);
#define PG8_SA(b, h) (((b) * 2 + (h)) * HTB)
#define PG8_SB(b, h) ((4 + (b) * 2 + (h)) * HTB)
#define PG8_STAGE(bufoff, gbase, voff) do { _Pragma("unroll") for (int _i = 0; _i < 2; ++_i) \
        __builtin_amdgcn_global_load_lds((const unsigned*)((const char*)(gbase) + (voff)[_i]), (PG8_LAS unsigned*)(lds + (bufoff) + ldsw + _i * 8192), 16, 0, 0); } while (0)
#define PG8_LDA(dst, b, h) do { _Pragma("unroll") for (int m = 0; m < 4; ++m) _Pragma("unroll") for (int k = 0; k < 2; ++k) dst[m][k] = *(const PG8_LAS bf16x8*)(lds + PG8_SA(b, h) + aoff + m * 2048 + k * 1024); } while (0)
#define PG8_LDB(dst, b, h) do { _Pragma("unroll") for (int n = 0; n < 2; ++n) _Pragma("unroll") for (int k = 0; k < 2; ++k) dst[n][k] = *(const PG8_LAS bf16x8*)(lds + PG8_SB(b, h) + boff + n * 2048 + k * 1024); } while (0)
#define PG8_MMA(ai, bj, At, Bt) do { __builtin_amdgcn_s_setprio(1); _Pragma("unroll") for (int m = 0; m < 4; ++m) _Pragma("unroll") for (int n = 0; n < 2; ++n) _Pragma("unroll") for (int k = 0; k < 2; ++k) \
        acc[ai][bj][m][n] = __builtin_amdgcn_mfma_f32_16x16x32_bf16(Bt[n][k], At[m][k], acc[ai][bj][m][n], 0, 0, 0); __builtin_amdgcn_s_setprio(0); } while (0)
#define PG8_WAIT_V(n) asm volatile("s_waitcnt vmcnt(" #n ")" ::: "memory")
#define PG8_WAIT_L(n) asm volatile("s_waitcnt lgkmcnt(" #n ")" ::: "memory")
#define PG8_BAR __builtin_amdgcn_s_barrier()
#define PG8_SCHED __builtin_amdgcn_sched_barrier(0)
    Unit cur, nxt; int ui = 0;
    if (!S.next(0, cur)) return;
    f32x4 acc[2][2][4][2];
#pragma unroll
    for (int a = 0; a < 2; ++a)
#pragma unroll
        for (int b = 0; b < 2; ++b)
#pragma unroll
            for (int m = 0; m < 4; ++m)
#pragma unroll
                for (int n = 0; n < 2; ++n) acc[a][b][m][n] = (f32x4){0.f, 0.f, 0.f, 0.f};
    bf16x8 At[4][2], B0[2][2], B1[2][2];
    const char* cA = (const char*)g.A + (size_t)cur.pm * tstep; const char* cB = (const char*)g.Bt + (size_t)cur.pn * tstep;
    S.a_ready(cur);
    if constexpr (SP2) {
        PG8_STAGE(PG8_SB(0, 0), cB, voffB); PG8_STAGE(PG8_SB(0, 1), cB + hstep, voffB); PG8_STAGE(PG8_SA(0, 0), cA, voffA); PG8_STAGE(PG8_SA(0, 1), cA + hstep, voffA);
        if (wr == 1) PG8_BAR;
        PG8_WAIT_V(2); PG8_BAR;
        PG8_STAGE(PG8_SB(1, 0), cB + kstep, voffB); PG8_STAGE(PG8_SA(1, 0), cA + kstep, voffA); PG8_STAGE(PG8_SB(1, 1), cB + hstep + kstep, voffB);
        PG8_WAIT_V(6); PG8_BAR;
    } else {
        PG8_STAGE(PG8_SB(0, 0), cB, voffB); PG8_STAGE(PG8_SA(0, 0), cA, voffA); PG8_STAGE(PG8_SB(0, 1), cB + hstep, voffB); PG8_STAGE(PG8_SA(0, 1), cA + hstep, voffA);
        if (wr == 1) PG8_BAR;
        PG8_WAIT_V(4); PG8_BAR;
        PG8_STAGE(PG8_SB(1, 0), cB + kstep, voffB); PG8_STAGE(PG8_SA(1, 0), cA + kstep, voffA); PG8_STAGE(PG8_SB(1, 1), cB + hstep + kstep, voffB);
        PG8_WAIT_V(6); PG8_BAR;
    }
    for (;;) {
        const bool has_next = S.next(ui + 1, nxt);
        const char* nA = has_next ? (const char*)g.A + (size_t)nxt.pm * tstep : cA; const char* nB = has_next ? (const char*)g.Bt + (size_t)nxt.pn * tstep : cB;
        for (int t = 0; t < nt; t += 2) {
            const bool last = (t == nt - 2);
            const char* a1 = cA + (size_t)(t + 1) * kstep;
            const char* a2 = last ? nA : cA + (size_t)(t + 2) * kstep; const char* b2 = last ? nB : cB + (size_t)(t + 2) * kstep;
            const char* a3 = a2 + kstep; const char* b3 = b2 + kstep;
            if (last && has_next) S.a_ready(nxt);
            if constexpr (SP2) {
            PG8_LDB(B0, 0, 0); PG8_LDB(B1, 0, 1); PG8_SCHED; PG8_LDA(At, 0, 0); PG8_STAGE(PG8_SA(1, 1), a1 + hstep, voffA);
            PG8_WAIT_V(8); PG8_WAIT_L(0); PG8_BAR; PG8_MMA(0, 0, At, B0); PG8_MMA(0, 1, At, B1); PG8_BAR; PG8_SCHED;
            PG8_LDA(At, 0, 1); PG8_STAGE(PG8_SB(0, 0), b2, voffB); PG8_STAGE(PG8_SB(0, 1), b2 + hstep, voffB); PG8_STAGE(PG8_SA(0, 0), a2, voffA);
            PG8_WAIT_V(8); PG8_WAIT_L(0); PG8_BAR; PG8_MMA(1, 0, At, B0); PG8_MMA(1, 1, At, B1); PG8_BAR; PG8_SCHED;
            PG8_LDB(B0, 1, 0); PG8_LDB(B1, 1, 1); PG8_SCHED; PG8_LDA(At, 1, 0); PG8_STAGE(PG8_SA(0, 1), a2 + hstep, voffA);
            PG8_WAIT_V(8); PG8_WAIT_L(0); PG8_BAR; PG8_MMA(0, 0, At, B0); PG8_MMA(0, 1, At, B1); PG8_BAR; PG8_SCHED;
            PG8_LDA(At, 1, 1); PG8_STAGE(PG8_SB(1, 0), b3, voffB); PG8_STAGE(PG8_SB(1, 1), b3 + hstep, voffB); PG8_STAGE(PG8_SA(1, 0), a3, voffA);
            PG8_WAIT_V(8); PG8_WAIT_L(0); PG8_BAR; PG8_MMA(1, 0, At, B0); PG8_MMA(1, 1, At, B1); PG8_BAR; PG8_SCHED;
            } else {
            PG8_LDB(B0, 0, 0); PG8_SCHED; PG8_LDA(At, 0, 0); PG8_STAGE(PG8_SA(1, 1), a1 + hstep, voffA);
            PG8_WAIT_L(8); PG8_BAR; PG8_WAIT_L(0); PG8_MMA(0, 0, At, B0); PG8_BAR; PG8_SCHED;
            PG8_LDB(B1, 0, 1); PG8_STAGE(PG8_SB(0, 0), b2, voffB);
            PG8_BAR; PG8_WAIT_L(0); PG8_MMA(0, 1, At, B1); PG8_BAR;
            PG8_LDA(At, 0, 1); PG8_STAGE(PG8_SA(0, 0), a2, voffA);
            PG8_BAR; PG8_WAIT_L(0); PG8_MMA(1, 0, At, B0); PG8_BAR; PG8_SCHED;
            PG8_STAGE(PG8_SB(0, 1), b2 + hstep, voffB);
            PG8_WAIT_V(6); PG8_BAR; PG8_MMA(1, 1, At, B1); PG8_BAR;
            PG8_LDB(B0, 1, 0); PG8_SCHED; PG8_LDA(At, 1, 0); PG8_STAGE(PG8_SA(0, 1), a2 + hstep, voffA);
            PG8_WAIT_L(8); PG8_BAR; PG8_WAIT_L(0); PG8_MMA(0, 0, At, B0); PG8_BAR; PG8_SCHED;
            PG8_LDB(B1, 1, 1); PG8_STAGE(PG8_SB(1, 0), b3, voffB);
            PG8_BAR; PG8_WAIT_L(0); PG8_MMA(0, 1, At, B1); PG8_BAR;
            PG8_LDA(At, 1, 1); PG8_STAGE(PG8_SA(1, 0), a3, voffA);
            PG8_BAR; PG8_WAIT_L(0); PG8_MMA(1, 0, At, B0); PG8_BAR; PG8_SCHED;
            PG8_STAGE(PG8_SB(1, 1), b3 + hstep, voffB);
            PG8_WAIT_V(6); PG8_BAR; PG8_MMA(1, 1, At, B1); PG8_BAR;
            }
        }
        if constexpr (ALIGN_EPI) { if (wr == 0) PG8_BAR; }
        if constexpr (!Epi::AFTER_DRAIN) { E(acc, cur, wr, wc, fr, fq); S.done(cur); }
        if (!has_next) break;
#pragma unroll
        for (int a = 0; a < 2; ++a)
#pragma unroll
            for (int b = 0; b < 2; ++b)
#pragma unroll
                for (int m = 0; m < 4; ++m)
#pragma unroll
                    for (int n = 0; n < 2; ++n) acc[a][b][m][n] = (f32x4){0.f, 0.f, 0.f, 0.f};
        cur = nxt; cA = nA; cB = nB; ++ui;
        if constexpr (ALIGN_EPI) { if (wr == 1) PG8_BAR; }
    }
    PG8_WAIT_V(0);
    if constexpr (!ALIGN_EPI) { if (wr == 0) PG8_BAR; }
    PG8_BAR;
    if constexpr (Epi::AFTER_DRAIN) { E.fused(acc, cur, wr, wc, fr, fq, lds, wid, lane); S.done(cur); }
#undef PG8_SA
#undef PG8_SB
#undef PG8_STAGE
#undef PG8_LDA
#undef PG8_LDB
#undef PG8_MMA
#undef PG8_WAIT_V
#undef PG8_WAIT_L
#undef PG8_BAR
#undef PG8_SCHED
}
}

struct RevOrder {
    pg8::StaticOrder S; int n;
    __device__ bool next(int i, pg8::Unit& u) const { return i < n && S.next(n - 1 - i, u); }
    __device__ __forceinline__ void a_ready(const pg8::Unit&) const {}
    __device__ __forceinline__ void done(const pg8::Unit&) const {}
};

#define LAS __attribute__((address_space(3)))
using pg8::bf16_t; using pg8::bf16x8; using pg8::f32x4; using pg8::u32x4; using pg8::Unit; using pg8::cvt_pk_bf16;
typedef float f32x16 __attribute__((ext_vector_type(16)));
typedef float f32x2 __attribute__((ext_vector_type(2)));
typedef unsigned u32x2 __attribute__((ext_vector_type(2)));

constexpr int NTOK = 65536, DM = 1024, SEQ = 2048, DFF = 2816, NGU = 2 * DFF, ABIN = 2304, CDIN = 2560;
constexpr float EPS = 1e-6f, LOG2E = 1.4426950408889634f;
constexpr size_t MiB = 1u << 20;
constexpr size_t WS_SS = 0;
constexpr size_t WS_ROPE = 7 * MiB;
constexpr size_t WS_BAR = 7 * MiB + 512 * 1024;
constexpr size_t WS_W = 8 * MiB;
constexpr size_t SZ_GU = (size_t)NGU * DM * 2, SZ_DN = (size_t)DM * DFF * 2, SZ_ABIN = (size_t)ABIN * DM * 2, SZ_SQ = (size_t)DM * DM * 2, SZ_CDIN = (size_t)CDIN * DM * 2;
constexpr size_t WS_WGU = WS_W, WS_WDN = WS_WGU + 8 * SZ_GU, WS_WABIN = WS_WDN + 8 * SZ_DN, WS_WABOUT = WS_WABIN + 2 * SZ_ABIN,
                 WS_WCDIN = WS_WABOUT + 2 * SZ_SQ, WS_WCDOUT = WS_WCDIN + 2 * SZ_CDIN, WS_WEND = WS_WCDOUT + 2 * SZ_SQ;
static_assert(WS_WEND <= 176 * MiB, "weights");
constexpr size_t WS_XB = 176 * MiB;
constexpr size_t WS_Y = 304 * MiB;
constexpr size_t WS_ACT = 432 * MiB;
constexpr size_t WS_XLO = 784 * MiB;
constexpr size_t WS_END = 912 * MiB;
constexpr size_t U_QA = 0, U_KA = U_QA + (size_t)NTOK * 512, U_VTA = U_KA + (size_t)NTOK * 128, U_QB = U_VTA + (size_t)NTOK * 128,
                 U_KB = U_QB + (size_t)NTOK * 512, U_VTB = U_KB + (size_t)NTOK * 512;
constexpr size_t U_E = 0, U_P = (size_t)NTOK * 512, U_BC = 2 * (size_t)NTOK * 512;

__device__ __forceinline__ float fast_rcp(float x) { return __builtin_amdgcn_rcpf(x); }
__device__ __forceinline__ float fast_exp2(float x) { return __builtin_amdgcn_exp2f(x); }
#ifdef NO_SS
__device__ __forceinline__ float fast_rsq(float x) { return x > 1e30f ? 0.f : 1.0f; }
#else
__device__ __forceinline__ float fast_rsq(float x) { return __builtin_amdgcn_rsqf(x); }
#endif
typedef unsigned long long ss_t;
constexpr float SS_SCALE = 65536.0f, SS_INV = 1.0f / (65536.0f * 1024.0f);
__device__ __forceinline__ ss_t ss_fix(float q) { return (ss_t)(q * SS_SCALE); }
__device__ __forceinline__ float ss_rstd(ss_t v) { return fast_rsq((float)v * SS_INV + 1e-6f); }
__device__ __forceinline__ float sigmoidf_(float v) { return fast_rcp(1.0f + fast_exp2(-v * LOG2E)); }
__device__ __forceinline__ float siluf_(float v) { return v * sigmoidf_(v); }
__device__ __forceinline__ float bf2f(unsigned short b) { return __uint_as_float(((unsigned)b) << 16); }
__device__ __forceinline__ unsigned short f2bf(float f) { return (unsigned short)(cvt_pk_bf16(f, 0.f) & 0xffffu); }
__device__ __forceinline__ u32x4 pack8(f32x4 a, f32x4 b) { u32x4 w; w.x = cvt_pk_bf16(a[0], a[1]); w.y = cvt_pk_bf16(a[2], a[3]); w.z = cvt_pk_bf16(b[0], b[1]); w.w = cvt_pk_bf16(b[2], b[3]); return w; }

#define EPI_ROW(ai, m) (u.pm * 256 + wr * 64 + fr + (ai) * 128 + (m) * 16)

constexpr int RS_OFF = 131072;
__device__ __forceinline__ void fill_rstd_table(LAS unsigned char* lds, const ss_t* ss, int bx, int wave_s) {
    int tid_; asm volatile("v_mbcnt_lo_u32_b32 %0, -1, 0\n\tv_mbcnt_hi_u32_b32 %0, -1, %0" : "=v"(tid_)); tid_ += wave_s * 64;
    LAS float* tab = (LAS float*)(lds + RS_OFF);
    constexpr int NPAN = 32 / pg8::WGM;
#pragma unroll
    for (int k = 0; k < NPAN / 2; ++k) {
        const int idx = tid_ + 512 * k, j = idx >> 8, rr = idx & 255, pm = pg8::WGM * (NPAN * (bx & 7) + j) + ((bx >> 3) & (pg8::WGM - 1));
        tab[idx] = ss_rstd(ss[pm * 256 + rr]);
    }
    __syncthreads();
}
#define EPI_RS(ai, m) (rs[((u.pm / pg8::WGM) & (32 / pg8::WGM - 1)) * 256 + wr * 64 + fr + (ai) * 128 + (m) * 16])

struct EpiUp {
    static constexpr bool PERM = true, AFTER_DRAIN = false;
    bf16_t* act; const LAS float* rs;
    __device__ __forceinline__ void operator()(const f32x4 (&acc)[2][2][4][2], const Unit& u, int wr, int wc, int fr, int fq) const {
        const unsigned e0 = (unsigned)(u.pm * 256 + wr * 64 + fr) * (unsigned)DFF + (unsigned)(u.pn * 128 + wc * 32 + 8 * fq);
        char* pa = (char*)act;
#pragma unroll
        for (int ai = 0; ai < 2; ++ai)
#pragma unroll
            for (int m = 0; m < 4; ++m) {
                const float r = EPI_RS(ai, m), c1 = -r * LOG2E, r2 = r * r;
                f32x4 h[2];
#pragma unroll
                for (int n = 0; n < 2; ++n) {
                    const f32x4 g = acc[ai][0][m][n], up = acc[ai][1][m][n];
                    const f32x4 ea = g * c1, gu = (g * up) * r2;
                    f32x4 d;
#pragma unroll
                    for (int i = 0; i < 4; ++i) d[i] = fast_exp2(ea[i]);
                    d = d + 1.0f;
#pragma unroll
                    for (int i = 0; i < 4; ++i) d[i] = fast_rcp(d[i]);
                    h[n] = gu * d;
                }
#ifdef ACT_SC1
                { const u32x4 hv = pack8(h[0], h[1]); const char* ap = pa + (size_t)((e0 + (unsigned)((ai * 128 + m * 16) * DFF)) * 2u);
                  asm volatile("global_store_dwordx4 %0, %1, off sc1" :: "v"(ap), "v"(hv) : "memory"); }
#else
                *(u32x4*)(pa + (e0 + (unsigned)((ai * 128 + m * 16) * DFF)) * 2u) = pack8(h[0], h[1]);
#endif
            }
    }
};

__device__ __forceinline__ void unpack8(u32x4 h, u32x4 l, f32x4& a, f32x4& b) {
    a[0] = __uint_as_float(h.x << 16) + __uint_as_float(l.x << 16); a[1] = __uint_as_float(h.x & 0xffff0000u) + __uint_as_float(l.x & 0xffff0000u);
    a[2] = __uint_as_float(h.y << 16) + __uint_as_float(l.y << 16); a[3] = __uint_as_float(h.y & 0xffff0000u) + __uint_as_float(l.y & 0xffff0000u);
    b[0] = __uint_as_float(h.z << 16) + __uint_as_float(l.z << 16); b[1] = __uint_as_float(h.z & 0xffff0000u) + __uint_as_float(l.z & 0xffff0000u);
    b[2] = __uint_as_float(h.w << 16) + __uint_as_float(l.w << 16); b[3] = __uint_as_float(h.w & 0xffff0000u) + __uint_as_float(l.w & 0xffff0000u);
}
__device__ __forceinline__ void split8(f32x4 a, f32x4 b, u32x4& h, u32x4& l) {
    h = pack8(a, b);
    f32x4 ra, rb;
    ra[0] = a[0] - __uint_as_float(h.x << 16); ra[1] = a[1] - __uint_as_float(h.x & 0xffff0000u); ra[2] = a[2] - __uint_as_float(h.y << 16); ra[3] = a[3] - __uint_as_float(h.y & 0xffff0000u);
    rb[0] = b[0] - __uint_as_float(h.z << 16); rb[1] = b[1] - __uint_as_float(h.z & 0xffff0000u); rb[2] = b[2] - __uint_as_float(h.w << 16); rb[3] = b[3] - __uint_as_float(h.w & 0xffff0000u);
    l = pack8(ra, rb);
}
struct EpiRes {
    static constexpr bool PERM = true, AFTER_DRAIN = false;
    bf16_t* xb; ss_t* ss; float alpha;
    __device__ __forceinline__ void operator()(const f32x4 (&acc)[2][2][4][2], const Unit& u, int wr, int wc, int fr, int fq) const {
        const unsigned row0 = (unsigned)(u.pm * 256 + wr * 64 + fr);
        const unsigned e0 = row0 * (unsigned)DM + (unsigned)(u.pn * 256 + wc * 64 + 8 * fq);
        char* ph = (char*)xb;
        u32x4 ch[2], nh[2];
        float qs[8];
#define RES_LOAD(dh, g) do { _Pragma("unroll") for (int bj = 0; bj < 2; ++bj) { const unsigned eo = e0 + (unsigned)((((g) >> 2) * 128 + ((g) & 3) * 16) * DM + bj * 32); \
            dh[bj] = *(const u32x4*)(ph + eo * 2u); } } while (0)
        RES_LOAD(ch, 0);
#pragma unroll
        for (int g = 0; g < 8; ++g) {
            const int ai = g >> 2, m = g & 3;
            if (g < 7) RES_LOAD(nh, g + 1);
            float q = 0.f;
#pragma unroll
            for (int bj = 0; bj < 2; ++bj) {
                const unsigned eo = e0 + (unsigned)((ai * 128 + m * 16) * DM + bj * 32);
                f32x4 x0, x1; unpack8(ch[bj], (u32x4){0u, 0u, 0u, 0u}, x0, x1);
                const f32x4 o0 = x0 + acc[ai][bj][m][0] * alpha, o1 = x1 + acc[ai][bj][m][1] * alpha;
                *(u32x4*)(ph + eo * 2u) = pack8(o0, o1);
                q += (o0[0] * o0[0] + o0[1] * o0[1]) + (o0[2] * o0[2] + o0[3] * o0[3]) + (o1[0] * o1[0] + o1[1] * o1[1]) + (o1[2] * o1[2] + o1[3] * o1[3]);
            }
            q += __shfl_xor(q, 16); q += __shfl_xor(q, 32);
            qs[g] = q;
            asm volatile("" ::: "memory");
#pragma unroll
            for (int bj = 0; bj < 2; ++bj) ch[bj] = nh[bj];
        }
#undef RES_LOAD
        if (fq == 0) {
#pragma unroll
            for (int g = 0; g < 8; ++g) atomicAdd((ss_t*)((char*)ss + (row0 + (unsigned)((g >> 2) * 128 + (g & 3) * 16)) * 8u), ss_fix(qs[g]));
        }
    }
};

struct EpiNull {
    static constexpr bool PERM = true, AFTER_DRAIN = false;
    float* sink;
    __device__ __forceinline__ void operator()(const f32x4 (&acc)[2][2][4][2], const Unit& u, int wr, int wc, int fr, int fq) const {
        float t = 0.f;
#pragma unroll
        for (int ai = 0; ai < 2; ++ai)
#pragma unroll
            for (int bj = 0; bj < 2; ++bj)
#pragma unroll
                for (int m = 0; m < 4; ++m)
#pragma unroll
                    for (int n = 0; n < 2; ++n) t += acc[ai][bj][m][n][0] + acc[ai][bj][m][n][1] + acc[ai][bj][m][n][2] + acc[ai][bj][m][n][3];
        if (t == 1.2345e-30f) sink[0] = t;
    }
};

struct EpiAB {
    static constexpr bool PERM = true, AFTER_DRAIN = false;
    const LAS float* rs; const float* qg; const float* kg; const float* rope; bf16_t* ub;
    __device__ __forceinline__ void operator()(const f32x4 (&acc)[2][2][4][2], const Unit& u, int wr, int wc, int fr, int fq) const {
        const int pn = u.pn;
        int kind, head;
        if (pn < 2) { kind = 0; head = 4 * pn + wc; }
        else if (pn == 2) { if (wc < 2) { kind = 1; head = wc; } else { kind = 2; head = wc - 2; } }
        else if (pn < 5) { kind = 3; head = 4 * (pn - 3) + wc; }
        else if (pn < 7) { kind = 4; head = 4 * (pn - 5) + wc; }
        else { kind = 5; head = 4 * (pn - 7) + wc; }
        if (kind <= 1) {
            const float* g = kind == 0 ? qg : kg;
            f32x4 gv[2][2];
#pragma unroll
            for (int bj = 0; bj < 2; ++bj)
#pragma unroll
                for (int n = 0; n < 2; ++n) gv[bj][n] = *(const f32x4*)(g + 32 * bj + 8 * fq + 4 * n);
            const float osc = kind == 0 ? 0.125f * LOG2E : 1.0f;
            bf16_t* dst = ub + (kind == 0 ? U_QA : U_KA);
            const int ldo = kind == 0 ? 512 : 128;
#pragma unroll
            for (int ai = 0; ai < 2; ++ai)
#pragma unroll
                for (int m = 0; m < 4; ++m) {
                    const int row = EPI_ROW(ai, m);
                    const float r = EPI_RS(ai, m);
                    f32x4 v[2][2]; float q = 0.f;
#pragma unroll
                    for (int bj = 0; bj < 2; ++bj)
#pragma unroll
                        for (int n = 0; n < 2; ++n) { v[bj][n] = acc[ai][bj][m][n] * r; const f32x4 t = v[bj][n]; q += (t[0] * t[0] + t[1] * t[1]) + (t[2] * t[2] + t[3] * t[3]); }
                    q += __shfl_xor(q, 16); q += __shfl_xor(q, 32);
                    const float rn = fast_rsq(q * (1.0f / 64.0f) + EPS) * osc;
                    const int pos = row & (SEQ - 1);
#pragma unroll
                    for (int bj = 0; bj < 2; ++bj) {
                        f32x4 o[2];
#pragma unroll
                        for (int n = 0; n < 2; ++n) {
                            const f32x4 t = v[bj][n] * gv[bj][n] * rn;
                            const f32x4 cs = *(const f32x4*)(rope + ((size_t)pos * 32 + 16 * bj + 4 * fq + 2 * n) * 2);
                            o[n][0] = t[0] * cs[0] - t[1] * cs[1]; o[n][1] = t[0] * cs[1] + t[1] * cs[0];
                            o[n][2] = t[2] * cs[2] - t[3] * cs[3]; o[n][3] = t[2] * cs[3] + t[3] * cs[2];
                        }
                        *(u32x4*)(dst + (size_t)row * ldo + head * 64 + 32 * bj + 8 * fq) = pack8(o[0], o[1]);
                    }
                    asm volatile("" ::: "memory");
                }
        } else if (kind == 3 || kind == 4) {
            const float osc = kind == 3 ? 0.125f * LOG2E : 1.0f;
            bf16_t* dst = ub + (kind == 3 ? U_QB : U_KB);
#pragma unroll
            for (int ai = 0; ai < 2; ++ai)
#pragma unroll
                for (int m = 0; m < 4; ++m) {
                    const int row = EPI_ROW(ai, m);
                    const float r = EPI_RS(ai, m) * osc;
#pragma unroll
                    for (int bj = 0; bj < 2; ++bj)
                        *(u32x4*)(dst + (size_t)row * 512 + head * 64 + 32 * bj + 8 * fq) = pack8(acc[ai][bj][m][0] * r, acc[ai][bj][m][1] * r);
                }
        } else {
            const int nh = kind == 2 ? 2 : 8;
            bf16_t* dst = ub + (kind == 2 ? U_VTA : U_VTB);
#pragma unroll
            for (int ai = 0; ai < 2; ++ai)
#pragma unroll
                for (int m = 0; m < 4; ++m) {
                    const int row = EPI_ROW(ai, m);
                    const float r = EPI_RS(ai, m);
                    const int b = row >> 11, pos = row & (SEQ - 1);
                    bf16_t* base = dst + ((size_t)(b * nh + head) * 64) * SEQ + pos;
#pragma unroll
                    for (int bj = 0; bj < 2; ++bj)
#pragma unroll
                        for (int n = 0; n < 2; ++n) {
                            const f32x4 t = acc[ai][bj][m][n] * r;
                            const unsigned w0 = cvt_pk_bf16(t[0], t[1]), w1 = cvt_pk_bf16(t[2], t[3]);
                            const int d = 32 * bj + 8 * fq + 4 * n;
                            base[(size_t)(d + 0) * SEQ] = (bf16_t)(w0 & 0xffffu); base[(size_t)(d + 1) * SEQ] = (bf16_t)(w0 >> 16);
                            base[(size_t)(d + 2) * SEQ] = (bf16_t)(w1 & 0xffffu); base[(size_t)(d + 3) * SEQ] = (bf16_t)(w1 >> 16);
                        }
                }
        }
    }
};

struct EpiCD {
    static constexpr bool PERM = true, AFTER_DRAIN = false;
    const LAS float* rs; bf16_t* ub;
    __device__ __forceinline__ void operator()(const f32x4 (&acc)[2][2][4][2], const Unit& u, int wr, int wc, int fr, int fq) const {
        const int pn = u.pn;
        const unsigned row0 = (unsigned)(u.pm * 256 + wr * 64 + fr);
        if (pn < 8) {
            char* dst = (char*)(ub + (pn < 4 ? U_E : U_P));
            const unsigned e0 = row0 * 512u + (unsigned)((pn & 3) * 128 + wc * 32 + 8 * fq);
            const bool gate = pn < 4;
#pragma unroll
            for (int ai = 0; ai < 2; ++ai)
#pragma unroll
                for (int m = 0; m < 4; ++m) {
                    const float r = EPI_RS(ai, m);
                    f32x4 h[2];
#pragma unroll
                    for (int n = 0; n < 2; ++n) {
                        const f32x4 a = acc[ai][0][m][n] * r, g = acc[ai][1][m][n] * r;
#pragma unroll
                        for (int i = 0; i < 4; ++i) h[n][i] = a[i] * (gate ? sigmoidf_(g[i]) : g[i]);
                    }
                    *(u32x4*)(dst + (e0 + (unsigned)((ai * 128 + m * 16) * 512)) * 2u) = pack8(h[0], h[1]);
                    asm volatile("" ::: "memory");
                }
        } else {
            char* dst = (char*)(ub + U_BC);
            const unsigned e0 = row0 * 512u + (unsigned)((pn - 8) * 256 + wc * 32 + 8 * fq);
#pragma unroll
            for (int ai = 0; ai < 2; ++ai)
#pragma unroll
                for (int m = 0; m < 4; ++m) {
                    const float r = EPI_RS(ai, m);
#pragma unroll
                    for (int bj = 0; bj < 2; ++bj)
                        *(u32x4*)(dst + (e0 + (unsigned)((ai * 128 + m * 16) * 512 + bj * 128)) * 2u) = pack8(acc[ai][bj][m][0] * r, acc[ai][bj][m][1] * r);
                    asm volatile("" ::: "memory");
                }
        }
    }
};

__device__ __forceinline__ float wave_sum(float v) {
#pragma unroll
    for (int o = 1; o < 64; o <<= 1) v += __shfl_xor(v, o);
    return v;
}
__device__ __forceinline__ void transpose_item(const float* src, int ldw, const float* gain, bf16_t* dst, int K, int k0, LAS float* scr, int lane) {
    float tv[32];
#pragma unroll
    for (int i = 0; i < 32; ++i) { const int kk = 2 * i + (lane >> 5); tv[i] = src[(size_t)(k0 + kk) * ldw + (lane & 31)]; }
#pragma unroll
    for (int i = 0; i < 32; ++i) { const int kk = 2 * i + (lane >> 5); float v = tv[i]; if (gain) v *= gain[k0 + kk]; scr[kk * 33 + (lane & 31)] = v; }
    asm volatile("s_waitcnt lgkmcnt(0)" ::: "memory");
    const int c = lane & 7;
#pragma unroll
    for (int j = 0; j < 4; ++j) { const int n = (lane >> 3) + 8 * j; const LAS float* s = scr + (8 * c) * 33 + n;
        u32x4 o; o.x = cvt_pk_bf16(s[0 * 33], s[1 * 33]); o.y = cvt_pk_bf16(s[2 * 33], s[3 * 33]); o.z = cvt_pk_bf16(s[4 * 33], s[5 * 33]); o.w = cvt_pk_bf16(s[6 * 33], s[7 * 33]);
        *(u32x4*)(dst + (size_t)n * K + k0 + 8 * c) = o; }
    asm volatile("s_waitcnt lgkmcnt(0)" ::: "memory");
}

struct Params {
    const float* in[18];
    float* out; unsigned char* ws;
    int ph_lo, ph_hi;
};
enum { I_X = 0, I_FFN_NORM, I_MIX_NORM, I_WG, I_WU, I_WD, I_ABIN, I_ABOUT, I_QN, I_KN, I_RPB, I_CDIN, I_CDOUT, I_CCW, I_DCW, I_DNG, I_DNB, I_FINAL };

#define RESCOL(nb) (256 * ((nb) >> 3) + 64 * ((nb) & 3) + 32 * (((nb) >> 2) & 1))
__device__ __forceinline__ void prologue_phase(const Params& p, LAS unsigned char* lds, int vcu, int NGW, int wave_s) {
    int tid_; asm volatile("v_mbcnt_lo_u32_b32 %0, -1, 0\n\tv_mbcnt_hi_u32_b32 %0, -1, %0" : "=v"(tid_)); tid_ += wave_s * 64;
    const int lane = tid_ & 63, wave = __builtin_amdgcn_readfirstlane(tid_ >> 6), gw = vcu * 8 + wave;
    unsigned char* ws = p.ws;
    ss_t* ss = (ss_t*)(ws + WS_SS);
    {
        const float* x = p.in[I_X]; bf16_t* xb = (bf16_t*)(ws + WS_XB);
        for (int row0 = gw; row0 < NTOK; row0 += 2 * NGW) {
            f32x4 v[2][4]; float sq[2];
#pragma unroll
            for (int k = 0; k < 2; ++k) { const f32x4* xr = (const f32x4*)(x + (size_t)(row0 + k * NGW) * DM) + lane;
#pragma unroll
                for (int j = 0; j < 4; ++j) v[k][j] = xr[64 * j]; }
#pragma unroll
            for (int k = 0; k < 2; ++k) {
                const int row = row0 + k * NGW; float s = 0.f;
#pragma unroll
                for (int j = 0; j < 4; ++j) s += (v[k][j][0] * v[k][j][0] + v[k][j][1] * v[k][j][1]) + (v[k][j][2] * v[k][j][2] + v[k][j][3] * v[k][j][3]);
                sq[k] = wave_sum(s);
                u32x2* o = (u32x2*)(xb + (size_t)row * DM) + lane;
#pragma unroll
                for (int j = 0; j < 4; ++j) { u32x2 w; w.x = cvt_pk_bf16(v[k][j][0], v[k][j][1]); w.y = cvt_pk_bf16(v[k][j][2], v[k][j][3]); o[64 * j] = w; }
                if (lane == 0) ss[row] = ss_fix(sq[k]);
                if (lane < 12) ss[(size_t)(lane + 1) * NTOK + row] = 0ull;
            }
        }
    }
    {
        float* rope = (float*)(ws + WS_ROPE);
        for (int idx = gw * 64 + lane; idx < SEQ * 32; idx += NGW * 64) {
            const int pos = idx >> 5, pr = idx & 31, j = pr & 15;
            const float coord = pr < 16 ? (float)(pos >> 6) : (float)(pos & 63);
            const float freq = fast_exp2(-(float)(2 * j) * (1.0f / 32.0f) * 13.287712379549449f);
            const float ang = coord * freq;
            float sn, cs; __sincosf(ang, &sn, &cs);
            rope[2 * idx] = cs; rope[2 * idx + 1] = sn;
        }
    }
    {
        LAS float* scr = (LAS float*)(lds + wave * 16384);
        constexpr int IT_GU = 16 * (NGU / 32), IT_DN = (DFF / 64) * 32, IT_ABIN = 16 * (ABIN / 32), IT_SQ = 16 * 32, IT_CDIN = 16 * (CDIN / 32);
        constexpr int IT_FFN = IT_GU + IT_DN, IT_AB = IT_ABIN + IT_SQ, IT_CD = IT_CDIN + IT_SQ;
        constexpr int NITEMS = 8 * IT_FFN + 2 * IT_AB + 2 * IT_CD;
        for (int it = gw; it < NITEMS; it += NGW) {
            int r = it;
            if (r < 8 * IT_FFN) {
                const int f = r / IT_FFN; r -= f * IT_FFN;
                if (r < IT_GU) {
                    const int nb = r % (NGU / 32), kb = r / (NGU / 32);
                    const int pn = nb >> 3, bj = (nb >> 2) & 1, j0 = 32 * (nb & 3);
                    const float* W = (bj ? p.in[I_WU] : p.in[I_WG]) + (size_t)f * DM * DFF + 128 * pn + j0;
                    transpose_item(W, DFF, p.in[I_FFN_NORM] + f * DM, (bf16_t*)(ws + WS_WGU + f * SZ_GU) + (size_t)(32 * nb) * DM, DM, 64 * kb, scr, lane);
                } else {
                    r -= IT_GU; const int nb = r % 32, kb = r / 32;
                    transpose_item(p.in[I_WD] + (size_t)f * DFF * DM + RESCOL(nb), DM, nullptr, (bf16_t*)(ws + WS_WDN + f * SZ_DN) + (size_t)(32 * nb) * DFF, DFF, 64 * kb, scr, lane);
                }
                continue;
            }
            r -= 8 * IT_FFN;
            if (r < 2 * IT_AB) {
                const int e = r / IT_AB; r -= e * IT_AB;
                if (r < IT_ABIN) {
                    const int nb = r % (ABIN / 32), kb = r / (ABIN / 32);
                    const int pn = nb >> 3, bj = (nb >> 2) & 1, wc = nb & 3;
                    transpose_item(p.in[I_ABIN] + (size_t)e * DM * ABIN + 256 * pn + 64 * wc + 32 * bj, ABIN, p.in[I_MIX_NORM] + (2 * e) * DM,
                                   (bf16_t*)(ws + WS_WABIN + e * SZ_ABIN) + (size_t)(32 * nb) * DM, DM, 64 * kb, scr, lane);
                } else {
                    r -= IT_ABIN; const int nb = r % 32, kb = r / 32;
                    transpose_item(p.in[I_ABOUT] + (size_t)e * DM * DM + RESCOL(nb), DM, nullptr, (bf16_t*)(ws + WS_WABOUT + e * SZ_SQ) + (size_t)(32 * nb) * DM, DM, 64 * kb, scr, lane);
                }
                continue;
            }
            r -= 2 * IT_AB;
            {
                const int e = r / IT_CD; r -= e * IT_CD;
                if (r < IT_CDIN) {
                    const int nb = r % (CDIN / 32), kb = r / (CDIN / 32);
                    const int pn = nb >> 3, bj = (nb >> 2) & 1, j0 = 32 * (nb & 3);
                    int scol;
                    if (pn < 4) scol = (bj ? 2048 : 1536) + 128 * pn + j0;
                    else if (pn < 8) scol = (bj ? 0 : 1024) + 128 * (pn - 4) + j0;
                    else scol = 512 + 256 * (pn - 8) + 128 * bj + j0;
                    transpose_item(p.in[I_CDIN] + (size_t)e * DM * CDIN + scol, CDIN, p.in[I_MIX_NORM] + (2 * e + 1) * DM,
                                   (bf16_t*)(ws + WS_WCDIN + e * SZ_CDIN) + (size_t)(32 * nb) * DM, DM, 64 * kb, scr, lane);
                } else {
                    r -= IT_CDIN; const int nb = r % 32, kb = r / 32;
                    transpose_item(p.in[I_CDOUT] + (size_t)e * DM * DM + RESCOL(nb), DM, nullptr, (bf16_t*)(ws + WS_WCDOUT + e * SZ_SQ) + (size_t)(32 * nb) * DM, DM, 64 * kb, scr, lane);
                }
            }
        }
    }
}

__device__ __forceinline__ void attn_global_phase(LAS unsigned char* lds, const bf16_t* Qa, const bf16_t* Ka, const bf16_t* Vta, const float* qg, const float* kg, bf16_t* y, int vcu, int G, int wave_s) {
    constexpr int PITCH = 144, TILEB = 64 * PITCH, BUFB = 2 * TILEB;
    float negCB;
    {
        int l_; asm volatile("v_mbcnt_lo_u32_b32 %0, -1, 0\n\tv_mbcnt_hi_u32_b32 %0, -1, %0" : "=v"(l_));
        float gq = fabsf(qg[l_]), gk = fabsf(kg[l_]);
#pragma unroll
        for (int o = 1; o < 64; o <<= 1) { gq = fmaxf(gq, __shfl_xor(gq, o)); gk = fmaxf(gk, __shfl_xor(gk, o)); }
        negCB = -(64.0f * 0.125f * LOG2E * 1.01f * gq * gk + 0.125f);
    }
    for (int un_ = vcu; un_ < 32 * 8 * 4; un_ += G) {
        const int un = 32 * 8 * 4 - 1 - un_;
        int tid_; asm volatile("v_mbcnt_lo_u32_b32 %0, -1, 0\n\tv_mbcnt_hi_u32_b32 %0, -1, %0" : "=v"(tid_)); tid_ += wave_s * 64;
        const int tid = tid_, lane = tid & 63, wid = __builtin_amdgcn_readfirstlane(tid >> 6), ql = lane & 31, hi = lane >> 5;
        const int srow = tid >> 3, sch = tid & 7;
        const int pik = (ql & 19) | ((ql & 4) << 1) | ((ql & 8) >> 1);
        const int qb = un & 3, h4 = (un >> 2) & 3, kvh = (un >> 4) & 1, b = un >> 5, h = kvh * 4 + h4;
        const int tok0 = b * SEQ + qb * 512 + wid * 64 + ql;
        const bf16_t* qp = Qa + (size_t)tok0 * 512 + h * 64 + hi * 8;
        bf16x8 qf[2][4];
#pragma unroll
        for (int t = 0; t < 2; ++t)
#pragma unroll
            for (int dc = 0; dc < 4; ++dc) qf[t][dc] = *(const bf16x8*)(qp + (size_t)t * 32 * 512 + dc * 16);
        const bf16_t* kg_ = Ka + (size_t)(b * SEQ + srow) * 128 + kvh * 64 + sch * 8;
        const bf16_t* vg_ = Vta + ((size_t)(b * 2 + kvh) * 64 + srow) * SEQ + sch * 8;
        f32x16 o[2][2];
#pragma unroll
        for (int t = 0; t < 2; ++t)
#pragma unroll
            for (int r = 0; r < 16; ++r) { o[t][0][r] = 0.f; o[t][1][r] = 0.f; }
        float lrun[2] = {0.f, 0.f};
        u32x4 kreg = *(const u32x4*)kg_, vreg = *(const u32x4*)vg_;
        __syncthreads();
        *(LAS u32x4*)(lds + srow * PITCH + sch * 16) = kreg; *(LAS u32x4*)(lds + TILEB + srow * PITCH + sch * 16) = vreg;
        __syncthreads();
        for (int kt = 0; kt < SEQ / 64; ++kt) {
            if (kt + 1 < SEQ / 64) { kreg = *(const u32x4*)(kg_ + (size_t)(kt + 1) * 64 * 128); vreg = *(const u32x4*)(vg_ + (kt + 1) * 64); }
            const LAS unsigned char* Kb_ = lds + (kt & 1) * BUFB; const LAS unsigned char* Vb_ = Kb_ + TILEB;
            f32x16 p[2][2];
#pragma unroll
            for (int t = 0; t < 2; ++t)
#pragma unroll
                for (int r = 0; r < 16; ++r) { p[t][0][r] = negCB; p[t][1][r] = negCB; }
#pragma unroll
            for (int dc = 0; dc < 4; ++dc) {
                const bf16x8 a0 = *(const LAS bf16x8*)(Kb_ + pik * PITCH + dc * 32 + hi * 16);
                const bf16x8 a1 = *(const LAS bf16x8*)(Kb_ + (32 + pik) * PITCH + dc * 32 + hi * 16);
#pragma unroll
                for (int t = 0; t < 2; ++t) {
                    p[t][0] = __builtin_amdgcn_mfma_f32_32x32x16_bf16(a0, qf[t][dc], p[t][0], 0, 0, 0);
                    p[t][1] = __builtin_amdgcn_mfma_f32_32x32x16_bf16(a1, qf[t][dc], p[t][1], 0, 0, 0);
                }
            }
            __builtin_amdgcn_sched_barrier(0);
            u32x4 pw[2][2][2];
#pragma unroll
            for (int t = 0; t < 2; ++t) {
                float sum = 0.f;
#pragma unroll
                for (int r = 0; r < 16; ++r) { p[t][0][r] = fast_exp2(p[t][0][r]); p[t][1][r] = fast_exp2(p[t][1][r]); sum += p[t][0][r] + p[t][1][r]; }
                lrun[t] += sum;
#pragma unroll
                for (int kb = 0; kb < 2; ++kb)
#pragma unroll
                    for (int c = 0; c < 2; ++c) {
                        pw[t][kb][c].x = cvt_pk_bf16(p[t][kb][8 * c + 0], p[t][kb][8 * c + 1]); pw[t][kb][c].y = cvt_pk_bf16(p[t][kb][8 * c + 2], p[t][kb][8 * c + 3]);
                        pw[t][kb][c].z = cvt_pk_bf16(p[t][kb][8 * c + 4], p[t][kb][8 * c + 5]); pw[t][kb][c].w = cvt_pk_bf16(p[t][kb][8 * c + 6], p[t][kb][8 * c + 7]);
                    }
            }
            __builtin_amdgcn_sched_barrier(0);
#pragma unroll
            for (int kb = 0; kb < 2; ++kb)
#pragma unroll
                for (int c = 0; c < 2; ++c) {
                    const bf16x8 v0 = *(const LAS bf16x8*)(Vb_ + ql * PITCH + (32 * kb + 16 * c + 8 * hi) * 2);
                    const bf16x8 v1 = *(const LAS bf16x8*)(Vb_ + (32 + ql) * PITCH + (32 * kb + 16 * c + 8 * hi) * 2);
#pragma unroll
                    for (int t = 0; t < 2; ++t) {
                        const bf16x8 pb = __builtin_bit_cast(bf16x8, pw[t][kb][c]);
                        o[t][0] = __builtin_amdgcn_mfma_f32_32x32x16_bf16(v0, pb, o[t][0], 0, 0, 0);
                        o[t][1] = __builtin_amdgcn_mfma_f32_32x32x16_bf16(v1, pb, o[t][1], 0, 0, 0);
                    }
                }
            if (kt + 1 < SEQ / 64) {
                LAS unsigned char* nb = lds + ((kt + 1) & 1) * BUFB;
                *(LAS u32x4*)(nb + srow * PITCH + sch * 16) = kreg; *(LAS u32x4*)(nb + TILEB + srow * PITCH + sch * 16) = vreg;
            }
            __syncthreads();
        }
#pragma unroll
        for (int t = 0; t < 2; ++t) {
            float l = lrun[t]; l += __shfl_xor(l, 32);
            const float inv = fast_rcp(l);
            bf16_t* yp = y + (size_t)(tok0 + 32 * t) * DM + h * 64 + 4 * hi;
#pragma unroll
            for (int g = 0; g < 4; ++g) {
                u32x2 w0, w1;
                w0.x = cvt_pk_bf16(o[t][0][4 * g] * inv, o[t][0][4 * g + 1] * inv); w0.y = cvt_pk_bf16(o[t][0][4 * g + 2] * inv, o[t][0][4 * g + 3] * inv);
                w1.x = cvt_pk_bf16(o[t][1][4 * g] * inv, o[t][1][4 * g + 1] * inv); w1.y = cvt_pk_bf16(o[t][1][4 * g + 2] * inv, o[t][1][4 * g + 3] * inv);
                *(u32x2*)(yp + 8 * g) = w0; *(u32x2*)(yp + 32 + 8 * g) = w1;
            }
        }
    }
}

constexpr int NA_TAB = 0, NA_K = 2048, NA_KP = 144, NA_V = NA_K + 576 * NA_KP, NA_VP = 1168, NA_END = NA_V + 64 * NA_VP;
__device__ __forceinline__ void attn_na_phase(LAS unsigned char* lds, const bf16_t* Qb, const bf16_t* Kb, const bf16_t* Vtb, const float* rpb, bf16_t* y, int vcu, int G, int wave_s) {
    int tid_; asm volatile("v_mbcnt_lo_u32_b32 %0, -1, 0\n\tv_mbcnt_hi_u32_b32 %0, -1, %0" : "=v"(tid_)); tid_ += wave_s * 64;
    const int tid = tid_, lane = tid & 63, wid = __builtin_amdgcn_readfirstlane(tid >> 6), ql = lane & 15, quad = lane >> 4;
    LAS float* tab = (LAS float*)(lds + NA_TAB);
    const int srow = tid >> 3, sch = tid & 7;
    u32x4 kreg[9], vreg[9];
#define NA_FETCH(unx) do { const int rp_ = (unx) & 15, h_ = ((unx) >> 4) & 7, b_ = (unx) >> 7; \
        const int rs0_ = min(max(2 * rp_ - 4, 0), 24), rs1_ = min(max(2 * rp_ - 3, 0), 24), nrows_ = rs1_ + 8 - rs0_; \
        const bf16_t* kg = Kb + (size_t)(b_ * SEQ + rs0_ * 64 + srow) * 512 + h_ * 64 + sch * 8; \
        const bf16_t* vg = Vtb + ((size_t)(b_ * 8 + h_) * 64 + srow) * SEQ + rs0_ * 64 + sch * 8; \
        _Pragma("unroll") for (int i = 0; i < 8; ++i) { kreg[i] = *(const u32x4*)(kg + (size_t)i * 64 * 512); vreg[i] = *(const u32x4*)(vg + i * 64); } \
        if (nrows_ > 8) { kreg[8] = *(const u32x4*)(kg + (size_t)8 * 64 * 512); vreg[8] = *(const u32x4*)(vg + 8 * 64); } \
        else { kreg[8] = (u32x4){0u, 0u, 0u, 0u}; vreg[8] = kreg[8]; } } while (0)
    if (vcu < 32 * 8 * 16) NA_FETCH(32 * 8 * 16 - 1 - vcu);
    for (int un_ = vcu; un_ < 32 * 8 * 16; un_ += G) {
        const int un = 32 * 8 * 16 - 1 - un_;
        const int rp = un & 15, h = (un >> 4) & 7, b = un >> 7;
        const int rs0 = min(max(2 * rp - 4, 0), 24);
        const int r = rp * 2 + (wid >> 2), n = wid & 3;
        const int rs = min(max(r - 4, 0), 24), kcol0 = min(max(16 * n - 8, 0), 32), ro = rs - rs0;
        const int qcol = 16 * n + ql, wcs = min(max(qcol - 8, 0), 48);
        const int tokq = b * SEQ + r * 64 + qcol;
        bf16x8 qf[2];
#pragma unroll
        for (int dc = 0; dc < 2; ++dc) qf[dc] = *(const bf16x8*)(Qb + (size_t)tokq * 512 + h * 64 + 32 * dc + 8 * quad);
        __syncthreads();
        for (int i = tid; i < 465; i += 512) tab[i] = rpb[h * 465 + i] * LOG2E;
#pragma unroll
        for (int i = 0; i < 9; ++i) {
            *(LAS u32x4*)(lds + NA_K + (i * 64 + srow) * NA_KP + sch * 16) = kreg[i];
            *(LAS u32x4*)(lds + NA_V + srow * NA_VP + (i * 64 + sch * 8) * 2) = vreg[i];
        }
        __syncthreads();
        if (un_ + G < 32 * 8 * 16) NA_FETCH(32 * 8 * 16 - 1 - (un_ + G));
        int co[2][4]; bool val[2][4];
#pragma unroll
        for (int ch = 0; ch < 2; ++ch)
#pragma unroll
            for (int i = 0; i < 4; ++i) { const int kc = kcol0 + 16 * ch + 4 * quad + i; val[ch][i] = (kc >= wcs) && (kc < wcs + 16); co[ch][i] = min(max(kc - qcol + 15, 0), 30); }
        const LAS unsigned char* kbase = lds + NA_K + ((ro * 64 + kcol0 + ql) * NA_KP) + quad * 16;
        const LAS unsigned char* vbase = lds + NA_V + ql * NA_VP + (ro * 64 + kcol0 + 4 * quad) * 2;
        f32x4 s[8][2];
        float mx = -1e30f;
#pragma unroll
        for (int w = 0; w < 8; ++w) {
            const int rowoff = (rs + w - r + 7) * 31;
#pragma unroll
            for (int ch = 0; ch < 2; ++ch) {
                const bf16x8 k0 = *(const LAS bf16x8*)(kbase + (w * 64 + 16 * ch) * NA_KP), k1 = *(const LAS bf16x8*)(kbase + (w * 64 + 16 * ch) * NA_KP + 64);
                f32x4 a = {0.f, 0.f, 0.f, 0.f};
                a = __builtin_amdgcn_mfma_f32_16x16x32_bf16(k0, qf[0], a, 0, 0, 0);
                a = __builtin_amdgcn_mfma_f32_16x16x32_bf16(k1, qf[1], a, 0, 0, 0);
#pragma unroll
                for (int i = 0; i < 4; ++i) { const float v = val[ch][i] ? a[i] + tab[rowoff + co[ch][i]] : -1e30f; s[w][ch][i] = v; mx = fmaxf(mx, v); }
            }
        }
        mx = fmaxf(mx, __shfl_xor(mx, 16)); mx = fmaxf(mx, __shfl_xor(mx, 32));
        float l = 0.f;
#pragma unroll
        for (int w = 0; w < 8; ++w)
#pragma unroll
            for (int ch = 0; ch < 2; ++ch)
#pragma unroll
                for (int i = 0; i < 4; ++i) { const float e = fast_exp2(s[w][ch][i] - mx); s[w][ch][i] = e; l += e; }
        l += __shfl_xor(l, 16); l += __shfl_xor(l, 32);
        f32x4 o[4];
#pragma unroll
        for (int dt = 0; dt < 4; ++dt) o[dt] = (f32x4){0.f, 0.f, 0.f, 0.f};
#pragma unroll
        for (int w = 0; w < 8; ++w) {
            const bf16x8 pb = __builtin_bit_cast(bf16x8, pack8(s[w][0], s[w][1]));
#pragma unroll
            for (int dt = 0; dt < 4; ++dt) {
                const u32x2 lo = *(const LAS u32x2*)(vbase + (16 * dt) * NA_VP + w * 128), hi2 = *(const LAS u32x2*)(vbase + (16 * dt) * NA_VP + w * 128 + 32);
                const u32x4 av = {lo.x, lo.y, hi2.x, hi2.y};
                o[dt] = __builtin_amdgcn_mfma_f32_16x16x32_bf16(__builtin_bit_cast(bf16x8, av), pb, o[dt], 0, 0, 0);
            }
        }
        const float inv = fast_rcp(l);
        bf16_t* yp = y + (size_t)tokq * DM + 512 + h * 64 + 4 * quad;
#pragma unroll
        for (int dt = 0; dt < 4; ++dt) { u32x2 w2; w2.x = cvt_pk_bf16(o[dt][0] * inv, o[dt][1] * inv); w2.y = cvt_pk_bf16(o[dt][2] * inv, o[dt][3] * inv); *(u32x2*)(yp + 16 * dt) = w2; }
    }
}

__device__ __forceinline__ float dpp_add(float v, float acc, const int ctrl, const int row_mask) { return acc; }
#define DPP_STEP(v, ctrl, rmask) (v) += __builtin_bit_cast(float, __builtin_amdgcn_update_dpp(0, __builtin_bit_cast(int, (v)), (ctrl), (rmask), 0xf, false))
__device__ __forceinline__ float wave_sum63(float v) {
    DPP_STEP(v, 0xB1, 0xf);
    DPP_STEP(v, 0x4E, 0xf);
    DPP_STEP(v, 0x114, 0xf);
    DPP_STEP(v, 0x118, 0xf);
    DPP_STEP(v, 0x142, 0xa);
    DPP_STEP(v, 0x143, 0xc);
    return v;
}
#undef NA_FETCH
template <int I> __device__ __forceinline__ void conv31_step(f32x2 (&acc)[32], const f32x2 (&wd)[31], const LAS unsigned char* base) {
    const unsigned raw = *(const LAS unsigned*)(base + I * 1024);
    const f32x2 v = {__uint_as_float(raw << 16), __uint_as_float(raw & 0xffff0000u)};
    constexpr int TLO = I - 30 > 0 ? I - 30 : 0, THI = I < 31 ? I : 31;
#pragma unroll
    for (int t = TLO; t <= THI; ++t) acc[t] += v * wd[I - t];
}
template <int... Is> __device__ __forceinline__ void conv31_all(f32x2 (&acc)[32], const f32x2 (&wd)[31], const LAS unsigned char* base, std::integer_sequence<int, Is...>) {
    (conv31_step<Is>(acc, wd, base), ...);
}
__device__ __forceinline__ void cd_core_phase(LAS unsigned char* lds, const bf16_t* E, const bf16_t* P, const bf16_t* Bc, const float* ccw, const float* dcw,
                                              const float* lng, const float* lnb, bf16_t* y, int vcu, int G, int wave_s) {
    constexpr int ROWS = 94, ROWB = 1024, PART_OFF = 96 * ROWB;
    LAS f32x2* part = (LAS f32x2*)(lds + PART_OFF);
    for (int un_ = vcu; un_ < NTOK / 64; un_ += G) {
        const int un = NTOK / 64 - 1 - un_;
        int tid_; asm volatile("v_mbcnt_lo_u32_b32 %0, -1, 0\n\tv_mbcnt_hi_u32_b32 %0, -1, %0" : "=v"(tid_)); tid_ += wave_s * 64;
        const int tid = tid_, lane = tid & 63, wid = __builtin_amdgcn_readfirstlane(tid >> 6), cp = tid & 255, th = tid >> 8, c0 = 2 * cp;
        const int t0 = un * 64, p0 = t0 & (SEQ - 1);
        __syncthreads();
        {
            u32x4 ev[12];
#pragma unroll
            for (int j = 0; j < 12; ++j) {
                const int c = tid + 512 * j, i = c >> 6, cc = c & 63, pos = p0 - 15 + i;
                ev[j] = (u32x4){0u, 0u, 0u, 0u};
                if (i < ROWS && pos >= 0 && pos < SEQ) ev[j] = *(const u32x4*)(E + (size_t)(t0 - 15 + i) * 512 + cc * 8);
            }
#pragma unroll
            for (int j = 0; j < 12; ++j) { const int c = tid + 512 * j, i = c >> 6, cc = c & 63; if (i < ROWS) *(LAS u32x4*)(lds + i * ROWB + cc * 16) = ev[j]; }
        }
        __syncthreads();
        f32x2 acc[32];
        {
            f32x2 wd[31];
#pragma unroll
            for (int k = 0; k < 31; ++k) wd[k] = *(const f32x2*)(dcw + k * 512 + c0);
#pragma unroll
            for (int t = 0; t < 32; ++t) acc[t] = (f32x2){0.f, 0.f};
            conv31_all(acc, wd, lds + (32 * th) * ROWB + cp * 4, std::make_integer_sequence<int, 62>{});
        }
        unsigned pr[34], br[32];
#pragma unroll
        for (int t = 0; t < 32; ++t) asm volatile("" : "+v"(acc[t]));
        {
            const int tokb = t0 + 32 * th, posb = p0 + 32 * th;
#pragma unroll
            for (int j = 0; j < 34; ++j) {
                const int pos = posb - 1 + j; const bool ok = (pos >= 0 && pos < SEQ);
                const unsigned v = *(const unsigned*)(P + (size_t)(ok ? tokb - 1 + j : tokb) * 512 + c0);
                pr[j] = ok ? v : 0u;
            }
#pragma unroll
            for (int j = 0; j < 32; ++j) br[j] = *(const unsigned*)(Bc + (size_t)(tokb + j) * 512 + c0);
        }
#ifdef REP_STATS
        for (int rep = 0; rep < REP_STATS; ++rep)
#endif
#pragma unroll
        for (int t = 0; t < 32; ++t) {
            float s1 = acc[t][0] + acc[t][1], s2 = acc[t][0] * acc[t][0] + acc[t][1] * acc[t][1];
            s1 = wave_sum63(s1); s2 = wave_sum63(s2);
            if (lane == 63) part[(32 * th + t) * 4 + (wid & 3)] = (f32x2){s1, s2};
        }
        __syncthreads();
        const f32x2 w0 = *(const f32x2*)(ccw + c0), w1 = *(const f32x2*)(ccw + 512 + c0), w2 = *(const f32x2*)(ccw + 1024 + c0);
        const f32x2 gg = *(const f32x2*)(lng + c0), bb = *(const f32x2*)(lnb + c0);
#pragma unroll
        for (int t = 0; t < 32; ++t) {
            const int tok = t0 + 32 * th + t;
            const f32x2 a = part[(32 * th + t) * 4 + 0], b2 = part[(32 * th + t) * 4 + 1], c2 = part[(32 * th + t) * 4 + 2], d2 = part[(32 * th + t) * 4 + 3];
            const float mean = ((a[0] + b2[0]) + (c2[0] + d2[0])) * (1.0f / 512.0f);
            const float var = ((a[1] + b2[1]) + (c2[1] + d2[1])) * (1.0f / 512.0f) - mean * mean;
            const float rstd = fast_rsq(fmaxf(var, 0.f) + EPS);
            const float z0 = (acc[t][0] - mean) * rstd * gg[0] + bb[0], z1 = (acc[t][1] - mean) * rstd * gg[1] + bb[1];
            *(unsigned*)(y + (size_t)tok * DM + 512 + c0) = cvt_pk_bf16(siluf_(z0), siluf_(z1));
            const unsigned rm = pr[t], rc = pr[t + 1], rp = pr[t + 2], rb = br[t];
            const float y0 = __uint_as_float(rb << 16) * (__uint_as_float(rm << 16) * w0[0] + __uint_as_float(rc << 16) * w1[0] + __uint_as_float(rp << 16) * w2[0]);
            const float y1 = __uint_as_float(rb & 0xffff0000u) * (__uint_as_float(rm & 0xffff0000u) * w0[1] + __uint_as_float(rc & 0xffff0000u) * w1[1] + __uint_as_float(rp & 0xffff0000u) * w2[1]);
            *(unsigned*)(y + (size_t)tok * DM + c0) = cvt_pk_bf16(y0, y1);
        }
    }
}

__device__ __forceinline__ void final_phase(float* out, const bf16_t* xb, const ss_t* ss, const float* g, int vcu, int NGW, int wave_s) {
    int tid_; asm volatile("v_mbcnt_lo_u32_b32 %0, -1, 0\n\tv_mbcnt_hi_u32_b32 %0, -1, %0" : "=v"(tid_)); tid_ += wave_s * 64;
    const int lane = tid_ & 63, gw = vcu * 8 + __builtin_amdgcn_readfirstlane(tid_ >> 6);
    f32x4 gv[2][2];
#pragma unroll
    for (int j = 0; j < 2; ++j) { gv[j][0] = *(const f32x4*)(g + 512 * j + 8 * lane); gv[j][1] = *(const f32x4*)(g + 512 * j + 8 * lane + 4); }
    for (int row0 = gw; row0 < NTOK; row0 += 2 * NGW) {
        u32x4 xv[2][2]; float r[2];
#pragma unroll
        for (int k = 0; k < 2; ++k) { const int row = row0 + k * NGW; r[k] = ss_rstd(ss[row]);
#pragma unroll
            for (int j = 0; j < 2; ++j) xv[k][j] = *(const u32x4*)(xb + (size_t)row * DM + 512 * j + 8 * lane); }
#pragma unroll
        for (int k = 0; k < 2; ++k)
#pragma unroll
            for (int j = 0; j < 2; ++j) {
                const size_t off = (size_t)(row0 + k * NGW) * DM + 512 * j + 8 * lane;
                f32x4 a, b; unpack8(xv[k][j], (u32x4){0u, 0u, 0u, 0u}, a, b);
                *(f32x4*)(out + off) = a * r[k] * gv[j][0]; *(f32x4*)(out + off + 4) = b * r[k] * gv[j][1];
            }
    }
}

#ifndef GEMM_SP2
#define GEMM_SP2 true
#endif
#ifndef RES_SP2
#define RES_SP2 true
#endif
#ifndef RES_ALIGN
#define RES_ALIGN true
#endif
#ifndef REP_UP
#define REP_UP 1
#endif
#ifndef REP_ABIN
#define REP_ABIN 1
#endif
#ifndef REP_CDIN
#define REP_CDIN 1
#endif
#ifndef REP_AG
#define REP_AG 1
#endif
#ifndef REP_NA
#define REP_NA 1
#endif
#ifndef REP_CDC
#define REP_CDC 1
#endif
#ifndef REP_PRO
#define REP_PRO 1
#endif
#define XB_TMO      128
#define XB_XCNT(j)  (256  + 64 * (j))
#define XB_XSUB(j)  (1280 + 64 * (j))
#define XB_XGEN(j)  (2304 + 64 * (j))
#define XB_TOP      3328
#define XB_TOPGEN   3392
#define XCD_BAR_WORDS 3456
#define XB_SPIN_CAP (1u << 18)

__device__ __forceinline__ unsigned xb_ld(unsigned* p)              { return __hip_atomic_load(p, __ATOMIC_RELAXED, __HIP_MEMORY_SCOPE_AGENT); }
__device__ __forceinline__ unsigned xb_add(unsigned* p, unsigned v) { return __hip_atomic_fetch_add(p, v, __ATOMIC_RELAXED, __HIP_MEMORY_SCOPE_AGENT); }
__device__ __forceinline__ unsigned xb_xcc_id() { return (unsigned)__builtin_amdgcn_s_getreg((3 << 11) | 20) & 0xFu; }
#define XB_SPIN(cond, bar) do { unsigned _sp = 0; while (cond) { __builtin_amdgcn_s_sleep(1); \
    if ((++_sp & 255u) == 0u) { if (xb_ld(&(bar)[XB_TMO])) break; if (_sp > XB_SPIN_CAP) { atomicAdd(&(bar)[XB_TMO], 1u); break; } } } } while (0)

struct XcdBarrier {
    unsigned* bar; unsigned x;
    volatile LAS unsigned* st;
};

__device__ __forceinline__ XcdBarrier xcd_barrier_post(unsigned* bar, volatile LAS unsigned* st) {
    XcdBarrier b; b.bar = bar; b.x = xb_xcc_id(); b.st = st;
    if (threadIdx.x == 0) (void)xb_add(&bar[XB_XCNT(b.x)], 1u);
    return b;
}
__device__ __forceinline__ void xcd_barrier_complete(unsigned* bar, unsigned x, unsigned& nloc, unsigned& nx) {
    const unsigned G = gridDim.x * gridDim.y * gridDim.z;
    unsigned sum, cnt, mine, sp = 0u;
    for (;;) {
        sum = 0u; cnt = 0u; mine = 0u;
#pragma unroll
        for (unsigned j = 0; j < 16; ++j) { const unsigned c = xb_ld(&bar[XB_XCNT(j)]); sum += c; cnt += (c > 0u) ? 1u : 0u; mine = (j == x) ? c : mine; }
        if (sum == G) break;
        __builtin_amdgcn_s_sleep(1);
        if ((++sp & 255u) == 0u) { if (xb_ld(&bar[XB_TMO])) break; if (sp > XB_SPIN_CAP) { atomicAdd(&bar[XB_TMO], 1u); break; } }
    }
    nloc = mine > 0u ? mine : 1u; nx = cnt > 0u ? cnt : 1u;
}

__device__ __forceinline__ void xcd_barrier(const XcdBarrier& b) {
    asm volatile("s_waitcnt vmcnt(0)" ::: "memory");
    __syncthreads();
    if (threadIdx.x == 0) {
        unsigned* bar = b.bar;
        __builtin_amdgcn_s_waitcnt(0);
        unsigned nloc = b.st[0], nx = b.st[1];
        if (nloc == 0u) { xcd_barrier_complete(bar, b.x, nloc, nx); b.st[0] = nloc; b.st[1] = nx; }
        const unsigned old = xb_add(&bar[XB_XSUB(b.x)], 1u);
        const unsigned gen = old / nloc;
        if (old + 1u == (gen + 1u) * nloc) {
            __builtin_amdgcn_fence(__ATOMIC_RELEASE, "agent");
            asm volatile("s_waitcnt vmcnt(0)" ::: "memory");
            const unsigned og = xb_add(&bar[XB_TOP], 1u);
            const unsigned tg = og / nx;
            if (og + 1u == (tg + 1u) * nx) xb_add(&bar[XB_TOPGEN], 1u);
            else XB_SPIN(xb_ld(&bar[XB_TOPGEN]) == tg, bar);
            __builtin_amdgcn_fence(__ATOMIC_ACQUIRE, "agent");
            xb_add(&bar[XB_XGEN(b.x)], 1u);
            asm volatile("s_waitcnt vmcnt(0)" ::: "memory");
        } else {
            XB_SPIN(xb_ld(&bar[XB_XGEN(b.x)]) == gen, bar);
            __builtin_amdgcn_fence(__ATOMIC_ACQUIRE, "agent");
            asm volatile("s_waitcnt vmcnt(0)" ::: "memory");
        }
    }
    __syncthreads();
}

constexpr int LDS_BYTES = 163840;
static_assert(NA_END <= LDS_BYTES - 64, "NA tiles vs LDS");
__global__ void __launch_bounds__(512, 2) mega_fwd(Params p) {
    extern __shared__ __attribute__((aligned(16))) unsigned char lds_raw[];
    LAS unsigned char* lds = (LAS unsigned char*)lds_raw;
    cg::grid_group grid = cg::this_grid();
    const int G = gridDim.x, bx = blockIdx.x;
    const int wave_s = __builtin_amdgcn_readfirstlane((int)threadIdx.x >> 6);
    const int vcu = (G % 8 == 0) ? (bx % 8) * (G / 8) + bx / 8 : bx;
    const int NGW = G * 8;
    unsigned char* ws = p.ws;
    ss_t* ss = (ss_t*)(ws + WS_SS);
    bf16_t* xb = (bf16_t*)(ws + WS_XB); bf16_t* yb = (bf16_t*)(ws + WS_Y); bf16_t* act = (bf16_t*)(ws + WS_ACT);
    const float* rope = (const float*)(ws + WS_ROPE);
    volatile LAS unsigned* bst = (volatile LAS unsigned*)(lds + LDS_BYTES - 64);
    if (threadIdx.x < 2) bst[threadIdx.x] = 0u;
    __syncthreads();
    XcdBarrier xbar = xcd_barrier_post((unsigned*)(ws + WS_BAR), bst);
    int ph = 0;
#define PHASE_BEGIN if (ph >= p.ph_lo && ph < p.ph_hi) {
#define PHASE_END   if (ph + 1 < p.ph_hi) { if (p.ph_lo < 0) { asm volatile("s_waitcnt vmcnt(0)" ::: "memory"); grid.sync(); __builtin_amdgcn_fence(__ATOMIC_ACQUIRE, "agent"); asm volatile("s_waitcnt vmcnt(0)" ::: "memory"); } else xcd_barrier(xbar); } } ++ph;

    PHASE_BEGIN
#ifndef NO_PRO
    for (int rep = 0; rep < REP_PRO; ++rep)
    prologue_phase(p, lds, vcu, NGW, wave_s);
#endif
    PHASE_END

    for (int l = 0; l < 4; ++l) {
        for (int half = 0; half < 2; ++half) {
            const int f = 2 * l + half;
            const ss_t* ssin = ss + (size_t)(3 * l + 2 * half) * NTOK;
            ss_t* ssmid = ss + (size_t)(3 * l + 2 * half + 1) * NTOK;
            PHASE_BEGIN {
                pg8::Gemm g{xb, (const bf16_t*)(ws + WS_WGU + f * SZ_GU), NTOK, NGU, DM}; pg8::StaticOrder S; S.init(NTOK, NGU, G, bx);
                fill_rstd_table(lds, ssin, bx, wave_s);
                EpiUp E{act, (const LAS float*)(lds + RS_OFF)};

#ifndef NO_UP
                for (int rep = 0; rep < REP_UP; ++rep)
                pg8::gemm_phase<EpiUp, pg8::StaticOrder, true, GEMM_SP2>(lds, g, S, E, wave_s);
#endif

            } PHASE_END
            PHASE_BEGIN {
                pg8::Gemm g{act, (const bf16_t*)(ws + WS_WDN + f * SZ_DN), NTOK, DM, DFF}; RevOrder S; S.S.init(NTOK, DM, G, bx); S.n = (NTOK / 256) * (DM / 256) / G;
#ifdef REP_DNULL
                { EpiNull EN{(float*)(ws + WS_ROPE)}; pg8::gemm_phase<EpiNull, pg8::StaticOrder, true, true>(lds, g, S, EN, wave_s); }
#endif
                EpiRes E{xb, ssmid, 0.5f};

#ifndef NO_RES
                pg8::gemm_phase<EpiRes, RevOrder, RES_ALIGN, RES_SP2>(lds, g, S, E, wave_s);
#endif

            } PHASE_END
#ifdef SKIP_MIX
            if (false) {
#else
            if (half == 0) {
#endif
                const int e = l >> 1;
                const ss_t* ssmix = ssmid;
                ss_t* ssout = ss + (size_t)(3 * l + 2) * NTOK;
                if ((l & 1) == 0) {
                    PHASE_BEGIN {
                        pg8::Gemm g{xb, (const bf16_t*)(ws + WS_WABIN + e * SZ_ABIN), NTOK, ABIN, DM}; pg8::StaticOrder S; S.init(NTOK, ABIN, G, bx);
                        fill_rstd_table(lds, ssmix, bx, wave_s);
                        EpiAB E{(const LAS float*)(lds + RS_OFF), p.in[I_QN] + e * 64, p.in[I_KN] + e * 64, rope, act};

#ifndef NO_AB
                for (int rep = 0; rep < REP_ABIN; ++rep)
                pg8::gemm_phase<EpiAB, pg8::StaticOrder, true, GEMM_SP2>(lds, g, S, E, wave_s);
#endif

                    } PHASE_END
                    PHASE_BEGIN {

#ifndef NO_AG
                        for (int rep = 0; rep < REP_AG; ++rep)
                        attn_global_phase(lds, act + U_QA, act + U_KA, act + U_VTA, p.in[I_QN] + e * 64, p.in[I_KN] + e * 64, yb, vcu, G, wave_s);
#endif
#ifndef NO_NA
                        for (int rep = 0; rep < REP_NA; ++rep)
                        attn_na_phase(lds, act + U_QB, act + U_KB, act + U_VTB, p.in[I_RPB] + (size_t)e * 8 * 465, yb, vcu, G, wave_s);
#endif

                    } PHASE_END
                } else {
                    PHASE_BEGIN {
                        pg8::Gemm g{xb, (const bf16_t*)(ws + WS_WCDIN + e * SZ_CDIN), NTOK, CDIN, DM}; pg8::StaticOrder S; S.init(NTOK, CDIN, G, bx);
                        fill_rstd_table(lds, ssmix, bx, wave_s);
                        EpiCD E{(const LAS float*)(lds + RS_OFF), act};

#ifndef NO_CDG
                for (int rep = 0; rep < REP_CDIN; ++rep)
                pg8::gemm_phase<EpiCD, pg8::StaticOrder, true, GEMM_SP2>(lds, g, S, E, wave_s);
#endif

                    } PHASE_END
                    PHASE_BEGIN {

#ifndef NO_CD
                        for (int rep = 0; rep < REP_CDC; ++rep)
                        cd_core_phase(lds, act + U_E, act + U_P, act + U_BC, p.in[I_CCW] + (size_t)e * 3 * 512, p.in[I_DCW] + (size_t)e * 31 * 512,
                                      p.in[I_DNG] + e * 512, p.in[I_DNB] + e * 512, yb, vcu, G, wave_s);
#endif

                    } PHASE_END
                }
                PHASE_BEGIN {
                    const size_t woff = (l & 1) ? (WS_WCDOUT + e * SZ_SQ) : (WS_WABOUT + e * SZ_SQ);
                    pg8::Gemm g{yb, (const bf16_t*)(ws + woff), NTOK, DM, DM}; RevOrder S; S.S.init(NTOK, DM, G, bx); S.n = (NTOK / 256) * (DM / 256) / G;
#ifdef REP_OUTFAKE
                    { EpiRes EF{xb, ss + (size_t)13 * NTOK, 1.0f}; pg8::gemm_phase<EpiRes, RevOrder, true, true>(lds, g, S, EF, wave_s); }
#endif
                    EpiRes E{xb, ssout, 1.0f};

#ifndef NO_RES
                pg8::gemm_phase<EpiRes, RevOrder, RES_ALIGN, RES_SP2>(lds, g, S, E, wave_s);
#endif

                } PHASE_END
            }
        }
    }
#ifdef REP_SYNC
    for (int rep = 0; rep < REP_SYNC; ++rep) xcd_barrier(xbar);
#endif
    PHASE_BEGIN final_phase(p.out, xb, ss + (size_t)12 * NTOK, p.in[I_FINAL], vcu, NGW, wave_s); PHASE_END
#undef PHASE_BEGIN
#undef PHASE_END
}

extern "C" void kernel_launch(void* const* d_in, const int* in_sizes, int n_in, void* d_out, int out_size, void* d_ws, size_t ws_size, hipStream_t stream) {
    static int grid = 0;
    if (grid == 0) {
        if (n_in != 18 || in_sizes[0] != NTOK * DM || out_size != NTOK * DM || ws_size < WS_END) {
            fprintf(stderr, "kernel_launch: unexpected shapes (n_in %d, in0 %d, out %d, ws %zu); nothing launched\n", n_in, n_in > 0 ? in_sizes[0] : -1, out_size, ws_size); grid = -1; return; }
        int dev = 0, cus = 0, per_cu = 0;
        hipGetDevice(&dev);
        hipDeviceGetAttribute(&cus, hipDeviceAttributeMultiprocessorCount, dev);
        hipFuncSetAttribute((const void*)mega_fwd, hipFuncAttributeMaxDynamicSharedMemorySize, LDS_BYTES);
        hipOccupancyMaxActiveBlocksPerMultiprocessor(&per_cu, (const void*)mega_fwd, 512, LDS_BYTES);
        if (per_cu < 1) per_cu = 1;
        grid = cus * (per_cu > 1 ? 1 : per_cu);
        if (grid != 256) { fprintf(stderr, "kernel_launch: built for a 256-CU device (got %d workgroups); nothing launched\n", grid); grid = -1; return; }
        (void)hipGetLastError();
    }
    if (grid < 0) return;
    Params p{};
    for (int i = 0; i < 18; ++i) p.in[i] = (const float*)d_in[i];
    p.out = (float*)d_out; p.ws = (unsigned char*)d_ws; p.ph_lo = 0; p.ph_hi = 1000;
    if (hipMemsetAsync((char*)d_ws + WS_BAR, 0, 16384, stream) != hipSuccess) { fprintf(stderr, "kernel_launch: memset of the barrier words failed\n"); return; }
    void* args[] = {&p};
    hipError_t e = hipLaunchCooperativeKernel((const void*)mega_fwd, dim3(grid), dim3(512), args, LDS_BYTES, stream);
    if (e != hipSuccess) fprintf(stderr, "cooperative launch failed: %s (grid %d)\n", hipGetErrorString(e), grid);
}
```

```cpp
#include <hip/hip_runtime.h>
#include <hip/hip_cooperative_groups.h>
#include <cstdio>
#include <cstdint>
#include <utility>
namespace cg = cooperative_groups;
#ifndef PG8_WGM
#define PG8_WGM 8
#endif
namespace pg8 {
#define PG8_LAS __attribute__((address_space(3)))
typedef unsigned short bf16_t;
typedef short bf16x8 __attribute__((ext_vector_type(8)));
typedef float f32x4 __attribute__((ext_vector_type(4)));
typedef unsigned u32x4 __attribute__((ext_vector_type(4)));
constexpr int BM = 256, BK = 64, HALF = 128, HTB = HALF * BK * 2  , STAGE_BYTES = 8 * HTB, NXCD = 8, WGM = PG8_WGM;

__host__ __device__ __forceinline__ int lds_byte(int r, int c) { const int st = (r >> 4) * 2 + (c >> 5), rr = r & 15, cc = c & 31, ob = rr * 64 + cc * 2; return st * 1024 + (ob ^ (((ob >> 9) & 1) << 5)); }
__host__ __device__ __forceinline__ void stage_rc(int b, int& R, int& C) { const int st = b / 1024, sb = b % 1024, swz = sb ^ (((sb >> 9) & 1) << 5); R = (st >> 1) * 16 + swz / 64; C = (st & 1) * 32 + (swz % 64) / 2; }
__host__ __device__ __forceinline__ int perm32(int rho) { const int n = rho >> 4, i = rho & 15; return 8 * (i >> 2) + 4 * n + (i & 3); }

struct Unit { int pm, pn; };
struct Gemm { const bf16_t* A; const bf16_t* Bt; int M, N, K; };

struct StaticOrder {
    int nM, nN, nwg, G, c;
    __host__ __device__ void init(int M, int N, int G_, int c_) { nM = M / BM; nN = N / BM; nwg = nM * nN; G = G_; c = c_; }
    __host__ __device__ bool next(int i, Unit& u) const {
        const long L = (long)i * G + c; if (L >= nwg) return false;
        int wgid = (int)L; { const int q = nwg / NXCD, r = nwg % NXCD, xcd = wgid % NXCD, off = wgid / NXCD; wgid = (xcd < r ? xcd * (q + 1) : r * (q + 1) + (xcd - r) * q) + off; }
        const int nig = WGM * nN, gid = wgid / nig, fm = gid * WGM, gsz = (nM - fm) < WGM ? (nM - fm) : WGM;
        u.pm = fm + ((wgid % nig) % gsz); u.pn = (wgid % nig) / gsz; return true;
    }
    __device__ __forceinline__ void a_ready(const Unit&) const {}
    __device__ __forceinline__ void done(const Unit&) const {}
};

__device__ __forceinline__ unsigned cvt_pk_bf16(float lo, float hi) { unsigned r; asm volatile("v_cvt_pk_bf16_f32 %0, %1, %2" : "=v"(r) : "v"(lo), "v"(hi)); return r; }
typedef float f32x2 __attribute__((ext_vector_type(2)));
template <class Epi, class Sched, bool ALIGN_EPI = false, bool SP2 = false>
__device__ __forceinline__ void gemm_phase(PG8_LAS unsigned char* lds, const Gemm g, const Sched& S, const Epi& E, int wave_s) {
    int tid_; asm volatile("v_mbcnt_lo_u32_b32 %0, -1, 0\n\tv_mbcnt_hi_u32_b32 %0, -1, %0" : "=v"(tid_)); tid_ += wave_s * 64;
    const int tid = tid_, wid = __builtin_amdgcn_readfirstlane(tid >> 6), lane = tid & 63, wr = wid >> 2, wc = wid & 3, fr = lane & 15, fq = lane >> 4;
    const int K = g.K, nt = K / BK;
    unsigned voffA[2], voffB[2];
#pragma unroll
    for (int i = 0; i < 2; ++i) { int R, C; stage_rc(tid * 16 + i * 8192, R, C); const int Rb = Epi::PERM ? ((R & ~31) + perm32(R & 31)) : R;
        voffA[i] = (unsigned)(R * K + C) * 2u; voffB[i] = (unsigned)(Rb * K + C) * 2u; }
    const size_t kstep = (size_t)(BK * 2);
    const size_t hstep = (size_t)HALF * K * 2;
    const size_t tstep = 2 * hstep;
    const unsigned ldsw = (unsigned)wid * 1024u;
    const int aoff = lds_byte(wr * 64 + fr, fq * 8), boff = lds_byte(wc * 32 + fr, fq * 8);
#define PG8_SA(b, h) (((b) * 2 + (h)) * HTB)
#define PG8_SB(b, h) ((4 + (b) * 2 + (h)) * HTB)
#define PG8_STAGE(bufoff, gbase, voff) do { _Pragma("unroll") for (int _i = 0; _i < 2; ++_i) \
        __builtin_amdgcn_global_load_lds((const unsigned*)((const char*)(gbase) + (voff)[_i]), (PG8_LAS unsigned*)(lds + (bufoff) + ldsw + _i * 8192), 16, 0, 0); } while (0)
#define PG8_LDA(dst, b, h) do { _Pragma("unroll") for (int m = 0; m < 4; ++m) _Pragma("unroll") for (int k = 0; k < 2; ++k) dst[m][k] = *(const PG8_LAS bf16x8*)(lds + PG8_SA(b, h) + aoff + m * 2048 + k * 1024); } while (0)
#define PG8_LDB(dst, b, h) do { _Pragma("unroll") for (int n = 0; n < 2; ++n) _Pragma("unroll") for (int k = 0; k < 2; ++k) dst[n][k] = *(const PG8_LAS bf16x8*)(lds + PG8_SB(b, h) + boff + n * 2048 + k * 1024); } while (0)
#define PG8_MMA(ai, bj, At, Bt) do { __builtin_amdgcn_s_setprio(1); _Pragma("unroll") for (int m = 0; m < 4; ++m) _Pragma("unroll") for (int n = 0; n < 2; ++n) _Pragma("unroll") for (int k = 0; k < 2; ++k) \
        acc[ai][bj][m][n] = __builtin_amdgcn_mfma_f32_16x16x32_bf16(Bt[n][k], At[m][k], acc[ai][bj][m][n], 0, 0, 0); __builtin_amdgcn_s_setprio(0); } while (0)
#define PG8_WAIT_V(n) asm volatile("s_waitcnt vmcnt(" #n ")" ::: "memory")
#define PG8_WAIT_L(n) asm volatile("s_waitcnt lgkmcnt(" #n ")" ::: "memory")
#define PG8_BAR __builtin_amdgcn_s_barrier()
#define PG8_SCHED __builtin_amdgcn_sched_barrier(0)
    Unit cur, nxt; int ui = 0;
    if (!S.next(0, cur)) return;
    f32x4 acc[2][2][4][2];
#pragma unroll
    for (int a = 0; a < 2; ++a)
#pragma unroll
        for (int b = 0; b < 2; ++b)
#pragma unroll
            for (int m = 0; m < 4; ++m)
#pragma unroll
                for (int n = 0; n < 2; ++n) acc[a][b][m][n] = (f32x4){0.f, 0.f, 0.f, 0.f};
    bf16x8 At[4][2], B0[2][2], B1[2][2];
    const char* cA = (const char*)g.A + (size_t)cur.pm * tstep; const char* cB = (const char*)g.Bt + (size_t)cur.pn * tstep;
    S.a_ready(cur);
    if constexpr (SP2) {
        PG8_STAGE(PG8_SB(0, 0), cB, voffB); PG8_STAGE(PG8_SB(0, 1), cB + hstep, voffB); PG8_STAGE(PG8_SA(0, 0), cA, voffA); PG8_STAGE(PG8_SA(0, 1), cA + hstep, voffA);
        if (wr == 1) PG8_BAR;
        PG8_WAIT_V(2); PG8_BAR;
        PG8_STAGE(PG8_SB(1, 0), cB + kstep, voffB); PG8_STAGE(PG8_SA(1, 0), cA + kstep, voffA); PG8_STAGE(PG8_SB(1, 1), cB + hstep + kstep, voffB);
        PG8_WAIT_V(6); PG8_BAR;
    } else {
        PG8_STAGE(PG8_SB(0, 0), cB, voffB); PG8_STAGE(PG8_SA(0, 0), cA, voffA); PG8_STAGE(PG8_SB(0, 1), cB + hstep, voffB); PG8_STAGE(PG8_SA(0, 1), cA + hstep, voffA);
        if (wr == 1) PG8_BAR;
        PG8_WAIT_V(4); PG8_BAR;
        PG8_STAGE(PG8_SB(1, 0), cB + kstep, voffB); PG8_STAGE(PG8_SA(1, 0), cA + kstep, voffA); PG8_STAGE(PG8_SB(1, 1), cB + hstep + kstep, voffB);
        PG8_WAIT_V(6); PG8_BAR;
    }
    for (;;) {
        const bool has_next = S.next(ui + 1, nxt);
        const char* nA = has_next ? (const char*)g.A + (size_t)nxt.pm * tstep : cA; const char* nB = has_next ? (const char*)g.Bt + (size_t)nxt.pn * tstep : cB;
        for (int t = 0; t < nt; t += 2) {
            const bool last = (t == nt - 2);
            const char* a1 = cA + (size_t)(t + 1) * kstep;
            const char* a2 = last ? nA : cA + (size_t)(t + 2) * kstep; const char* b2 = last ? nB : cB + (size_t)(t + 2) * kstep;
            const char* a3 = a2 + kstep; const char* b3 = b2 + kstep;
            if (last && has_next) S.a_ready(nxt);
            if constexpr (SP2) {
            PG8_LDB(B0, 0, 0); PG8_LDB(B1, 0, 1); PG8_SCHED; PG8_LDA(At, 0, 0); PG8_STAGE(PG8_SA(1, 1), a1 + hstep, voffA);
            PG8_WAIT_V(8); PG8_WAIT_L(0); PG8_BAR; PG8_MMA(0, 0, At, B0); PG8_MMA(0, 1, At, B1); PG8_BAR; PG8_SCHED;
            PG8_LDA(At, 0, 1); PG8_STAGE(PG8_SB(0, 0), b2, voffB); PG8_STAGE(PG8_SB(0, 1), b2 + hstep, voffB); PG8_STAGE(PG8_SA(0, 0), a2, voffA);
            PG8_WAIT_V(8); PG8_WAIT_L(0); PG8_BAR; PG8_MMA(1, 0, At, B0); PG8_MMA(1, 1, At, B1); PG8_BAR; PG8_SCHED;
            PG8_LDB(B0, 1, 0); PG8_LDB(B1, 1, 1); PG8_SCHED; PG8_LDA(At, 1, 0); PG8_STAGE(PG8_SA(0, 1), a2 + hstep, voffA);
            PG8_WAIT_V(8); PG8_WAIT_L(0); PG8_BAR; PG8_MMA(0, 0, At, B0); PG8_MMA(0, 1, At, B1); PG8_BAR; PG8_SCHED;
            PG8_LDA(At, 1, 1); PG8_STAGE(PG8_SB(1, 0), b3, voffB); PG8_STAGE(PG8_SB(1, 1), b3 + hstep, voffB); PG8_STAGE(PG8_SA(1, 0), a3, voffA);
            PG8_WAIT_V(8); PG8_WAIT_L(0); PG8_BAR; PG8_MMA(1, 0, At, B0); PG8_MMA(1, 1, At, B1); PG8_BAR; PG8_SCHED;
            } else {
            PG8_LDB(B0, 0, 0); PG8_SCHED; PG8_LDA(At, 0, 0); PG8_STAGE(PG8_SA(1, 1), a1 + hstep, voffA);
            PG8_WAIT_L(8); PG8_BAR; PG8_WAIT_L(0); PG8_MMA(0, 0, At, B0); PG8_BAR; PG8_SCHED;
            PG8_LDB(B1, 0, 1); PG8_STAGE(PG8_SB(0, 0), b2, voffB);
            PG8_BAR; PG8_WAIT_L(0); PG8_MMA(0, 1, At, B1); PG8_BAR;
            PG8_LDA(At, 0, 1); PG8_STAGE(PG8_SA(0, 0), a2, voffA);
            PG8_BAR; PG8_WAIT_L(0); PG8_MMA(1, 0, At, B0); PG8_BAR; PG8_SCHED;
            PG8_STAGE(PG8_SB(0, 1), b2 + hstep, voffB);
            PG8_WAIT_V(6); PG8_BAR; PG8_MMA(1, 1, At, B1); PG8_BAR;
            PG8_LDB(B0, 1, 0); PG8_SCHED; PG8_LDA(At, 1, 0); PG8_STAGE(PG8_SA(0, 1), a2 + hstep, voffA);
            PG8_WAIT_L(8); PG8_BAR; PG8_WAIT_L(0); PG8_MMA(0, 0, At, B0); PG8_BAR; PG8_SCHED;
            PG8_LDB(B1, 1, 1); PG8_STAGE(PG8_SB(1, 0), b3, voffB);
            PG8_BAR; PG8_WAIT_L(0); PG8_MMA(0, 1, At, B1); PG8_BAR;
            PG8_LDA(At, 1, 1); PG8_STAGE(PG8_SA(1, 0), a3, voffA);
            PG8_BAR; PG8_WAIT_L(0); PG8_MMA(1, 0, At, B0); PG8_BAR; PG8_SCHED;
            PG8_STAGE(PG8_SB(1, 1), b3 + hstep, voffB);
            PG8_WAIT_V(6); PG8_BAR; PG8_MMA(1, 1, At, B1); PG8_BAR;
            }
        }
        if constexpr (ALIGN_EPI) { if (wr == 0) PG8_BAR; }
        if constexpr (!Epi::AFTER_DRAIN) { E(acc, cur, wr, wc, fr, fq); S.done(cur); }
        if (!has_next) break;
#pragma unroll
        for (int a = 0; a < 2; ++a)
#pragma unroll
            for (int b = 0; b < 2; ++b)
#pragma unroll
                for (int m = 0; m < 4; ++m)
#pragma unroll
                    for (int n = 0; n < 2; ++n) acc[a][b][m][n] = (f32x4){0.f, 0.f, 0.f, 0.f};
        cur = nxt; cA = nA; cB = nB; ++ui;
        if constexpr (ALIGN_EPI) { if (wr == 1) PG8_BAR; }
    }
    PG8_WAIT_V(0);
    if constexpr (!ALIGN_EPI) { if (wr == 0) PG8_BAR; }
    PG8_BAR;
    if constexpr (Epi::AFTER_DRAIN) { E.fused(acc, cur, wr, wc, fr, fq, lds, wid, lane); S.done(cur); }
#undef PG8_SA
#undef PG8_SB
#undef PG8_STAGE
#undef PG8_LDA
#undef PG8_LDB
#undef PG8_MMA
#undef PG8_WAIT_V
#undef PG8_WAIT_L
#undef PG8_BAR
#undef PG8_SCHED
}
}

struct RevOrder {
    pg8::StaticOrder S; int n;
    __device__ bool next(int i, pg8::Unit& u) const { return i < n && S.next(n - 1 - i, u); }
    __device__ __forceinline__ void a_ready(const pg8::Unit&) const {}
    __device__ __forceinline__ void done(const pg8::Unit&) const {}
};

#define LAS __attribute__((address_space(3)))
using pg8::bf16_t; using pg8::bf16x8; using pg8::f32x4; using pg8::u32x4; using pg8::Unit; using pg8::cvt_pk_bf16;
typedef float f32x16 __attribute__((ext_vector_type(16)));
typedef float f32x2 __attribute__((ext_vector_type(2)));
typedef unsigned u32x2 __attribute__((ext_vector_type(2)));

constexpr int NTOK = 65536, DM = 1024, SEQ = 2048, DFF = 2816, NGU = 2 * DFF, ABIN = 2304, CDIN = 2560;
constexpr float EPS = 1e-6f, LOG2E = 1.4426950408889634f;
constexpr size_t MiB = 1u << 20;
constexpr size_t WS_SS = 784 * MiB;
constexpr size_t WS_ROPE = 7 * MiB;
constexpr size_t WS_BAR = 7 * MiB + 512 * 1024;
constexpr size_t WS_W = 8 * MiB;
constexpr size_t SZ_GU = (size_t)NGU * DM * 2, SZ_DN = (size_t)DM * DFF * 2, SZ_ABIN = (size_t)ABIN * DM * 2, SZ_SQ = (size_t)DM * DM * 2, SZ_CDIN = (size_t)CDIN * DM * 2;
constexpr size_t WS_WGU = WS_W, WS_WDN = WS_WGU + 8 * SZ_GU, WS_WABIN = WS_WDN + 8 * SZ_DN, WS_WABOUT = WS_WABIN + 2 * SZ_ABIN,
                 WS_WCDIN = WS_WABOUT + 2 * SZ_SQ, WS_WCDOUT = WS_WCDIN + 2 * SZ_CDIN, WS_WEND = WS_WCDOUT + 2 * SZ_SQ;
static_assert(WS_WEND <= 176 * MiB, "weights");
constexpr size_t WS_XB = 176 * MiB;
constexpr size_t WS_Y = 304 * MiB;
constexpr size_t WS_ACT = 432 * MiB;
constexpr size_t WS_XLO = 784 * MiB;
constexpr size_t WS_END = 912 * MiB;
constexpr size_t U_QA = 0, U_KA = U_QA + (size_t)NTOK * 512, U_VTA = U_KA + (size_t)NTOK * 128, U_QB = U_VTA + (size_t)NTOK * 128,
                 U_KB = U_QB + (size_t)NTOK * 512, U_VTB = U_KB + (size_t)NTOK * 512;
constexpr size_t U_E = 0, U_P = (size_t)NTOK * 512, U_BC = 2 * (size_t)NTOK * 512;

__device__ __forceinline__ float fast_rcp(float x) { return __builtin_amdgcn_rcpf(x); }
__device__ __forceinline__ float fast_exp2(float x) { return __builtin_amdgcn_exp2f(x); }
#ifdef NO_SS
__device__ __forceinline__ float fast_rsq(float x) { return x > 1e30f ? 0.f : 1.0f; }
#else
__device__ __forceinline__ float fast_rsq(float x) { return __builtin_amdgcn_rsqf(x); }
#endif
typedef float ss_t;
constexpr float SS_SCALE = 65536.0f, SS_INV = 1.0f / (65536.0f * 1024.0f);
__device__ __forceinline__ ss_t ss_fix(float q) { return (ss_t)(q * SS_SCALE); }
__device__ __forceinline__ float ss_rstd(const ss_t* rowp) {
    const f32x4 a = *(const f32x4*)rowp, b = *(const f32x4*)(rowp + 4), c = *(const f32x4*)(rowp + 8), d = *(const f32x4*)(rowp + 12);
    const f32x4 t = (a + b) + (c + d);
    return fast_rsq(((t[0] + t[1]) + (t[2] + t[3])) * (1.0f / DM) + 1e-6f);
}
__device__ __forceinline__ float sigmoidf_(float v) { return fast_rcp(1.0f + fast_exp2(-v * LOG2E)); }
__device__ __forceinline__ float siluf_(float v) { return v * sigmoidf_(v); }
__device__ __forceinline__ float bf2f(unsigned short b) { return __uint_as_float(((unsigned)b) << 16); }
__device__ __forceinline__ unsigned short f2bf(float f) { return (unsigned short)(cvt_pk_bf16(f, 0.f) & 0xffffu); }
__device__ __forceinline__ u32x4 pack8(f32x4 a, f32x4 b) { u32x4 w; w.x = cvt_pk_bf16(a[0], a[1]); w.y = cvt_pk_bf16(a[2], a[3]); w.z = cvt_pk_bf16(b[0], b[1]); w.w = cvt_pk_bf16(b[2], b[3]); return w; }

#define EPI_ROW(ai, m) (u.pm * 256 + wr * 64 + fr + (ai) * 128 + (m) * 16)

constexpr int RS_OFF = 131072;
__device__ __forceinline__ void fill_rstd_table(LAS unsigned char* lds, const ss_t* ss, int bx, int wave_s) {
    int tid_; asm volatile("v_mbcnt_lo_u32_b32 %0, -1, 0\n\tv_mbcnt_hi_u32_b32 %0, -1, %0" : "=v"(tid_)); tid_ += wave_s * 64;
    LAS float* tab = (LAS float*)(lds + RS_OFF);
    constexpr int NPAN = 32 / pg8::WGM;
#pragma unroll
    for (int k = 0; k < NPAN / 2; ++k) {
        const int idx = tid_ + 512 * k, j = idx >> 8, rr = idx & 255, pm = pg8::WGM * (NPAN * (bx & 7) + j) + ((bx >> 3) & (pg8::WGM - 1));
        tab[idx] = ss_rstd(ss + (size_t)(pm * 256 + rr) * 16);
    }
    __syncthreads();
}
#define EPI_RS(ai, m) (rs[((u.pm / pg8::WGM) & (32 / pg8::WGM - 1)) * 256 + wr * 64 + fr + (ai) * 128 + (m) * 16])

struct EpiUp {
    static constexpr bool PERM = true, AFTER_DRAIN = false;
    bf16_t* act; const LAS float* rs;
    __device__ __forceinline__ void operator()(const f32x4 (&acc)[2][2][4][2], const Unit& u, int wr, int wc, int fr, int fq) const {
        const unsigned e0 = (unsigned)(u.pm * 256 + wr * 64 + fr) * (unsigned)DFF + (unsigned)(u.pn * 128 + wc * 32 + 8 * fq);
        char* pa = (char*)act;
#pragma unroll
        for (int ai = 0; ai < 2; ++ai)
#pragma unroll
            for (int m = 0; m < 4; ++m) {
                const float r = EPI_RS(ai, m), c1 = -r * LOG2E, r2 = r * r;
                f32x4 h[2];
#pragma unroll
                for (int n = 0; n < 2; ++n) {
                    const f32x4 g = acc[ai][0][m][n], up = acc[ai][1][m][n];
                    const f32x4 ea = g * c1, gu = (g * up) * r2;
                    f32x4 d;
#pragma unroll
                    for (int i = 0; i < 4; ++i) d[i] = fast_exp2(ea[i]);
                    d = d + 1.0f;
#pragma unroll
                    for (int i = 0; i < 4; ++i) d[i] = fast_rcp(d[i]);
                    h[n] = gu * d;
                }
#ifdef ACT_SC1
                { const u32x4 hv = pack8(h[0], h[1]); const char* ap = pa + (size_t)((e0 + (unsigned)((ai * 128 + m * 16) * DFF)) * 2u);
                  asm volatile("global_store_dwordx4 %0, %1, off sc1" :: "v"(ap), "v"(hv) : "memory"); }
#else
                *(u32x4*)(pa + (e0 + (unsigned)((ai * 128 + m * 16) * DFF)) * 2u) = pack8(h[0], h[1]);
#endif
            }
    }
};

__device__ __forceinline__ void unpack8(u32x4 h, u32x4 l, f32x4& a, f32x4& b) {
    a[0] = __uint_as_float(h.x << 16) + __uint_as_float(l.x << 16); a[1] = __uint_as_float(h.x & 0xffff0000u) + __uint_as_float(l.x & 0xffff0000u);
    a[2] = __uint_as_float(h.y << 16) + __uint_as_float(l.y << 16); a[3] = __uint_as_float(h.y & 0xffff0000u) + __uint_as_float(l.y & 0xffff0000u);
    b[0] = __uint_as_float(h.z << 16) + __uint_as_float(l.z << 16); b[1] = __uint_as_float(h.z & 0xffff0000u) + __uint_as_float(l.z & 0xffff0000u);
    b[2] = __uint_as_float(h.w << 16) + __uint_as_float(l.w << 16); b[3] = __uint_as_float(h.w & 0xffff0000u) + __uint_as_float(l.w & 0xffff0000u);
}
__device__ __forceinline__ void split8(f32x4 a, f32x4 b, u32x4& h, u32x4& l) {
    h = pack8(a, b);
    f32x4 ra, rb;
    ra[0] = a[0] - __uint_as_float(h.x << 16); ra[1] = a[1] - __uint_as_float(h.x & 0xffff0000u); ra[2] = a[2] - __uint_as_float(h.y << 16); ra[3] = a[3] - __uint_as_float(h.y & 0xffff0000u);
    rb[0] = b[0] - __uint_as_float(h.z << 16); rb[1] = b[1] - __uint_as_float(h.z & 0xffff0000u); rb[2] = b[2] - __uint_as_float(h.w << 16); rb[3] = b[3] - __uint_as_float(h.w & 0xffff0000u);
    l = pack8(ra, rb);
}
struct EpiRes {
    static constexpr bool PERM = true, AFTER_DRAIN = false;
    bf16_t* xb; ss_t* ss; float alpha;
    __device__ __forceinline__ void operator()(const f32x4 (&acc)[2][2][4][2], const Unit& u, int wr, int wc, int fr, int fq) const {
        const unsigned row0 = (unsigned)(u.pm * 256 + wr * 64 + fr);
        const unsigned e0 = row0 * (unsigned)DM + (unsigned)(u.pn * 256 + wc * 64 + 8 * fq);
        char* ph = (char*)xb;
        u32x4 ch[2], nh[2];
        float qs[8];
#define RES_LOAD(dh, g) do { _Pragma("unroll") for (int bj = 0; bj < 2; ++bj) { const unsigned eo = e0 + (unsigned)((((g) >> 2) * 128 + ((g) & 3) * 16) * DM + bj * 32); \
            dh[bj] = *(const u32x4*)(ph + eo * 2u); } } while (0)
        RES_LOAD(ch, 0);
#pragma unroll
        for (int g = 0; g < 8; ++g) {
            const int ai = g >> 2, m = g & 3;
            if (g < 7) RES_LOAD(nh, g + 1);
            float q = 0.f;
#pragma unroll
            for (int bj = 0; bj < 2; ++bj) {
                const unsigned eo = e0 + (unsigned)((ai * 128 + m * 16) * DM + bj * 32);
                f32x4 x0, x1; unpack8(ch[bj], (u32x4){0u, 0u, 0u, 0u}, x0, x1);
                const f32x4 o0 = x0 + acc[ai][bj][m][0] * alpha, o1 = x1 + acc[ai][bj][m][1] * alpha;
                *(u32x4*)(ph + eo * 2u) = pack8(o0, o1);
                q += (o0[0] * o0[0] + o0[1] * o0[1]) + (o0[2] * o0[2] + o0[3] * o0[3]) + (o1[0] * o1[0] + o1[1] * o1[1]) + (o1[2] * o1[2] + o1[3] * o1[3]);
            }
            q += __shfl_xor(q, 16); q += __shfl_xor(q, 32);
            qs[g] = q;
            asm volatile("" ::: "memory");
#pragma unroll
            for (int bj = 0; bj < 2; ++bj) ch[bj] = nh[bj];
        }
#undef RES_LOAD
        if (fq == 0) {
#pragma unroll
            for (int g = 0; g < 8; ++g) *(float*)((char*)ss + ((row0 + (unsigned)((g >> 2) * 128 + (g & 3) * 16)) * 16u + (unsigned)(u.pn * 4 + wc)) * 4u) = qs[g];
        }
    }
};

struct EpiNull {
    static constexpr bool PERM = true, AFTER_DRAIN = false;
    float* sink;
    __device__ __forceinline__ void operator()(const f32x4 (&acc)[2][2][4][2], const Unit& u, int wr, int wc, int fr, int fq) const {
        float t = 0.f;
#pragma unroll
        for (int ai = 0; ai < 2; ++ai)
#pragma unroll
            for (int bj = 0; bj < 2; ++bj)
#pragma unroll
                for (int m = 0; m < 4; ++m)
#pragma unroll
                    for (int n = 0; n < 2; ++n) t += acc[ai][bj][m][n][0] + acc[ai][bj][m][n][1] + acc[ai][bj][m][n][2] + acc[ai][bj][m][n][3];
        if (t == 1.2345e-30f) sink[0] = t;
    }
};

struct EpiAB {
    static constexpr bool PERM = true, AFTER_DRAIN = false;
    const LAS float* rs; const float* qg; const float* kg; const float* rope; bf16_t* ub;
    __device__ __forceinline__ void operator()(const f32x4 (&acc)[2][2][4][2], const Unit& u, int wr, int wc, int fr, int fq) const {
        const int pn = u.pn;
        int kind, head;
        if (pn < 2) { kind = 0; head = 4 * pn + wc; }
        else if (pn == 2) { if (wc < 2) { kind = 1; head = wc; } else { kind = 2; head = wc - 2; } }
        else if (pn < 5) { kind = 3; head = 4 * (pn - 3) + wc; }
        else if (pn < 7) { kind = 4; head = 4 * (pn - 5) + wc; }
        else { kind = 5; head = 4 * (pn - 7) + wc; }
        if (kind <= 1) {
            const float* g = kind == 0 ? qg : kg;
            f32x4 gv[2][2];
#pragma unroll
            for (int bj = 0; bj < 2; ++bj)
#pragma unroll
                for (int n = 0; n < 2; ++n) gv[bj][n] = *(const f32x4*)(g + 32 * bj + 8 * fq + 4 * n);
            const float osc = kind == 0 ? 0.125f * LOG2E : 1.0f;
            bf16_t* dst = ub + (kind == 0 ? U_QA : U_KA);
            const int ldo = kind == 0 ? 512 : 128;
#pragma unroll
            for (int ai = 0; ai < 2; ++ai)
#pragma unroll
                for (int m = 0; m < 4; ++m) {
                    const int row = EPI_ROW(ai, m);
                    const float r = EPI_RS(ai, m);
                    f32x4 v[2][2]; float q = 0.f;
#pragma unroll
                    for (int bj = 0; bj < 2; ++bj)
#pragma unroll
                        for (int n = 0; n < 2; ++n) { v[bj][n] = acc[ai][bj][m][n] * r; const f32x4 t = v[bj][n]; q += (t[0] * t[0] + t[1] * t[1]) + (t[2] * t[2] + t[3] * t[3]); }
                    q += __shfl_xor(q, 16); q += __shfl_xor(q, 32);
                    const float rn = fast_rsq(q * (1.0f / 64.0f) + EPS) * osc;
                    const int pos = row & (SEQ - 1);
#pragma unroll
                    for (int bj = 0; bj < 2; ++bj) {
                        f32x4 o[2];
#pragma unroll
                        for (int n = 0; n < 2; ++n) {
                            const f32x4 t = v[bj][n] * gv[bj][n] * rn;
                            const f32x4 cs = *(const f32x4*)(rope + ((size_t)pos * 32 + 16 * bj + 4 * fq + 2 * n) * 2);
                            o[n][0] = t[0] * cs[0] - t[1] * cs[1]; o[n][1] = t[0] * cs[1] + t[1] * cs[0];
                            o[n][2] = t[2] * cs[2] - t[3] * cs[3]; o[n][3] = t[2] * cs[3] + t[3] * cs[2];
                        }
                        *(u32x4*)(dst + (size_t)row * ldo + head * 64 + 32 * bj + 8 * fq) = pack8(o[0], o[1]);
                    }
                    asm volatile("" ::: "memory");
                }
        } else if (kind == 3 || kind == 4) {
            const float osc = kind == 3 ? 0.125f * LOG2E : 1.0f;
            bf16_t* dst = ub + (kind == 3 ? U_QB : U_KB);
#pragma unroll
            for (int ai = 0; ai < 2; ++ai)
#pragma unroll
                for (int m = 0; m < 4; ++m) {
                    const int row = EPI_ROW(ai, m);
                    const float r = EPI_RS(ai, m) * osc;
#pragma unroll
                    for (int bj = 0; bj < 2; ++bj)
                        *(u32x4*)(dst + (size_t)row * 512 + head * 64 + 32 * bj + 8 * fq) = pack8(acc[ai][bj][m][0] * r, acc[ai][bj][m][1] * r);
                }
        } else {
            const int nh = kind == 2 ? 2 : 8;
            bf16_t* dst = ub + (kind == 2 ? U_VTA : U_VTB);
#pragma unroll
            for (int ai = 0; ai < 2; ++ai)
#pragma unroll
                for (int m = 0; m < 4; ++m) {
                    const int row = EPI_ROW(ai, m);
                    const float r = EPI_RS(ai, m);
                    const int b = row >> 11, pos = row & (SEQ - 1);
                    bf16_t* base = dst + ((size_t)(b * nh + head) * 64) * SEQ + pos;
#pragma unroll
                    for (int bj = 0; bj < 2; ++bj)
#pragma unroll
                        for (int n = 0; n < 2; ++n) {
                            const f32x4 t = acc[ai][bj][m][n] * r;
                            const unsigned w0 = cvt_pk_bf16(t[0], t[1]), w1 = cvt_pk_bf16(t[2], t[3]);
                            const int d = 32 * bj + 8 * fq + 4 * n;
                            base[(size_t)(d + 0) * SEQ] = (bf16_t)(w0 & 0xffffu); base[(size_t)(d + 1) * SEQ] = (bf16_t)(w0 >> 16);
                            base[(size_t)(d + 2) * SEQ] = (bf16_t)(w1 & 0xffffu); base[(size_t)(d + 3) * SEQ] = (bf16_t)(w1 >> 16);
                        }
                }
        }
    }
};

struct EpiCD {
    static constexpr bool PERM = true, AFTER_DRAIN = false;
    const LAS float* rs; bf16_t* ub;
    __device__ __forceinline__ void operator()(const f32x4 (&acc)[2][2][4][2], const Unit& u, int wr, int wc, int fr, int fq) const {
        const int pn = u.pn;
        const unsigned row0 = (unsigned)(u.pm * 256 + wr * 64 + fr);
        if (pn < 8) {
            char* dst = (char*)(ub + (pn < 4 ? U_E : U_P));
            const unsigned e0 = row0 * 512u + (unsigned)((pn & 3) * 128 + wc * 32 + 8 * fq);
            const bool gate = pn < 4;
#pragma unroll
            for (int ai = 0; ai < 2; ++ai)
#pragma unroll
                for (int m = 0; m < 4; ++m) {
                    const float r = EPI_RS(ai, m);
                    f32x4 h[2];
#pragma unroll
                    for (int n = 0; n < 2; ++n) {
                        const f32x4 a = acc[ai][0][m][n] * r, g = acc[ai][1][m][n] * r;
#pragma unroll
                        for (int i = 0; i < 4; ++i) h[n][i] = a[i] * (gate ? sigmoidf_(g[i]) : g[i]);
                    }
                    *(u32x4*)(dst + (e0 + (unsigned)((ai * 128 + m * 16) * 512)) * 2u) = pack8(h[0], h[1]);
                    asm volatile("" ::: "memory");
                }
        } else {
            char* dst = (char*)(ub + U_BC);
            const unsigned e0 = row0 * 512u + (unsigned)((pn - 8) * 256 + wc * 32 + 8 * fq);
#pragma unroll
            for (int ai = 0; ai < 2; ++ai)
#pragma unroll
                for (int m = 0; m < 4; ++m) {
                    const float r = EPI_RS(ai, m);
#pragma unroll
                    for (int bj = 0; bj < 2; ++bj)
                        *(u32x4*)(dst + (e0 + (unsigned)((ai * 128 + m * 16) * 512 + bj * 128)) * 2u) = pack8(acc[ai][bj][m][0] * r, acc[ai][bj][m][1] * r);
                    asm volatile("" ::: "memory");
                }
        }
    }
};

__device__ __forceinline__ float wave_sum(float v) {
#pragma unroll
    for (int o = 1; o < 64; o <<= 1) v += __shfl_xor(v, o);
    return v;
}
__device__ __forceinline__ void transpose_item(const float* src, int ldw, const float* gain, bf16_t* dst, int K, int k0, LAS float* scr, int lane) {
    float tv[32];
#pragma unroll
    for (int i = 0; i < 32; ++i) { const int kk = 2 * i + (lane >> 5); tv[i] = src[(size_t)(k0 + kk) * ldw + (lane & 31)]; }
#pragma unroll
    for (int i = 0; i < 32; ++i) { const int kk = 2 * i + (lane >> 5); float v = tv[i]; if (gain) v *= gain[k0 + kk]; scr[kk * 33 + (lane & 31)] = v; }
    asm volatile("s_waitcnt lgkmcnt(0)" ::: "memory");
    const int c = lane & 7;
#pragma unroll
    for (int j = 0; j < 4; ++j) { const int n = (lane >> 3) + 8 * j; const LAS float* s = scr + (8 * c) * 33 + n;
        u32x4 o; o.x = cvt_pk_bf16(s[0 * 33], s[1 * 33]); o.y = cvt_pk_bf16(s[2 * 33], s[3 * 33]); o.z = cvt_pk_bf16(s[4 * 33], s[5 * 33]); o.w = cvt_pk_bf16(s[6 * 33], s[7 * 33]);
        *(u32x4*)(dst + (size_t)n * K + k0 + 8 * c) = o; }
    asm volatile("s_waitcnt lgkmcnt(0)" ::: "memory");
}

struct Params {
    const float* in[18];
    float* out; unsigned char* ws;
    int ph_lo, ph_hi;
};
enum { I_X = 0, I_FFN_NORM, I_MIX_NORM, I_WG, I_WU, I_WD, I_ABIN, I_ABOUT, I_QN, I_KN, I_RPB, I_CDIN, I_CDOUT, I_CCW, I_DCW, I_DNG, I_DNB, I_FINAL };

#define RESCOL(nb) (256 * ((nb) >> 3) + 64 * ((nb) & 3) + 32 * (((nb) >> 2) & 1))
__device__ __forceinline__ void prologue_phase(const Params& p, LAS unsigned char* lds, int vcu, int NGW, int wave_s) {
    int tid_; asm volatile("v_mbcnt_lo_u32_b32 %0, -1, 0\n\tv_mbcnt_hi_u32_b32 %0, -1, %0" : "=v"(tid_)); tid_ += wave_s * 64;
    const int lane = tid_ & 63, wave = __builtin_amdgcn_readfirstlane(tid_ >> 6), gw = vcu * 8 + wave;
    unsigned char* ws = p.ws;
    ss_t* ss = (ss_t*)(ws + WS_SS);
    {
        const float* x = p.in[I_X]; bf16_t* xb = (bf16_t*)(ws + WS_XB);
        for (int row0 = gw; row0 < NTOK; row0 += 2 * NGW) {
            f32x4 v[2][4]; float sq[2];
#pragma unroll
            for (int k = 0; k < 2; ++k) { const f32x4* xr = (const f32x4*)(x + (size_t)(row0 + k * NGW) * DM) + lane;
#pragma unroll
                for (int j = 0; j < 4; ++j) v[k][j] = xr[64 * j]; }
#pragma unroll
            for (int k = 0; k < 2; ++k) {
                const int row = row0 + k * NGW; float s = 0.f;
#pragma unroll
                for (int j = 0; j < 4; ++j) s += (v[k][j][0] * v[k][j][0] + v[k][j][1] * v[k][j][1]) + (v[k][j][2] * v[k][j][2] + v[k][j][3] * v[k][j][3]);
                sq[k] = wave_sum(s);
                u32x2* o = (u32x2*)(xb + (size_t)row * DM) + lane;
#pragma unroll
                for (int j = 0; j < 4; ++j) { u32x2 w; w.x = cvt_pk_bf16(v[k][j][0], v[k][j][1]); w.y = cvt_pk_bf16(v[k][j][2], v[k][j][3]); o[64 * j] = w; }
                if (lane < 16) ss[(size_t)row * 16 + lane] = lane == 0 ? sq[k] : 0.f;
            }
        }
    }
    {
        float* rope = (float*)(ws + WS_ROPE);
        for (int idx = gw * 64 + lane; idx < SEQ * 32; idx += NGW * 64) {
            const int pos = idx >> 5, pr = idx & 31, j = pr & 15;
            const float coord = pr < 16 ? (float)(pos >> 6) : (float)(pos & 63);
            const float freq = fast_exp2(-(float)(2 * j) * (1.0f / 32.0f) * 13.287712379549449f);
            const float ang = coord * freq;
            float sn, cs; __sincosf(ang, &sn, &cs);
            rope[2 * idx] = cs; rope[2 * idx + 1] = sn;
        }
    }
    {
        LAS float* scr = (LAS float*)(lds + wave * 16384);
        constexpr int IT_GU = 16 * (NGU / 32), IT_DN = (DFF / 64) * 32, IT_ABIN = 16 * (ABIN / 32), IT_SQ = 16 * 32, IT_CDIN = 16 * (CDIN / 32);
        constexpr int IT_FFN = IT_GU + IT_DN, IT_AB = IT_ABIN + IT_SQ, IT_CD = IT_CDIN + IT_SQ;
        constexpr int NITEMS = 8 * IT_FFN + 2 * IT_AB + 2 * IT_CD;
        for (int it = gw; it < NITEMS; it += NGW) {
            int r = it;
            if (r < 8 * IT_FFN) {
                const int f = r / IT_FFN; r -= f * IT_FFN;
                if (r < IT_GU) {
                    const int nb = r % (NGU / 32), kb = r / (NGU / 32);
                    const int pn = nb >> 3, bj = (nb >> 2) & 1, j0 = 32 * (nb & 3);
                    const float* W = (bj ? p.in[I_WU] : p.in[I_WG]) + (size_t)f * DM * DFF + 128 * pn + j0;
                    transpose_item(W, DFF, p.in[I_FFN_NORM] + f * DM, (bf16_t*)(ws + WS_WGU + f * SZ_GU) + (size_t)(32 * nb) * DM, DM, 64 * kb, scr, lane);
                } else {
                    r -= IT_GU; const int nb = r % 32, kb = r / 32;
                    transpose_item(p.in[I_WD] + (size_t)f * DFF * DM + RESCOL(nb), DM, nullptr, (bf16_t*)(ws + WS_WDN + f * SZ_DN) + (size_t)(32 * nb) * DFF, DFF, 64 * kb, scr, lane);
                }
                continue;
            }
            r -= 8 * IT_FFN;
            if (r < 2 * IT_AB) {
                const int e = r / IT_AB; r -= e * IT_AB;
                if (r < IT_ABIN) {
                    const int nb = r % (ABIN / 32), kb = r / (ABIN / 32);
                    const int pn = nb >> 3, bj = (nb >> 2) & 1, wc = nb & 3;
                    transpose_item(p.in[I_ABIN] + (size_t)e * DM * ABIN + 256 * pn + 64 * wc + 32 * bj, ABIN, p.in[I_MIX_NORM] + (2 * e) * DM,
                                   (bf16_t*)(ws + WS_WABIN + e * SZ_ABIN) + (size_t)(32 * nb) * DM, DM, 64 * kb, scr, lane);
                } else {
                    r -= IT_ABIN; const int nb = r % 32, kb = r / 32;
                    transpose_item(p.in[I_ABOUT] + (size_t)e * DM * DM + RESCOL(nb), DM, nullptr, (bf16_t*)(ws + WS_WABOUT + e * SZ_SQ) + (size_t)(32 * nb) * DM, DM, 64 * kb, scr, lane);
                }
                continue;
            }
            r -= 2 * IT_AB;
            {
                const int e = r / IT_CD; r -= e * IT_CD;
                if (r < IT_CDIN) {
                    const int nb = r % (CDIN / 32), kb = r / (CDIN / 32);
                    const int pn = nb >> 3, bj = (nb >> 2) & 1, j0 = 32 * (nb & 3);
                    int scol;
                    if (pn < 4) scol = (bj ? 2048 : 1536) + 128 * pn + j0;
                    else if (pn < 8) scol = (bj ? 0 : 1024) + 128 * (pn - 4) + j0;
                    else scol = 512 + 256 * (pn - 8) + 128 * bj + j0;
                    transpose_item(p.in[I_CDIN] + (size_t)e * DM * CDIN + scol, CDIN, p.in[I_MIX_NORM] + (2 * e + 1) * DM,
                                   (bf16_t*)(ws + WS_WCDIN + e * SZ_CDIN) + (size_t)(32 * nb) * DM, DM, 64 * kb, scr, lane);
                } else {
                    r -= IT_CDIN; const int nb = r % 32, kb = r / 32;
                    transpose_item(p.in[I_CDOUT] + (size_t)e * DM * DM + RESCOL(nb), DM, nullptr, (bf16_t*)(ws + WS_WCDOUT + e * SZ_SQ) + (size_t)(32 * nb) * DM, DM, 64 * kb, scr, lane);
                }
            }
        }
    }
}

__device__ __forceinline__ void attn_global_phase(LAS unsigned char* lds, const bf16_t* Qa, const bf16_t* Ka, const bf16_t* Vta, const float* qg, const float* kg, bf16_t* y, int vcu, int G, int wave_s) {
    constexpr int PITCH = 144, TILEB = 64 * PITCH, BUFB = 2 * TILEB;
    float negCB;
    {
        int l_; asm volatile("v_mbcnt_lo_u32_b32 %0, -1, 0\n\tv_mbcnt_hi_u32_b32 %0, -1, %0" : "=v"(l_));
        float gq = fabsf(qg[l_]), gk = fabsf(kg[l_]);
#pragma unroll
        for (int o = 1; o < 64; o <<= 1) { gq = fmaxf(gq, __shfl_xor(gq, o)); gk = fmaxf(gk, __shfl_xor(gk, o)); }
        negCB = -(64.0f * 0.125f * LOG2E * 1.01f * gq * gk + 0.125f);
    }
    for (int un_ = vcu; un_ < 32 * 8 * 4; un_ += G) {
        const int un = 32 * 8 * 4 - 1 - un_;
        int tid_; asm volatile("v_mbcnt_lo_u32_b32 %0, -1, 0\n\tv_mbcnt_hi_u32_b32 %0, -1, %0" : "=v"(tid_)); tid_ += wave_s * 64;
        const int tid = tid_, lane = tid & 63, wid = __builtin_amdgcn_readfirstlane(tid >> 6), ql = lane & 31, hi = lane >> 5;
        const int srow = tid >> 3, sch = tid & 7;
        const int pik = (ql & 19) | ((ql & 4) << 1) | ((ql & 8) >> 1);
        const int qb = un & 3, h4 = (un >> 2) & 3, kvh = (un >> 4) & 1, b = un >> 5, h = kvh * 4 + h4;
        const int tok0 = b * SEQ + qb * 512 + wid * 64 + ql;
        const bf16_t* qp = Qa + (size_t)tok0 * 512 + h * 64 + hi * 8;
        bf16x8 qf[2][4];
#pragma unroll
        for (int t = 0; t < 2; ++t)
#pragma unroll
            for (int dc = 0; dc < 4; ++dc) qf[t][dc] = *(const bf16x8*)(qp + (size_t)t * 32 * 512 + dc * 16);
        const bf16_t* kg_ = Ka + (size_t)(b * SEQ + srow) * 128 + kvh * 64 + sch * 8;
        const bf16_t* vg_ = Vta + ((size_t)(b * 2 + kvh) * 64 + srow) * SEQ + sch * 8;
        f32x16 o[2][2];
#pragma unroll
        for (int t = 0; t < 2; ++t)
#pragma unroll
            for (int r = 0; r < 16; ++r) { o[t][0][r] = 0.f; o[t][1][r] = 0.f; }
        float lrun[2] = {0.f, 0.f};
        u32x4 kreg = *(const u32x4*)kg_, vreg = *(const u32x4*)vg_;
        __syncthreads();
        *(LAS u32x4*)(lds + srow * PITCH + sch * 16) = kreg; *(LAS u32x4*)(lds + TILEB + srow * PITCH + sch * 16) = vreg;
        __syncthreads();
        for (int kt = 0; kt < SEQ / 64; ++kt) {
            if (kt + 1 < SEQ / 64) { kreg = *(const u32x4*)(kg_ + (size_t)(kt + 1) * 64 * 128); vreg = *(const u32x4*)(vg_ + (kt + 1) * 64); }
            const LAS unsigned char* Kb_ = lds + (kt & 1) * BUFB; const LAS unsigned char* Vb_ = Kb_ + TILEB;
            f32x16 p[2][2];
#pragma unroll
            for (int t = 0; t < 2; ++t)
#pragma unroll
                for (int r = 0; r < 16; ++r) { p[t][0][r] = negCB; p[t][1][r] = negCB; }
#pragma unroll
            for (int dc = 0; dc < 4; ++dc) {
                const bf16x8 a0 = *(const LAS bf16x8*)(Kb_ + pik * PITCH + dc * 32 + hi * 16);
                const bf16x8 a1 = *(const LAS bf16x8*)(Kb_ + (32 + pik) * PITCH + dc * 32 + hi * 16);
#pragma unroll
                for (int t = 0; t < 2; ++t) {
                    p[t][0] = __builtin_amdgcn_mfma_f32_32x32x16_bf16(a0, qf[t][dc], p[t][0], 0, 0, 0);
                    p[t][1] = __builtin_amdgcn_mfma_f32_32x32x16_bf16(a1, qf[t][dc], p[t][1], 0, 0, 0);
                }
            }
            __builtin_amdgcn_sched_barrier(0);
            u32x4 pw[2][2][2];
#pragma unroll
            for (int t = 0; t < 2; ++t) {
                float sum = 0.f;
#pragma unroll
                for (int r = 0; r < 16; ++r) { p[t][0][r] = fast_exp2(p[t][0][r]); p[t][1][r] = fast_exp2(p[t][1][r]); sum += p[t][0][r] + p[t][1][r]; }
                lrun[t] += sum;
#pragma unroll
                for (int kb = 0; kb < 2; ++kb)
#pragma unroll
                    for (int c = 0; c < 2; ++c) {
                        pw[t][kb][c].x = cvt_pk_bf16(p[t][kb][8 * c + 0], p[t][kb][8 * c + 1]); pw[t][kb][c].y = cvt_pk_bf16(p[t][kb][8 * c + 2], p[t][kb][8 * c + 3]);
                        pw[t][kb][c].z = cvt_pk_bf16(p[t][kb][8 * c + 4], p[t][kb][8 * c + 5]); pw[t][kb][c].w = cvt_pk_bf16(p[t][kb][8 * c + 6], p[t][kb][8 * c + 7]);
                    }
            }
            __builtin_amdgcn_sched_barrier(0);
#pragma unroll
            for (int kb = 0; kb < 2; ++kb)
#pragma unroll
                for (int c = 0; c < 2; ++c) {
                    const bf16x8 v0 = *(const LAS bf16x8*)(Vb_ + ql * PITCH + (32 * kb + 16 * c + 8 * hi) * 2);
                    const bf16x8 v1 = *(const LAS bf16x8*)(Vb_ + (32 + ql) * PITCH + (32 * kb + 16 * c + 8 * hi) * 2);
#pragma unroll
                    for (int t = 0; t < 2; ++t) {
                        const bf16x8 pb = __builtin_bit_cast(bf16x8, pw[t][kb][c]);
                        o[t][0] = __builtin_amdgcn_mfma_f32_32x32x16_bf16(v0, pb, o[t][0], 0, 0, 0);
                        o[t][1] = __builtin_amdgcn_mfma_f32_32x32x16_bf16(v1, pb, o[t][1], 0, 0, 0);
                    }
                }
            if (kt + 1 < SEQ / 64) {
                LAS unsigned char* nb = lds + ((kt + 1) & 1) * BUFB;
                *(LAS u32x4*)(nb + srow * PITCH + sch * 16) = kreg; *(LAS u32x4*)(nb + TILEB + srow * PITCH + sch * 16) = vreg;
            }
            __syncthreads();
        }
#pragma unroll
        for (int t = 0; t < 2; ++t) {
            float l = lrun[t]; l += __shfl_xor(l, 32);
            const float inv = fast_rcp(l);
            bf16_t* yp = y + (size_t)(tok0 + 32 * t) * DM + h * 64 + 4 * hi;
#pragma unroll
            for (int g = 0; g < 4; ++g) {
                u32x2 w0, w1;
                w0.x = cvt_pk_bf16(o[t][0][4 * g] * inv, o[t][0][4 * g + 1] * inv); w0.y = cvt_pk_bf16(o[t][0][4 * g + 2] * inv, o[t][0][4 * g + 3] * inv);
                w1.x = cvt_pk_bf16(o[t][1][4 * g] * inv, o[t][1][4 * g + 1] * inv); w1.y = cvt_pk_bf16(o[t][1][4 * g + 2] * inv, o[t][1][4 * g + 3] * inv);
                *(u32x2*)(yp + 8 * g) = w0; *(u32x2*)(yp + 32 + 8 * g) = w1;
            }
        }
    }
}

constexpr int NA_TAB = 0, NA_K = 2048, NA_KP = 144, NA_V = NA_K + 576 * NA_KP, NA_VP = 1168, NA_END = NA_V + 64 * NA_VP;
__device__ __forceinline__ void attn_na_phase(LAS unsigned char* lds, const bf16_t* Qb, const bf16_t* Kb, const bf16_t* Vtb, const float* rpb, bf16_t* y, int vcu, int G, int wave_s) {
    int tid_; asm volatile("v_mbcnt_lo_u32_b32 %0, -1, 0\n\tv_mbcnt_hi_u32_b32 %0, -1, %0" : "=v"(tid_)); tid_ += wave_s * 64;
    const int tid = tid_, lane = tid & 63, wid = __builtin_amdgcn_readfirstlane(tid >> 6), ql = lane & 15, quad = lane >> 4;
    LAS float* tab = (LAS float*)(lds + NA_TAB);
    const int srow = tid >> 3, sch = tid & 7;
    u32x4 kreg[9], vreg[9];
#define NA_FETCH(unx) do { const int rp_ = (unx) & 15, h_ = ((unx) >> 4) & 7, b_ = (unx) >> 7; \
        const int rs0_ = min(max(2 * rp_ - 4, 0), 24), rs1_ = min(max(2 * rp_ - 3, 0), 24), nrows_ = rs1_ + 8 - rs0_; \
        const bf16_t* kg = Kb + (size_t)(b_ * SEQ + rs0_ * 64 + srow) * 512 + h_ * 64 + sch * 8; \
        const bf16_t* vg = Vtb + ((size_t)(b_ * 8 + h_) * 64 + srow) * SEQ + rs0_ * 64 + sch * 8; \
        _Pragma("unroll") for (int i = 0; i < 8; ++i) { kreg[i] = *(const u32x4*)(kg + (size_t)i * 64 * 512); vreg[i] = *(const u32x4*)(vg + i * 64); } \
        if (nrows_ > 8) { kreg[8] = *(const u32x4*)(kg + (size_t)8 * 64 * 512); vreg[8] = *(const u32x4*)(vg + 8 * 64); } \
        else { kreg[8] = (u32x4){0u, 0u, 0u, 0u}; vreg[8] = kreg[8]; } } while (0)
    if (vcu < 32 * 8 * 16) NA_FETCH(32 * 8 * 16 - 1 - vcu);
    for (int un_ = vcu; un_ < 32 * 8 * 16; un_ += G) {
        const int un = 32 * 8 * 16 - 1 - un_;
        const int rp = un & 15, h = (un >> 4) & 7, b = un >> 7;
        const int rs0 = min(max(2 * rp - 4, 0), 24);
        const int r = rp * 2 + (wid >> 2), n = wid & 3;
        const int rs = min(max(r - 4, 0), 24), kcol0 = min(max(16 * n - 8, 0), 32), ro = rs - rs0;
        const int qcol = 16 * n + ql, wcs = min(max(qcol - 8, 0), 48);
        const int tokq = b * SEQ + r * 64 + qcol;
        bf16x8 qf[2];
#pragma unroll
        for (int dc = 0; dc < 2; ++dc) qf[dc] = *(const bf16x8*)(Qb + (size_t)tokq * 512 + h * 64 + 32 * dc + 8 * quad);
        __syncthreads();
        for (int i = tid; i < 465; i += 512) tab[i] = rpb[h * 465 + i] * LOG2E;
#pragma unroll
        for (int i = 0; i < 9; ++i) {
            *(LAS u32x4*)(lds + NA_K + (i * 64 + srow) * NA_KP + sch * 16) = kreg[i];
            *(LAS u32x4*)(lds + NA_V + srow * NA_VP + (i * 64 + sch * 8) * 2) = vreg[i];
        }
        __syncthreads();
        if (un_ + G < 32 * 8 * 16) NA_FETCH(32 * 8 * 16 - 1 - (un_ + G));
        int co[2][4]; bool val[2][4];
#pragma unroll
        for (int ch = 0; ch < 2; ++ch)
#pragma unroll
            for (int i = 0; i < 4; ++i) { const int kc = kcol0 + 16 * ch + 4 * quad + i; val[ch][i] = (kc >= wcs) && (kc < wcs + 16); co[ch][i] = min(max(kc - qcol + 15, 0), 30); }
        const LAS unsigned char* kbase = lds + NA_K + ((ro * 64 + kcol0 + ql) * NA_KP) + quad * 16;
        const LAS unsigned char* vbase = lds + NA_V + ql * NA_VP + (ro * 64 + kcol0 + 4 * quad) * 2;
        f32x4 s[8][2];
        float mx = -1e30f;
#pragma unroll
        for (int w = 0; w < 8; ++w) {
            const int rowoff = (rs + w - r + 7) * 31;
#pragma unroll
            for (int ch = 0; ch < 2; ++ch) {
                const bf16x8 k0 = *(const LAS bf16x8*)(kbase + (w * 64 + 16 * ch) * NA_KP), k1 = *(const LAS bf16x8*)(kbase + (w * 64 + 16 * ch) * NA_KP + 64);
                f32x4 a = {0.f, 0.f, 0.f, 0.f};
                a = __builtin_amdgcn_mfma_f32_16x16x32_bf16(k0, qf[0], a, 0, 0, 0);
                a = __builtin_amdgcn_mfma_f32_16x16x32_bf16(k1, qf[1], a, 0, 0, 0);
#pragma unroll
                for (int i = 0; i < 4; ++i) { const float v = val[ch][i] ? a[i] + tab[rowoff + co[ch][i]] : -1e30f; s[w][ch][i] = v; mx = fmaxf(mx, v); }
            }
        }
        mx = fmaxf(mx, __shfl_xor(mx, 16)); mx = fmaxf(mx, __shfl_xor(mx, 32));
        float l = 0.f;
#pragma unroll
        for (int w = 0; w < 8; ++w)
#pragma unroll
            for (int ch = 0; ch < 2; ++ch)
#pragma unroll
                for (int i = 0; i < 4; ++i) { const float e = fast_exp2(s[w][ch][i] - mx); s[w][ch][i] = e; l += e; }
        l += __shfl_xor(l, 16); l += __shfl_xor(l, 32);
        f32x4 o[4];
#pragma unroll
        for (int dt = 0; dt < 4; ++dt) o[dt] = (f32x4){0.f, 0.f, 0.f, 0.f};
#pragma unroll
        for (int w = 0; w < 8; ++w) {
            const bf16x8 pb = __builtin_bit_cast(bf16x8, pack8(s[w][0], s[w][1]));
#pragma unroll
            for (int dt = 0; dt < 4; ++dt) {
                const u32x2 lo = *(const LAS u32x2*)(vbase + (16 * dt) * NA_VP + w * 128), hi2 = *(const LAS u32x2*)(vbase + (16 * dt) * NA_VP + w * 128 + 32);
                const u32x4 av = {lo.x, lo.y, hi2.x, hi2.y};
                o[dt] = __builtin_amdgcn_mfma_f32_16x16x32_bf16(__builtin_bit_cast(bf16x8, av), pb, o[dt], 0, 0, 0);
            }
        }
        const float inv = fast_rcp(l);
        bf16_t* yp = y + (size_t)tokq * DM + 512 + h * 64 + 4 * quad;
#pragma unroll
        for (int dt = 0; dt < 4; ++dt) { u32x2 w2; w2.x = cvt_pk_bf16(o[dt][0] * inv, o[dt][1] * inv); w2.y = cvt_pk_bf16(o[dt][2] * inv, o[dt][3] * inv); *(u32x2*)(yp + 16 * dt) = w2; }
    }
}

__device__ __forceinline__ float dpp_add(float v, float acc, const int ctrl, const int row_mask) { return acc; }
#define DPP_STEP(v, ctrl, rmask) (v) += __builtin_bit_cast(float, __builtin_amdgcn_update_dpp(0, __builtin_bit_cast(int, (v)), (ctrl), (rmask), 0xf, false))
__device__ __forceinline__ float wave_sum63(float v) {
    DPP_STEP(v, 0xB1, 0xf);
    DPP_STEP(v, 0x4E, 0xf);
    DPP_STEP(v, 0x114, 0xf);
    DPP_STEP(v, 0x118, 0xf);
    DPP_STEP(v, 0x142, 0xa);
    DPP_STEP(v, 0x143, 0xc);
    return v;
}
#undef NA_FETCH
template <int I> __device__ __forceinline__ void conv31_step(f32x2 (&acc)[32], const f32x2 (&wd)[31], const LAS unsigned char* base) {
    const unsigned raw = *(const LAS unsigned*)(base + I * 1024);
    const f32x2 v = {__uint_as_float(raw << 16), __uint_as_float(raw & 0xffff0000u)};
    constexpr int TLO = I - 30 > 0 ? I - 30 : 0, THI = I < 31 ? I : 31;
#pragma unroll
    for (int t = TLO; t <= THI; ++t) acc[t] += v * wd[I - t];
}
template <int... Is> __device__ __forceinline__ void conv31_all(f32x2 (&acc)[32], const f32x2 (&wd)[31], const LAS unsigned char* base, std::integer_sequence<int, Is...>) {
    (conv31_step<Is>(acc, wd, base), ...);
}
__device__ __forceinline__ void cd_core_phase(LAS unsigned char* lds, const bf16_t* E, const bf16_t* P, const bf16_t* Bc, const float* ccw, const float* dcw,
                                              const float* lng, const float* lnb, bf16_t* y, int vcu, int G, int wave_s) {
    constexpr int ROWS = 94, ROWB = 1024, PART_OFF = 96 * ROWB;
    LAS f32x2* part = (LAS f32x2*)(lds + PART_OFF);
    for (int un_ = vcu; un_ < NTOK / 64; un_ += G) {
        const int un = NTOK / 64 - 1 - un_;
        int tid_; asm volatile("v_mbcnt_lo_u32_b32 %0, -1, 0\n\tv_mbcnt_hi_u32_b32 %0, -1, %0" : "=v"(tid_)); tid_ += wave_s * 64;
        const int tid = tid_, lane = tid & 63, wid = __builtin_amdgcn_readfirstlane(tid >> 6), cp = tid & 255, th = tid >> 8, c0 = 2 * cp;
        const int t0 = un * 64, p0 = t0 & (SEQ - 1);
        __syncthreads();
        {
            u32x4 ev[12];
#pragma unroll
            for (int j = 0; j < 12; ++j) {
                const int c = tid + 512 * j, i = c >> 6, cc = c & 63, pos = p0 - 15 + i;
                ev[j] = (u32x4){0u, 0u, 0u, 0u};
                if (i < ROWS && pos >= 0 && pos < SEQ) ev[j] = *(const u32x4*)(E + (size_t)(t0 - 15 + i) * 512 + cc * 8);
            }
#pragma unroll
            for (int j = 0; j < 12; ++j) { const int c = tid + 512 * j, i = c >> 6, cc = c & 63; if (i < ROWS) *(LAS u32x4*)(lds + i * ROWB + cc * 16) = ev[j]; }
        }
        __syncthreads();
        f32x2 acc[32];
        {
            f32x2 wd[31];
#pragma unroll
            for (int k = 0; k < 31; ++k) wd[k] = *(const f32x2*)(dcw + k * 512 + c0);
#pragma unroll
            for (int t = 0; t < 32; ++t) acc[t] = (f32x2){0.f, 0.f};
            conv31_all(acc, wd, lds + (32 * th) * ROWB + cp * 4, std::make_integer_sequence<int, 62>{});
        }
        unsigned pr[34], br[32];
#pragma unroll
        for (int t = 0; t < 32; ++t) asm volatile("" : "+v"(acc[t]));
        {
            const int tokb = t0 + 32 * th, posb = p0 + 32 * th;
#pragma unroll
            for (int j = 0; j < 34; ++j) {
                const int pos = posb - 1 + j; const bool ok = (pos >= 0 && pos < SEQ);
                const unsigned v = *(const unsigned*)(P + (size_t)(ok ? tokb - 1 + j : tokb) * 512 + c0);
                pr[j] = ok ? v : 0u;
            }
#pragma unroll
            for (int j = 0; j < 32; ++j) br[j] = *(const unsigned*)(Bc + (size_t)(tokb + j) * 512 + c0);
        }
#ifdef REP_STATS
        for (int rep = 0; rep < REP_STATS; ++rep)
#endif
#pragma unroll
        for (int t = 0; t < 32; ++t) {
            float s1 = acc[t][0] + acc[t][1], s2 = acc[t][0] * acc[t][0] + acc[t][1] * acc[t][1];
            s1 = wave_sum63(s1); s2 = wave_sum63(s2);
            if (lane == 63) part[(32 * th + t) * 4 + (wid & 3)] = (f32x2){s1, s2};
        }
        __syncthreads();
        const f32x2 w0 = *(const f32x2*)(ccw + c0), w1 = *(const f32x2*)(ccw + 512 + c0), w2 = *(const f32x2*)(ccw + 1024 + c0);
        const f32x2 gg = *(const f32x2*)(lng + c0), bb = *(const f32x2*)(lnb + c0);
#pragma unroll
        for (int t = 0; t < 32; ++t) {
            const int tok = t0 + 32 * th + t;
            const f32x2 a = part[(32 * th + t) * 4 + 0], b2 = part[(32 * th + t) * 4 + 1], c2 = part[(32 * th + t) * 4 + 2], d2 = part[(32 * th + t) * 4 + 3];
            const float mean = ((a[0] + b2[0]) + (c2[0] + d2[0])) * (1.0f / 512.0f);
            const float var = ((a[1] + b2[1]) + (c2[1] + d2[1])) * (1.0f / 512.0f) - mean * mean;
            const float rstd = fast_rsq(fmaxf(var, 0.f) + EPS);
            const float z0 = (acc[t][0] - mean) * rstd * gg[0] + bb[0], z1 = (acc[t][1] - mean) * rstd * gg[1] + bb[1];
            *(unsigned*)(y + (size_t)tok * DM + 512 + c0) = cvt_pk_bf16(siluf_(z0), siluf_(z1));
            const unsigned rm = pr[t], rc = pr[t + 1], rp = pr[t + 2], rb = br[t];
            const float y0 = __uint_as_float(rb << 16) * (__uint_as_float(rm << 16) * w0[0] + __uint_as_float(rc << 16) * w1[0] + __uint_as_float(rp << 16) * w2[0]);
            const float y1 = __uint_as_float(rb & 0xffff0000u) * (__uint_as_float(rm & 0xffff0000u) * w0[1] + __uint_as_float(rc & 0xffff0000u) * w1[1] + __uint_as_float(rp & 0xffff0000u) * w2[1]);
            *(unsigned*)(y + (size_t)tok * DM + c0) = cvt_pk_bf16(y0, y1);
        }
    }
}

__device__ __forceinline__ void final_phase(float* out, const bf16_t* xb, const ss_t* ss, const float* g, int vcu, int NGW, int wave_s) {
    int tid_; asm volatile("v_mbcnt_lo_u32_b32 %0, -1, 0\n\tv_mbcnt_hi_u32_b32 %0, -1, %0" : "=v"(tid_)); tid_ += wave_s * 64;
    const int lane = tid_ & 63, gw = vcu * 8 + __builtin_amdgcn_readfirstlane(tid_ >> 6);
    f32x4 gv[2][2];
#pragma unroll
    for (int j = 0; j < 2; ++j) { gv[j][0] = *(const f32x4*)(g + 512 * j + 8 * lane); gv[j][1] = *(const f32x4*)(g + 512 * j + 8 * lane + 4); }
    for (int row0 = gw; row0 < NTOK; row0 += 2 * NGW) {
        u32x4 xv[2][2]; float r[2];
#pragma unroll
        for (int k = 0; k < 2; ++k) { const int row = row0 + k * NGW; r[k] = ss_rstd(ss + (size_t)row * 16);
#pragma unroll
            for (int j = 0; j < 2; ++j) xv[k][j] = *(const u32x4*)(xb + (size_t)row * DM + 512 * j + 8 * lane); }
#pragma unroll
        for (int k = 0; k < 2; ++k)
#pragma unroll
            for (int j = 0; j < 2; ++j) {
                const size_t off = (size_t)(row0 + k * NGW) * DM + 512 * j + 8 * lane;
                f32x4 a, b; unpack8(xv[k][j], (u32x4){0u, 0u, 0u, 0u}, a, b);
                *(f32x4*)(out + off) = a * r[k] * gv[j][0]; *(f32x4*)(out + off + 4) = b * r[k] * gv[j][1];
            }
    }
}

#ifndef GEMM_SP2
#define GEMM_SP2 true
#endif
#ifndef RES_SP2
#define RES_SP2 true
#endif
#ifndef RES_ALIGN
#define RES_ALIGN true
#endif
#ifndef REP_UP
#define REP_UP 1
#endif
#ifndef REP_ABIN
#define REP_ABIN 1
#endif
#ifndef REP_CDIN
#define REP_CDIN 1
#endif
#ifndef REP_AG
#define REP_AG 1
#endif
#ifndef REP_NA
#define REP_NA 1
#endif
#ifndef REP_CDC
#define REP_CDC 1
#endif
#ifndef REP_PRO
#define REP_PRO 1
#endif
#define XB_TMO      128
#define XB_XCNT(j)  (256  + 64 * (j))
#define XB_XSUB(j)  (1280 + 64 * (j))
#define XB_XGEN(j)  (2304 + 64 * (j))
#define XB_TOP      3328
#define XB_TOPGEN   3392
#define XCD_BAR_WORDS 3456
#define XB_SPIN_CAP (1u << 18)

__device__ __forceinline__ unsigned xb_ld(unsigned* p)              { return __hip_atomic_load(p, __ATOMIC_RELAXED, __HIP_MEMORY_SCOPE_AGENT); }
__device__ __forceinline__ unsigned xb_add(unsigned* p, unsigned v) { return __hip_atomic_fetch_add(p, v, __ATOMIC_RELAXED, __HIP_MEMORY_SCOPE_AGENT); }
__device__ __forceinline__ unsigned xb_xcc_id() { return (unsigned)__builtin_amdgcn_s_getreg((3 << 11) | 20) & 0xFu; }
#define XB_SPIN(cond, bar) do { unsigned _sp = 0; while (cond) { __builtin_amdgcn_s_sleep(1); \
    if ((++_sp & 255u) == 0u) { if (xb_ld(&(bar)[XB_TMO])) break; if (_sp > XB_SPIN_CAP) { atomicAdd(&(bar)[XB_TMO], 1u); break; } } } } while (0)

struct XcdBarrier {
    unsigned* bar; unsigned x;
    volatile LAS unsigned* st;
};

__device__ __forceinline__ XcdBarrier xcd_barrier_post(unsigned* bar, volatile LAS unsigned* st) {
    XcdBarrier b; b.bar = bar; b.x = xb_xcc_id(); b.st = st;
    if (threadIdx.x == 0) (void)xb_add(&bar[XB_XCNT(b.x)], 1u);
    return b;
}
__device__ __forceinline__ void xcd_barrier_complete(unsigned* bar, unsigned x, unsigned& nloc, unsigned& nx) {
    const unsigned G = gridDim.x * gridDim.y * gridDim.z;
    unsigned sum, cnt, mine, sp = 0u;
    for (;;) {
        sum = 0u; cnt = 0u; mine = 0u;
#pragma unroll
        for (unsigned j = 0; j < 16; ++j) { const unsigned c = xb_ld(&bar[XB_XCNT(j)]); sum += c; cnt += (c > 0u) ? 1u : 0u; mine = (j == x) ? c : mine; }
        if (sum == G) break;
        __builtin_amdgcn_s_sleep(1);
        if ((++sp & 255u) == 0u) { if (xb_ld(&bar[XB_TMO])) break; if (sp > XB_SPIN_CAP) { atomicAdd(&bar[XB_TMO], 1u); break; } }
    }
    nloc = mine > 0u ? mine : 1u; nx = cnt > 0u ? cnt : 1u;
}

__device__ __forceinline__ void xcd_barrier(const XcdBarrier& b) {
    asm volatile("s_waitcnt vmcnt(0)" ::: "memory");
    __syncthreads();
    if (threadIdx.x == 0) {
        unsigned* bar = b.bar;
        __builtin_amdgcn_s_waitcnt(0);
        unsigned nloc = b.st[0], nx = b.st[1];
        if (nloc == 0u) { xcd_barrier_complete(bar, b.x, nloc, nx); b.st[0] = nloc; b.st[1] = nx; }
        const unsigned old = xb_add(&bar[XB_XSUB(b.x)], 1u);
        const unsigned gen = old / nloc;
        if (old + 1u == (gen + 1u) * nloc) {
            __builtin_amdgcn_fence(__ATOMIC_RELEASE, "agent");
            asm volatile("s_waitcnt vmcnt(0)" ::: "memory");
            const unsigned og = xb_add(&bar[XB_TOP], 1u);
            const unsigned tg = og / nx;
            if (og + 1u == (tg + 1u) * nx) xb_add(&bar[XB_TOPGEN], 1u);
            else XB_SPIN(xb_ld(&bar[XB_TOPGEN]) == tg, bar);
            __builtin_amdgcn_fence(__ATOMIC_ACQUIRE, "agent");
            xb_add(&bar[XB_XGEN(b.x)], 1u);
            asm volatile("s_waitcnt vmcnt(0)" ::: "memory");
        } else {
            XB_SPIN(xb_ld(&bar[XB_XGEN(b.x)]) == gen, bar);
            __builtin_amdgcn_fence(__ATOMIC_ACQUIRE, "agent");
            asm volatile("s_waitcnt vmcnt(0)" ::: "memory");
        }
    }
    __syncthreads();
}

constexpr int LDS_BYTES = 163840;
static_assert(NA_END <= LDS_BYTES - 64, "NA tiles vs LDS");
__global__ void __launch_bounds__(512, 2) mega_fwd(Params p) {
    extern __shared__ __attribute__((aligned(16))) unsigned char lds_raw[];
    LAS unsigned char* lds = (LAS unsigned char*)lds_raw;
    cg::grid_group grid = cg::this_grid();
    const int G = gridDim.x, bx = blockIdx.x;
    const int wave_s = __builtin_amdgcn_readfirstlane((int)threadIdx.x >> 6);
    const int vcu = (G % 8 == 0) ? (bx % 8) * (G / 8) + bx / 8 : bx;
    const int NGW = G * 8;
    unsigned char* ws = p.ws;
    ss_t* ss = (ss_t*)(ws + WS_SS);
    bf16_t* xb = (bf16_t*)(ws + WS_XB); bf16_t* yb = (bf16_t*)(ws + WS_Y); bf16_t* act = (bf16_t*)(ws + WS_ACT);
    const float* rope = (const float*)(ws + WS_ROPE);
    volatile LAS unsigned* bst = (volatile LAS unsigned*)(lds + LDS_BYTES - 64);
    if (threadIdx.x < 2) bst[threadIdx.x] = 0u;
    __syncthreads();
    XcdBarrier xbar = xcd_barrier_post((unsigned*)(ws + WS_BAR), bst);
    int ph = 0;
#define PHASE_BEGIN if (ph >= p.ph_lo && ph < p.ph_hi) {
#define PHASE_END   if (ph + 1 < p.ph_hi) { if (p.ph_lo < 0) { asm volatile("s_waitcnt vmcnt(0)" ::: "memory"); grid.sync(); __builtin_amdgcn_fence(__ATOMIC_ACQUIRE, "agent"); asm volatile("s_waitcnt vmcnt(0)" ::: "memory"); } else xcd_barrier(xbar); } } ++ph;

    PHASE_BEGIN
#ifndef NO_PRO
    for (int rep = 0; rep < REP_PRO; ++rep)
    prologue_phase(p, lds, vcu, NGW, wave_s);
#endif
    PHASE_END

    for (int l = 0; l < 4; ++l) {
        for (int half = 0; half < 2; ++half) {
            const int f = 2 * l + half;
            const ss_t* ssin = ss + (size_t)(3 * l + 2 * half) * NTOK * 16;
            ss_t* ssmid = ss + (size_t)(3 * l + 2 * half + 1) * NTOK * 16;
            PHASE_BEGIN {
                pg8::Gemm g{xb, (const bf16_t*)(ws + WS_WGU + f * SZ_GU), NTOK, NGU, DM}; pg8::StaticOrder S; S.init(NTOK, NGU, G, bx);
                fill_rstd_table(lds, ssin, bx, wave_s);
                EpiUp E{act, (const LAS float*)(lds + RS_OFF)};

#ifndef NO_UP
                for (int rep = 0; rep < REP_UP; ++rep)
                pg8::gemm_phase<EpiUp, pg8::StaticOrder, true, GEMM_SP2>(lds, g, S, E, wave_s);
#endif

            } PHASE_END
            PHASE_BEGIN {
                pg8::Gemm g{act, (const bf16_t*)(ws + WS_WDN + f * SZ_DN), NTOK, DM, DFF}; RevOrder S; S.S.init(NTOK, DM, G, bx); S.n = (NTOK / 256) * (DM / 256) / G;
#ifdef REP_DNULL
                { EpiNull EN{(float*)(ws + WS_ROPE)}; pg8::gemm_phase<EpiNull, pg8::StaticOrder, true, true>(lds, g, S, EN, wave_s); }
#endif
                EpiRes E{xb, ssmid, 0.5f};

#ifndef NO_RES
                pg8::gemm_phase<EpiRes, RevOrder, RES_ALIGN, RES_SP2>(lds, g, S, E, wave_s);
#endif

            } PHASE_END
#ifdef SKIP_MIX
            if (false) {
#else
            if (half == 0) {
#endif
                const int e = l >> 1;
                const ss_t* ssmix = ssmid;
                ss_t* ssout = ss + (size_t)(3 * l + 2) * NTOK * 16;
                if ((l & 1) == 0) {
                    PHASE_BEGIN {
                        pg8::Gemm g{xb, (const bf16_t*)(ws + WS_WABIN + e * SZ_ABIN), NTOK, ABIN, DM}; pg8::StaticOrder S; S.init(NTOK, ABIN, G, bx);
                        fill_rstd_table(lds, ssmix, bx, wave_s);
                        EpiAB E{(const LAS float*)(lds + RS_OFF), p.in[I_QN] + e * 64, p.in[I_KN] + e * 64, rope, act};

#ifndef NO_AB
                for (int rep = 0; rep < REP_ABIN; ++rep)
                pg8::gemm_phase<EpiAB, pg8::StaticOrder, true, GEMM_SP2>(lds, g, S, E, wave_s);
#endif

                    } PHASE_END
                    PHASE_BEGIN {

#ifndef NO_AG
                        for (int rep = 0; rep < REP_AG; ++rep)
                        attn_global_phase(lds, act + U_QA, act + U_KA, act + U_VTA, p.in[I_QN] + e * 64, p.in[I_KN] + e * 64, yb, vcu, G, wave_s);
#endif
#ifndef NO_NA
                        for (int rep = 0; rep < REP_NA; ++rep)
                        attn_na_phase(lds, act + U_QB, act + U_KB, act + U_VTB, p.in[I_RPB] + (size_t)e * 8 * 465, yb, vcu, G, wave_s);
#endif

                    } PHASE_END
                } else {
                    PHASE_BEGIN {
                        pg8::Gemm g{xb, (const bf16_t*)(ws + WS_WCDIN + e * SZ_CDIN), NTOK, CDIN, DM}; pg8::StaticOrder S; S.init(NTOK, CDIN, G, bx);
                        fill_rstd_table(lds, ssmix, bx, wave_s);
                        EpiCD E{(const LAS float*)(lds + RS_OFF), act};

#ifndef NO_CDG
                for (int rep = 0; rep < REP_CDIN; ++rep)
                pg8::gemm_phase<EpiCD, pg8::StaticOrder, true, GEMM_SP2>(lds, g, S, E, wave_s);
#endif

                    } PHASE_END
                    PHASE_BEGIN {

#ifndef NO_CD
                        for (int rep = 0; rep < REP_CDC; ++rep)
                        cd_core_phase(lds, act + U_E, act + U_P, act + U_BC, p.in[I_CCW] + (size_t)e * 3 * 512, p.in[I_DCW] + (size_t)e * 31 * 512,
                                      p.in[I_DNG] + e * 512, p.in[I_DNB] + e * 512, yb, vcu, G, wave_s);
#endif

                    } PHASE_END
                }
                PHASE_BEGIN {
                    const size_t woff = (l & 1) ? (WS_WCDOUT + e * SZ_SQ) : (WS_WABOUT + e * SZ_SQ);
                    pg8::Gemm g{yb, (const bf16_t*)(ws + woff), NTOK, DM, DM}; RevOrder S; S.S.init(NTOK, DM, G, bx); S.n = (NTOK / 256) * (DM / 256) / G;
#ifdef REP_OUTFAKE
                    { EpiRes EF{xb, ss + (size_t)13 * NTOK * 16, 1.0f}; pg8::gemm_phase<EpiRes, RevOrder, true, true>(lds, g, S, EF, wave_s); }
#endif
                    EpiRes E{xb, ssout, 1.0f};

#ifndef NO_RES
                pg8::gemm_phase<EpiRes, RevOrder, RES_ALIGN, RES_SP2>(lds, g, S, E, wave_s);
#endif

                } PHASE_END
            }
        }
    }
#ifdef REP_SYNC
    for (int rep = 0; rep < REP_SYNC; ++rep) xcd_barrier(xbar);
#endif
    PHASE_BEGIN final_phase(p.out, xb, ss + (size_t)12 * NTOK * 16, p.in[I_FINAL], vcu, NGW, wave_s); PHASE_END
#undef PHASE_BEGIN
#undef PHASE_END
}

extern "C" void kernel_launch(void* const* d_in, const int* in_sizes, int n_in, void* d_out, int out_size, void* d_ws, size_t ws_size, hipStream_t stream) {
    static int grid = 0;
    if (grid == 0) {
        if (n_in != 18 || in_sizes[0] != NTOK * DM || out_size != NTOK * DM || ws_size < WS_END) {
            fprintf(stderr, "kernel_launch: unexpected shapes (n_in %d, in0 %d, out %d, ws %zu); nothing launched\n", n_in, n_in > 0 ? in_sizes[0] : -1, out_size, ws_size); grid = -1; return; }
        int dev = 0, cus = 0, per_cu = 0;
        hipGetDevice(&dev);
        hipDeviceGetAttribute(&cus, hipDeviceAttributeMultiprocessorCount, dev);
        hipFuncSetAttribute((const void*)mega_fwd, hipFuncAttributeMaxDynamicSharedMemorySize, LDS_BYTES);
        hipOccupancyMaxActiveBlocksPerMultiprocessor(&per_cu, (const void*)mega_fwd, 512, LDS_BYTES);
        if (per_cu < 1) per_cu = 1;
        grid = cus * (per_cu > 1 ? 1 : per_cu);
        if (grid != 256) { fprintf(stderr, "kernel_launch: built for a 256-CU device (got %d workgroups); nothing launched\n", grid); grid = -1; return; }
        (void)hipGetLastError();
    }
    if (grid < 0) return;
    Params p{};
    for (int i = 0; i < 18; ++i) p.in[i] = (const float*)d_in[i];
    p.out = (float*)d_out; p.ws = (unsigned char*)d_ws; p.ph_lo = 0; p.ph_hi = 1000;
    if (hipMemsetAsync((char*)d_ws + WS_BAR, 0, 16384, stream) != hipSuccess) { fprintf(stderr, "kernel_launch: memset of the barrier words failed\n"); return; }
    void* args[] = {&p};
    hipError_t e = hipLaunchCooperativeKernel((const void*)mega_fwd, dim3(grid), dim3(512), args, LDS_BYTES, stream);
    if (e != hipSuccess) fprintf(stderr, "cooperative launch failed: %s (grid %d)\n", hipGetErrorString(e), grid);
}
```

```cpp
#include <hip/hip_runtime.h>
#include <hip/hip_cooperative_groups.h>
#include <cstdio>
#include <cstdint>
#include <utility>
namespace cg = cooperative_groups;
#ifndef PG8_WGM
#define PG8_WGM 8
#endif
namespace pg8 {
#define PG8_LAS __attribute__((address_space(3)))
typedef unsigned short bf16_t;
typedef short bf16x8 __attribute__((ext_vector_type(8)));
typedef float f32x4 __attribute__((ext_vector_type(4)));
typedef unsigned u32x4 __attribute__((ext_vector_type(4)));
constexpr int BM = 256, BK = 64, HALF = 128, HTB = HALF * BK * 2  , STAGE_BYTES = 8 * HTB, NXCD = 8, WGM = PG8_WGM;

__host__ __device__ __forceinline__ int lds_byte(int r, int c) { const int st = (r >> 4) * 2 + (c >> 5), rr = r & 15, cc = c & 31, ob = rr * 64 + cc * 2; return st * 1024 + (ob ^ (((ob >> 9) & 1) << 5)); }
__host__ __device__ __forceinline__ void stage_rc(int b, int& R, int& C) { const int st = b / 1024, sb = b % 1024, swz = sb ^ (((sb >> 9) & 1) << 5); R = (st >> 1) * 16 + swz / 64; C = (st & 1) * 32 + (swz % 64) / 2; }
__host__ __device__ __forceinline__ int perm32(int rho) { const int n = rho >> 4, i = rho & 15; return 8 * (i >> 2) + 4 * n + (i & 3); }

struct Unit { int pm, pn; };
struct Gemm { const bf16_t* A; const bf16_t* Bt; int M, N, K; };

struct StaticOrder {
    int nM, nN, nwg, G, c;
    __host__ __device__ void init(int M, int N, int G_, int c_) { nM = M / BM; nN = N / BM; nwg = nM * nN; G = G_; c = c_; }
    __host__ __device__ bool next(int i, Unit& u) const {
        const long L = (long)i * G + c; if (L >= nwg) return false;
        int wgid = (int)L; { const int q = nwg / NXCD, r = nwg % NXCD, xcd = wgid % NXCD, off = wgid / NXCD; wgid = (xcd < r ? xcd * (q + 1) : r * (q + 1) + (xcd - r) * q) + off; }
        const int nig = WGM * nN, gid = wgid / nig, fm = gid * WGM, gsz = (nM - fm) < WGM ? (nM - fm) : WGM;
        u.pm = fm + ((wgid % nig) % gsz); u.pn = (wgid % nig) / gsz; return true;
    }
    __device__ __forceinline__ void a_ready(const Unit&) const {}
    __device__ __forceinline__ void done(const Unit&) const {}
};

__device__ __forceinline__ unsigned cvt_pk_bf16(float lo, float hi) { unsigned r; asm volatile("v_cvt_pk_bf16_f32 %0, %1, %2" : "=v"(r) : "v"(lo), "v"(hi)); return r; }
typedef float f32x2 __attribute__((ext_vector_type(2)));
template <class Epi, class Sched, bool ALIGN_EPI = false, bool SP2 = false>
__device__ __forceinline__ void gemm_phase(PG8_LAS unsigned char* lds, const Gemm g, const Sched& S, const Epi& E, int wave_s) {
    int tid_; asm volatile("v_mbcnt_lo_u32_b32 %0, -1, 0\n\tv_mbcnt_hi_u32_b32 %0, -1, %0" : "=v"(tid_)); tid_ += wave_s * 64;
    const int tid = tid_, wid = __builtin_amdgcn_readfirstlane(tid >> 6), lane = tid & 63, wr = wid >> 2, wc = wid & 3, fr = lane & 15, fq = lane >> 4;
    const int K = g.K, nt = K / BK;
    unsigned voffA[2], voffB[2];
#pragma unroll
    for (int i = 0; i < 2; ++i) { int R, C; stage_rc(tid * 16 + i * 8192, R, C); const int Rb = Epi::PERM ? ((R & ~31) + perm32(R & 31)) : R;
        voffA[i] = (unsigned)(R * K + C) * 2u; voffB[i] = (unsigned)(Rb * K + C) * 2u; }
    const size_t kstep = (size_t)(BK * 2);
    const size_t hstep = (size_t)HALF * K * 2;
    const size_t tstep = 2 * hstep;
    const unsigned ldsw = (unsigned)wid * 1024u;
    const int aoff = lds_byte(wr * 64 + fr, fq * 8), boff = lds_byte(wc * 32 + fr, fq * 8);
#define PG8_SA(b, h) (((b) * 2 + (h)) * HTB)
#define PG8_SB(b, h) ((4 + (b) * 2 + (h)) * HTB)
#define PG8_STAGE(bufoff, gbase, voff) do { _Pragma("unroll") for (int _i = 0; _i < 2; ++_i) \
        __builtin_amdgcn_global_load_lds((const unsigned*)((const char*)(gbase) + (voff)[_i]), (PG8_LAS unsigned*)(lds + (bufoff) + ldsw + _i * 8192), 16, 0, 0); } while (0)
#define PG8_LDA(dst, b, h) do { _Pragma("unroll") for (int m = 0; m < 4; ++m) _Pragma("unroll") for (int k = 0; k < 2; ++k) dst[m][k] = *(const PG8_LAS bf16x8*)(lds + PG8_SA(b, h) + aoff + m * 2048 + k * 1024); } while (0)
#define PG8_LDB(dst, b, h) do { _Pragma("unroll") for (int n = 0; n < 2; ++n) _Pragma("unroll") for (int k = 0; k < 2; ++k) dst[n][k] = *(const PG8_LAS bf16x8*)(lds + PG8_SB(b, h) + boff + n * 2048 + k * 1024); } while (0)
#define PG8_MMA(ai, bj, At, Bt) do { __builtin_amdgcn_s_setprio(1); _Pragma("unroll") for (int m = 0; m < 4; ++m) _Pragma("unroll") for (int n = 0; n < 2; ++n) _Pragma("unroll") for (int k = 0; k < 2; ++k) \
        acc[ai][bj][m][n] = __builtin_amdgcn_mfma_f32_16x16x32_bf16(Bt[n][k], At[m][k], acc[ai][bj][m][n], 0, 0, 0); __builtin_amdgcn_s_setprio(0); } while (0)
#define PG8_WAIT_V(n) asm volatile("s_waitcnt vmcnt(" #n ")" ::: "memory")
#define PG8_WAIT_L(n) asm volatile("s_waitcnt lgkmcnt(" #n ")" ::: "memory")
#define PG8_BAR __builtin_amdgcn_s_barrier()
#define PG8_SCHED __builtin_amdgcn_sched_barrier(0)
    Unit cur, nxt; int ui = 0;
    if (!S.next(0, cur)) return;
    f32x4 acc[2][2][4][2];
#pragma unroll
    for (int a = 0; a < 2; ++a)
#pragma unroll
        for (int b = 0; b < 2; ++b)
#pragma unroll
            for (int m = 0; m < 4; ++m)
#pragma unroll
                for (int n = 0; n < 2; ++n) acc[a][b][m][n] = (f32x4){0.f, 0.f, 0.f, 0.f};
    bf16x8 At[4][2], B0[2][2], B1[2][2];
    const char* cA = (const char*)g.A + (size_t)cur.pm * tstep; const char* cB = (const char*)g.Bt + (size_t)cur.pn * tstep;
    S.a_ready(cur);
    if constexpr (SP2) {
        PG8_STAGE(PG8_SB(0, 0), cB, voffB); PG8_STAGE(PG8_SB(0, 1), cB + hstep, voffB); PG8_STAGE(PG8_SA(0, 0), cA, voffA); PG8_STAGE(PG8_SA(0, 1), cA + hstep, voffA);
        if (wr == 1) PG8_BAR;
        PG8_WAIT_V(2); PG8_BAR;
        PG8_STAGE(PG8_SB(1, 0), cB + kstep, voffB); PG8_STAGE(PG8_SA(1, 0), cA + kstep, voffA); PG8_STAGE(PG8_SB(1, 1), cB + hstep + kstep, voffB);
        PG8_WAIT_V(6); PG8_BAR;
    } else {
        PG8_STAGE(PG8_SB(0, 0), cB, voffB); PG8_STAGE(PG8_SA(0, 0), cA, voffA); PG8_STAGE(PG8_SB(0, 1), cB + hstep, voffB); PG8_STAGE(PG8_SA(0, 1), cA + hstep, voffA);
        if (wr == 1) PG8_BAR;
        PG8_WAIT_V(4); PG8_BAR;
        PG8_STAGE(PG8_SB(1, 0), cB + kstep, voffB); PG8_STAGE(PG8_SA(1, 0), cA + kstep, voffA); PG8_STAGE(PG8_SB(1, 1), cB + hstep + kstep, voffB);
        PG8_WAIT_V(6); PG8_BAR;
    }
    for (;;) {
        const bool has_next = S.next(ui + 1, nxt);
        const char* nA = has_next ? (const char*)g.A + (size_t)nxt.pm * tstep : cA; const char* nB = has_next ? (const char*)g.Bt + (size_t)nxt.pn * tstep : cB;
        for (int t = 0; t < nt; t += 2) {
            const bool last = (t == nt - 2);
            const char* a1 = cA + (size_t)(t + 1) * kstep;
            const char* a2 = last ? nA : cA + (size_t)(t + 2) * kstep; const char* b2 = last ? nB : cB + (size_t)(t + 2) * kstep;
            const char* a3 = a2 + kstep; const char* b3 = b2 + kstep;
            if (last && has_next) S.a_ready(nxt);
            if constexpr (SP2) {
            PG8_LDB(B0, 0, 0); PG8_LDB(B1, 0, 1); PG8_SCHED; PG8_LDA(At, 0, 0); PG8_STAGE(PG8_SA(1, 1), a1 + hstep, voffA);
            PG8_WAIT_V(8); PG8_WAIT_L(0); PG8_BAR; PG8_MMA(0, 0, At, B0); PG8_MMA(0, 1, At, B1); PG8_BAR; PG8_SCHED;
            PG8_LDA(At, 0, 1); PG8_STAGE(PG8_SB(0, 0), b2, voffB); PG8_STAGE(PG8_SB(0, 1), b2 + hstep, voffB); PG8_STAGE(PG8_SA(0, 0), a2, voffA);
            PG8_WAIT_V(8); PG8_WAIT_L(0); PG8_BAR; PG8_MMA(1, 0, At, B0); PG8_MMA(1, 1, At, B1); PG8_BAR; PG8_SCHED;
            PG8_LDB(B0, 1, 0); PG8_LDB(B1, 1, 1); PG8_SCHED; PG8_LDA(At, 1, 0); PG8_STAGE(PG8_SA(0, 1), a2 + hstep, voffA);
            PG8_WAIT_V(8); PG8_WAIT_L(0); PG8_BAR; PG8_MMA(0, 0, At, B0); PG8_MMA(0, 1, At, B1); PG8_BAR; PG8_SCHED;
            PG8_LDA(At, 1, 1); PG8_STAGE(PG8_SB(1, 0), b3, voffB); PG8_STAGE(PG8_SB(1, 1), b3 + hstep, voffB); PG8_STAGE(PG8_SA(1, 0), a3, voffA);
            PG8_WAIT_V(8); PG8_WAIT_L(0); PG8_BAR; PG8_MMA(1, 0, At, B0); PG8_MMA(1, 1, At, B1); PG8_BAR; PG8_SCHED;
            } else {
            PG8_LDB(B0, 0, 0); PG8_SCHED; PG8_LDA(At, 0, 0); PG8_STAGE(PG8_SA(1, 1), a1 + hstep, voffA);
            PG8_WAIT_L(8); PG8_BAR; PG8_WAIT_L(0); PG8_MMA(0, 0, At, B0); PG8_BAR; PG8_SCHED;
            PG8_LDB(B1, 0, 1); PG8_STAGE(PG8_SB(0, 0), b2, voffB);
            PG8_BAR; PG8_WAIT_L(0); PG8_MMA(0, 1, At, B1); PG8_BAR;
            PG8_LDA(At, 0, 1); PG8_STAGE(PG8_SA(0, 0), a2, voffA);
            PG8_BAR; PG8_WAIT_L(0); PG8_MMA(1, 0, At, B0); PG8_BAR; PG8_SCHED;
            PG8_STAGE(PG8_SB(0, 1), b2 + hstep, voffB);
            PG8_WAIT_V(6); PG8_BAR; PG8_MMA(1, 1, At, B1); PG8_BAR;
            PG8_LDB(B0, 1, 0); PG8_SCHED; PG8_LDA(At, 1, 0); PG8_STAGE(PG8_SA(0, 1), a2 + hstep, voffA);
            PG8_WAIT_L(8); PG8_BAR; PG8_WAIT_L(0); PG8_MMA(0, 0, At, B0); PG8_BAR; PG8_SCHED;
            PG8_LDB(B1, 1, 1); PG8_STAGE(PG8_SB(1, 0), b3, voffB);
            PG8_BAR; PG8_WAIT_L(0); PG8_MMA(0, 1, At, B1); PG8_BAR;
            PG8_LDA(At, 1, 1); PG8_STAGE(PG8_SA(1, 0), a3, voffA);
            PG8_BAR; PG8_WAIT_L(0); PG8_MMA(1, 0, At, B0); PG8_BAR; PG8_SCHED;
            PG8_STAGE(PG8_SB(1, 1), b3 + hstep, voffB);
            PG8_WAIT_V(6); PG8_BAR; PG8_MMA(1, 1, At, B1); PG8_BAR;
            }
        }
        if constexpr (ALIGN_EPI) { if (wr == 0) PG8_BAR; }
        if constexpr (!Epi::AFTER_DRAIN) { E(acc, cur, wr, wc, fr, fq); S.done(cur); }
        if (!has_next) break;
#pragma unroll
        for (int a = 0; a < 2; ++a)
#pragma unroll
            for (int b = 0; b < 2; ++b)
#pragma unroll
                for (int m = 0; m < 4; ++m)
#pragma unroll
                    for (int n = 0; n < 2; ++n) acc[a][b][m][n] = (f32x4){0.f, 0.f, 0.f, 0.f};
        cur = nxt; cA = nA; cB = nB; ++ui;
        if constexpr (ALIGN_EPI) { if (wr == 1) PG8_BAR; }
    }
    PG8_WAIT_V(0);
    if constexpr (!ALIGN_EPI) { if (wr == 0) PG8_BAR; }
    PG8_BAR;
    if constexpr (Epi::AFTER_DRAIN) { E.fused(acc, cur, wr, wc, fr, fq, lds, wid, lane); S.done(cur); }
#undef PG8_SA
#undef PG8_SB
#undef PG8_STAGE
#undef PG8_LDA
#undef PG8_LDB
#undef PG8_MMA
#undef PG8_WAIT_V
#undef PG8_WAIT_L
#undef PG8_BAR
#undef PG8_SCHED
}
}

struct RevOrder {
    pg8::StaticOrder S; int n;
    __device__ bool next(int i, pg8::Unit& u) const { return i < n && S.next(n - 1 - i, u); }
    __device__ __forceinline__ void a_ready(const pg8::Unit&) const {}
    __device__ __forceinline__ void done(const pg8::Unit&) const {}
};

#define LAS __attribute__((address_space(3)))
using pg8::bf16_t; using pg8::bf16x8; using pg8::f32x4; using pg8::u32x4; using pg8::Unit; using pg8::cvt_pk_bf16;
typedef float f32x16 __attribute__((ext_vector_type(16)));
typedef float f32x2 __attribute__((ext_vector_type(2)));
typedef unsigned u32x2 __attribute__((ext_vector_type(2)));

constexpr int NTOK = 65536, DM = 1024, SEQ = 2048, DFF = 2816, NGU = 2 * DFF, ABIN = 2304, CDIN = 2560;
constexpr float EPS = 1e-6f, LOG2E = 1.4426950408889634f;
constexpr size_t MiB = 1u << 20;
constexpr size_t WS_SS = 784 * MiB;
constexpr size_t WS_ROPE = 7 * MiB;
constexpr size_t WS_BAR = 7 * MiB + 512 * 1024;
constexpr size_t WS_W = 8 * MiB;
constexpr size_t SZ_GU = (size_t)NGU * DM * 2, SZ_DN = (size_t)DM * DFF * 2, SZ_ABIN = (size_t)ABIN * DM * 2, SZ_SQ = (size_t)DM * DM * 2, SZ_CDIN = (size_t)CDIN * DM * 2;
constexpr size_t WS_WGU = WS_W, WS_WDN = WS_WGU + 8 * SZ_GU, WS_WABIN = WS_WDN + 8 * SZ_DN, WS_WABOUT = WS_WABIN + 2 * SZ_ABIN,
                 WS_WCDIN = WS_WABOUT + 2 * SZ_SQ, WS_WCDOUT = WS_WCDIN + 2 * SZ_CDIN, WS_WEND = WS_WCDOUT + 2 * SZ_SQ;
static_assert(WS_WEND <= 176 * MiB, "weights");
constexpr size_t WS_XB = 176 * MiB;
constexpr size_t WS_Y = 304 * MiB;
constexpr size_t WS_ACT = 432 * MiB;
constexpr size_t WS_XLO = 784 * MiB;
constexpr size_t WS_END = 912 * MiB;
constexpr size_t U_QA = 0, U_KA = U_QA + (size_t)NTOK * 512, U_VTA = U_KA + (size_t)NTOK * 128, U_QB = U_VTA + (size_t)NTOK * 128,
                 U_KB = U_QB + (size_t)NTOK * 512, U_VTB = U_KB + (size_t)NTOK * 512;
constexpr size_t U_E = 0, U_P = (size_t)NTOK * 512, U_BC = 2 * (size_t)NTOK * 512;

__device__ __forceinline__ float fast_rcp(float x) { return __builtin_amdgcn_rcpf(x); }
__device__ __forceinline__ float fast_exp2(float x) { return __builtin_amdgcn_exp2f(x); }
#ifdef NO_SS
__device__ __forceinline__ float fast_rsq(float x) { return x > 1e30f ? 0.f : 1.0f; }
#else
__device__ __forceinline__ float fast_rsq(float x) { return __builtin_amdgcn_rsqf(x); }
#endif
typedef float ss_t;
constexpr float SS_SCALE = 65536.0f, SS_INV = 1.0f / (65536.0f * 1024.0f);
__device__ __forceinline__ ss_t ss_fix(float q) { return (ss_t)(q * SS_SCALE); }
__device__ __forceinline__ float ss_rstd(const ss_t* rowp) {
    const f32x4 a = *(const f32x4*)rowp, b = *(const f32x4*)(rowp + 4), c = *(const f32x4*)(rowp + 8), d = *(const f32x4*)(rowp + 12);
    const f32x4 t = (a + b) + (c + d);
    return fast_rsq(((t[0] + t[1]) + (t[2] + t[3])) * (1.0f / DM) + 1e-6f);
}
__device__ __forceinline__ float sigmoidf_(float v) { return fast_rcp(1.0f + fast_exp2(-v * LOG2E)); }
__device__ __forceinline__ float siluf_(float v) { return v * sigmoidf_(v); }
__device__ __forceinline__ float bf2f(unsigned short b) { return __uint_as_float(((unsigned)b) << 16); }
__device__ __forceinline__ unsigned short f2bf(float f) { return (unsigned short)(cvt_pk_bf16(f, 0.f) & 0xffffu); }
__device__ __forceinline__ u32x4 pack8(f32x4 a, f32x4 b) { u32x4 w; w.x = cvt_pk_bf16(a[0], a[1]); w.y = cvt_pk_bf16(a[2], a[3]); w.z = cvt_pk_bf16(b[0], b[1]); w.w = cvt_pk_bf16(b[2], b[3]); return w; }

#define EPI_ROW(ai, m) (u.pm * 256 + wr * 64 + fr + (ai) * 128 + (m) * 16)

constexpr int RS_OFF = 131072;
__device__ __forceinline__ void fill_rstd_table(LAS unsigned char* lds, const ss_t* ss, int bx, int wave_s) {
    int tid_; asm volatile("v_mbcnt_lo_u32_b32 %0, -1, 0\n\tv_mbcnt_hi_u32_b32 %0, -1, %0" : "=v"(tid_)); tid_ += wave_s * 64;
    LAS float* tab = (LAS float*)(lds + RS_OFF);
    constexpr int NPAN = 32 / pg8::WGM;
#pragma unroll
    for (int k = 0; k < NPAN / 2; ++k) {
        const int idx = tid_ + 512 * k, j = idx >> 8, rr = idx & 255, pm = pg8::WGM * (NPAN * (bx & 7) + j) + ((bx >> 3) & (pg8::WGM - 1));
        tab[idx] = ss_rstd(ss + (size_t)(pm * 256 + rr) * 16);
    }
    __syncthreads();
}
#define EPI_RS(ai, m) (rs[((u.pm / pg8::WGM) & (32 / pg8::WGM - 1)) * 256 + wr * 64 + fr + (ai) * 128 + (m) * 16])

struct EpiUp {
    static constexpr bool PERM = true, AFTER_DRAIN = false;
    bf16_t* act; const LAS float* rs;
    __device__ __forceinline__ void operator()(const f32x4 (&acc)[2][2][4][2], const Unit& u, int wr, int wc, int fr, int fq) const {
        const unsigned e0 = (unsigned)(u.pm * 256 + wr * 64 + fr) * (unsigned)DFF + (unsigned)(u.pn * 128 + wc * 32 + 8 * fq);
        char* pa = (char*)act;
#pragma unroll
        for (int ai = 0; ai < 2; ++ai)
#pragma unroll
            for (int m = 0; m < 4; ++m) {
                const float r = EPI_RS(ai, m), c1 = -r * LOG2E, r2 = r * r;
                f32x4 h[2];
#pragma unroll
                for (int n = 0; n < 2; ++n) {
                    const f32x4 g = acc[ai][0][m][n], up = acc[ai][1][m][n];
                    const f32x4 ea = g * c1, gu = (g * up) * r2;
                    f32x4 d;
#pragma unroll
                    for (int i = 0; i < 4; ++i) d[i] = fast_exp2(ea[i]);
                    d = d + 1.0f;
#pragma unroll
                    for (int i = 0; i < 4; ++i) d[i] = fast_rcp(d[i]);
                    h[n] = gu * d;
                }
#ifdef ACT_SC1
                { const u32x4 hv = pack8(h[0], h[1]); const char* ap = pa + (size_t)((e0 + (unsigned)((ai * 128 + m * 16) * DFF)) * 2u);
                  asm volatile("global_store_dwordx4 %0, %1, off sc1" :: "v"(ap), "v"(hv) : "memory"); }
#else
                *(u32x4*)(pa + (e0 + (unsigned)((ai * 128 + m * 16) * DFF)) * 2u) = pack8(h[0], h[1]);
#endif
            }
    }
};

__device__ __forceinline__ void unpack8(u32x4 h, u32x4 l, f32x4& a, f32x4& b) {
    a[0] = __uint_as_float(h.x << 16) + __uint_as_float(l.x << 16); a[1] = __uint_as_float(h.x & 0xffff0000u) + __uint_as_float(l.x & 0xffff0000u);
    a[2] = __uint_as_float(h.y << 16) + __uint_as_float(l.y << 16); a[3] = __uint_as_float(h.y & 0xffff0000u) + __uint_as_float(l.y & 0xffff0000u);
    b[0] = __uint_as_float(h.z << 16) + __uint_as_float(l.z << 16); b[1] = __uint_as_float(h.z & 0xffff0000u) + __uint_as_float(l.z & 0xffff0000u);
    b[2] = __uint_as_float(h.w << 16) + __uint_as_float(l.w << 16); b[3] = __uint_as_float(h.w & 0xffff0000u) + __uint_as_float(l.w & 0xffff0000u);
}
__device__ __forceinline__ void split8(f32x4 a, f32x4 b, u32x4& h, u32x4& l) {
    h = pack8(a, b);
    f32x4 ra, rb;
    ra[0] = a[0] - __uint_as_float(h.x << 16); ra[1] = a[1] - __uint_as_float(h.x & 0xffff0000u); ra[2] = a[2] - __uint_as_float(h.y << 16); ra[3] = a[3] - __uint_as_float(h.y & 0xffff0000u);
    rb[0] = b[0] - __uint_as_float(h.z << 16); rb[1] = b[1] - __uint_as_float(h.z & 0xffff0000u); rb[2] = b[2] - __uint_as_float(h.w << 16); rb[3] = b[3] - __uint_as_float(h.w & 0xffff0000u);
    l = pack8(ra, rb);
}
struct EpiRes {
    static constexpr bool PERM = true, AFTER_DRAIN = false;
    bf16_t* xb; ss_t* ss; float alpha;
    __device__ __forceinline__ void operator()(const f32x4 (&acc)[2][2][4][2], const Unit& u, int wr, int wc, int fr, int fq) const {
        const unsigned row0 = (unsigned)(u.pm * 256 + wr * 64 + fr);
        const unsigned e0 = row0 * (unsigned)DM + (unsigned)(u.pn * 256 + wc * 64 + 8 * fq);
        char* ph = (char*)xb;
        u32x4 ch[2], nh[2];
        float qs[8];
#define RES_LOAD(dh, g) do { _Pragma("unroll") for (int bj = 0; bj < 2; ++bj) { const unsigned eo = e0 + (unsigned)((((g) >> 2) * 128 + ((g) & 3) * 16) * DM + bj * 32); \
            dh[bj] = *(const u32x4*)(ph + eo * 2u); } } while (0)
        RES_LOAD(ch, 0);
#pragma unroll
        for (int g = 0; g < 8; ++g) {
            const int ai = g >> 2, m = g & 3;
            if (g < 7) RES_LOAD(nh, g + 1);
            float q = 0.f;
#pragma unroll
            for (int bj = 0; bj < 2; ++bj) {
                const unsigned eo = e0 + (unsigned)((ai * 128 + m * 16) * DM + bj * 32);
                f32x4 x0, x1; unpack8(ch[bj], (u32x4){0u, 0u, 0u, 0u}, x0, x1);
                const f32x4 o0 = x0 + acc[ai][bj][m][0] * alpha, o1 = x1 + acc[ai][bj][m][1] * alpha;
                *(u32x4*)(ph + eo * 2u) = pack8(o0, o1);
                q += (o0[0] * o0[0] + o0[1] * o0[1]) + (o0[2] * o0[2] + o0[3] * o0[3]) + (o1[0] * o1[0] + o1[1] * o1[1]) + (o1[2] * o1[2] + o1[3] * o1[3]);
            }
            q += __shfl_xor(q, 16); q += __shfl_xor(q, 32);
            qs[g] = q;
            asm volatile("" ::: "memory");
#pragma unroll
            for (int bj = 0; bj < 2; ++bj) ch[bj] = nh[bj];
        }
#undef RES_LOAD
        if (fq == 0) {
#pragma unroll
            for (int g = 0; g < 8; ++g) *(float*)((char*)ss + ((row0 + (unsigned)((g >> 2) * 128 + (g & 3) * 16)) * 16u + (unsigned)(u.pn * 4 + wc)) * 4u) = qs[g];
        }
    }
};

struct EpiNull {
    static constexpr bool PERM = true, AFTER_DRAIN = false;
    float* sink;
    __device__ __forceinline__ void operator()(const f32x4 (&acc)[2][2][4][2], const Unit& u, int wr, int wc, int fr, int fq) const {
        float t = 0.f;
#pragma unroll
        for (int ai = 0; ai < 2; ++ai)
#pragma unroll
            for (int bj = 0; bj < 2; ++bj)
#pragma unroll
                for (int m = 0; m < 4; ++m)
#pragma unroll
                    for (int n = 0; n < 2; ++n) t += acc[ai][bj][m][n][0] + acc[ai][bj][m][n][1] + acc[ai][bj][m][n][2] + acc[ai][bj][m][n][3];
        if (t == 1.2345e-30f) sink[0] = t;
    }
};

struct EpiAB {
    static constexpr bool PERM = true, AFTER_DRAIN = false;
    const LAS float* rs; const float* qg; const float* kg; const float* rope; bf16_t* ub;
    __device__ __forceinline__ void operator()(const f32x4 (&acc)[2][2][4][2], const Unit& u, int wr, int wc, int fr, int fq) const {
        const int pn = u.pn;
        int kind, head;
        if (pn < 2) { kind = 0; head = 4 * pn + wc; }
        else if (pn == 2) { if (wc < 2) { kind = 1; head = wc; } else { kind = 2; head = wc - 2; } }
        else if (pn < 5) { kind = 3; head = 4 * (pn - 3) + wc; }
        else if (pn < 7) { kind = 4; head = 4 * (pn - 5) + wc; }
        else { kind = 5; head = 4 * (pn - 7) + wc; }
        if (kind <= 1) {
            const float* g = kind == 0 ? qg : kg;
            f32x4 gv[2][2];
#pragma unroll
            for (int bj = 0; bj < 2; ++bj)
#pragma unroll
                for (int n = 0; n < 2; ++n) gv[bj][n] = *(const f32x4*)(g + 32 * bj + 8 * fq + 4 * n);
            const float osc = kind == 0 ? 0.125f * LOG2E : 1.0f;
            bf16_t* dst = ub + (kind == 0 ? U_QA : U_KA);
            const int ldo = kind == 0 ? 512 : 128;
#pragma unroll
            for (int ai = 0; ai < 2; ++ai)
#pragma unroll
                for (int m = 0; m < 4; ++m) {
                    const int row = EPI_ROW(ai, m);
                    const float r = EPI_RS(ai, m);
                    f32x4 v[2][2]; float q = 0.f;
#pragma unroll
                    for (int bj = 0; bj < 2; ++bj)
#pragma unroll
                        for (int n = 0; n < 2; ++n) { v[bj][n] = acc[ai][bj][m][n] * r; const f32x4 t = v[bj][n]; q += (t[0] * t[0] + t[1] * t[1]) + (t[2] * t[2] + t[3] * t[3]); }
                    q += __shfl_xor(q, 16); q += __shfl_xor(q, 32);
                    const float rn = fast_rsq(q * (1.0f / 64.0f) + EPS) * osc;
                    const int pos = row & (SEQ - 1);
#pragma unroll
                    for (int bj = 0; bj < 2; ++bj) {
                        f32x4 o[2];
#pragma unroll
                        for (int n = 0; n < 2; ++n) {
                            const f32x4 t = v[bj][n] * gv[bj][n] * rn;
                            const f32x4 cs = *(const f32x4*)(rope + ((size_t)pos * 32 + 16 * bj + 4 * fq + 2 * n) * 2);
                            o[n][0] = t[0] * cs[0] - t[1] * cs[1]; o[n][1] = t[0] * cs[1] + t[1] * cs[0];
                            o[n][2] = t[2] * cs[2] - t[3] * cs[3]; o[n][3] = t[2] * cs[3] + t[3] * cs[2];
                        }
                        *(u32x4*)(dst + (size_t)row * ldo + head * 64 + 32 * bj + 8 * fq) = pack8(o[0], o[1]);
                    }
                    asm volatile("" ::: "memory");
                }
        } else if (kind == 3 || kind == 4) {
            const float osc = kind == 3 ? 0.125f * LOG2E : 1.0f;
            bf16_t* dst = ub + (kind == 3 ? U_QB : U_KB);
#pragma unroll
            for (int ai = 0; ai < 2; ++ai)
#pragma unroll
                for (int m = 0; m < 4; ++m) {
                    const int row = EPI_ROW(ai, m);
                    const float r = EPI_RS(ai, m) * osc;
#pragma unroll
                    for (int bj = 0; bj < 2; ++bj)
                        *(u32x4*)(dst + (size_t)row * 512 + head * 64 + 32 * bj + 8 * fq) = pack8(acc[ai][bj][m][0] * r, acc[ai][bj][m][1] * r);
                }
        } else {
            const int nh = kind == 2 ? 2 : 8;
            bf16_t* dst = ub + (kind == 2 ? U_VTA : U_VTB);
#pragma unroll
            for (int ai = 0; ai < 2; ++ai)
#pragma unroll
                for (int m = 0; m < 4; ++m) {
                    const int row = EPI_ROW(ai, m);
                    const float r = EPI_RS(ai, m);
                    const int b = row >> 11, pos = row & (SEQ - 1);
                    bf16_t* base = dst + ((size_t)(b * nh + head) * 64) * SEQ + pos;
#pragma unroll
                    for (int bj = 0; bj < 2; ++bj)
#pragma unroll
                        for (int n = 0; n < 2; ++n) {
                            const f32x4 t = acc[ai][bj][m][n] * r;
                            const unsigned w0 = cvt_pk_bf16(t[0], t[1]), w1 = cvt_pk_bf16(t[2], t[3]);
                            const int d = 32 * bj + 8 * fq + 4 * n;
                            base[(size_t)(d + 0) * SEQ] = (bf16_t)(w0 & 0xffffu); base[(size_t)(d + 1) * SEQ] = (bf16_t)(w0 >> 16);
                            base[(size_t)(d + 2) * SEQ] = (bf16_t)(w1 & 0xffffu); base[(size_t)(d + 3) * SEQ] = (bf16_t)(w1 >> 16);
                        }
                }
        }
    }
};

struct EpiCD {
    static constexpr bool PERM = true, AFTER_DRAIN = false;
    const LAS float* rs; bf16_t* ub;
    __device__ __forceinline__ void operator()(const f32x4 (&acc)[2][2][4][2], const Unit& u, int wr, int wc, int fr, int fq) const {
        const int pn = u.pn;
        const unsigned row0 = (unsigned)(u.pm * 256 + wr * 64 + fr);
        if (pn < 8) {
            char* dst = (char*)(ub + (pn < 4 ? U_E : U_P));
            const unsigned e0 = row0 * 512u + (unsigned)((pn & 3) * 128 + wc * 32 + 8 * fq);
            const bool gate = pn < 4;
#pragma unroll
            for (int ai = 0; ai < 2; ++ai)
#pragma unroll
                for (int m = 0; m < 4; ++m) {
                    const float r = EPI_RS(ai, m);
                    f32x4 h[2];
#pragma unroll
                    for (int n = 0; n < 2; ++n) {
                        const f32x4 a = acc[ai][0][m][n] * r, g = acc[ai][1][m][n] * r;
#pragma unroll
                        for (int i = 0; i < 4; ++i) h[n][i] = a[i] * (gate ? sigmoidf_(g[i]) : g[i]);
                    }
                    *(u32x4*)(dst + (e0 + (unsigned)((ai * 128 + m * 16) * 512)) * 2u) = pack8(h[0], h[1]);
                    asm volatile("" ::: "memory");
                }
        } else {
            char* dst = (char*)(ub + U_BC);
            const unsigned e0 = row0 * 512u + (unsigned)((pn - 8) * 256 + wc * 32 + 8 * fq);
#pragma unroll
            for (int ai = 0; ai < 2; ++ai)
#pragma unroll
                for (int m = 0; m < 4; ++m) {
                    const float r = EPI_RS(ai, m);
#pragma unroll
                    for (int bj = 0; bj < 2; ++bj)
                        *(u32x4*)(dst + (e0 + (unsigned)((ai * 128 + m * 16) * 512 + bj * 128)) * 2u) = pack8(acc[ai][bj][m][0] * r, acc[ai][bj][m][1] * r);
                    asm volatile("" ::: "memory");
                }
        }
    }
};

__device__ __forceinline__ float wave_sum(float v) {
#pragma unroll
    for (int o = 1; o < 64; o <<= 1) v += __shfl_xor(v, o);
    return v;
}
__device__ __forceinline__ void transpose_item(const float* src, int ldw, const float* gain, bf16_t* dst, int K, int k0, LAS float* scr, int lane) {
    float tv[32];
#pragma unroll
    for (int i = 0; i < 32; ++i) { const int kk = 2 * i + (lane >> 5); tv[i] = src[(size_t)(k0 + kk) * ldw + (lane & 31)]; }
#pragma unroll
    for (int i = 0; i < 32; ++i) { const int kk = 2 * i + (lane >> 5); float v = tv[i]; if (gain) v *= gain[k0 + kk]; scr[kk * 33 + (lane & 31)] = v; }
    asm volatile("s_waitcnt lgkmcnt(0)" ::: "memory");
    const int c = lane & 7;
#pragma unroll
    for (int j = 0; j < 4; ++j) { const int n = (lane >> 3) + 8 * j; const LAS float* s = scr + (8 * c) * 33 + n;
        u32x4 o; o.x = cvt_pk_bf16(s[0 * 33], s[1 * 33]); o.y = cvt_pk_bf16(s[2 * 33], s[3 * 33]); o.z = cvt_pk_bf16(s[4 * 33], s[5 * 33]); o.w = cvt_pk_bf16(s[6 * 33], s[7 * 33]);
        *(u32x4*)(dst + (size_t)n * K + k0 + 8 * c) = o; }
    asm volatile("s_waitcnt lgkmcnt(0)" ::: "memory");
}

struct Params {
    const float* in[18];
    float* out; unsigned char* ws;
    int ph_lo, ph_hi;
};
enum { I_X = 0, I_FFN_NORM, I_MIX_NORM, I_WG, I_WU, I_WD, I_ABIN, I_ABOUT, I_QN, I_KN, I_RPB, I_CDIN, I_CDOUT, I_CCW, I_DCW, I_DNG, I_DNB, I_FINAL };

#define RESCOL(nb) (256 * ((nb) >> 3) + 64 * ((nb) & 3) + 32 * (((nb) >> 2) & 1))
__device__ __forceinline__ void prologue_phase(const Params& p, LAS unsigned char* lds, int vcu, int NGW, int wave_s) {
    int tid_; asm volatile("v_mbcnt_lo_u32_b32 %0, -1, 0\n\tv_mbcnt_hi_u32_b32 %0, -1, %0" : "=v"(tid_)); tid_ += wave_s * 64;
    const int lane = tid_ & 63, wave = __builtin_amdgcn_readfirstlane(tid_ >> 6), gw = vcu * 8 + wave;
    unsigned char* ws = p.ws;
    ss_t* ss = (ss_t*)(ws + WS_SS);
    {
        const float* x = p.in[I_X]; bf16_t* xb = (bf16_t*)(ws + WS_XB);
        for (int row0 = gw; row0 < NTOK; row0 += 2 * NGW) {
            f32x4 v[2][4]; float sq[2];
#pragma unroll
            for (int k = 0; k < 2; ++k) { const f32x4* xr = (const f32x4*)(x + (size_t)(row0 + k * NGW) * DM) + lane;
#pragma unroll
                for (int j = 0; j < 4; ++j) v[k][j] = xr[64 * j]; }
#pragma unroll
            for (int k = 0; k < 2; ++k) {
                const int row = row0 + k * NGW; float s = 0.f;
#pragma unroll
                for (int j = 0; j < 4; ++j) s += (v[k][j][0] * v[k][j][0] + v[k][j][1] * v[k][j][1]) + (v[k][j][2] * v[k][j][2] + v[k][j][3] * v[k][j][3]);
                sq[k] = wave_sum(s);
                u32x2* o = (u32x2*)(xb + (size_t)row * DM) + lane;
#pragma unroll
                for (int j = 0; j < 4; ++j) { u32x2 w; w.x = cvt_pk_bf16(v[k][j][0], v[k][j][1]); w.y = cvt_pk_bf16(v[k][j][2], v[k][j][3]); o[64 * j] = w; }
                if (lane < 16) ss[(size_t)row * 16 + lane] = lane == 0 ? sq[k] : 0.f;
            }
        }
    }
    {
        float* rope = (float*)(ws + WS_ROPE);
        for (int idx = gw * 64 + lane; idx < SEQ * 32; idx += NGW * 64) {
            const int pos = idx >> 5, pr = idx & 31, j = pr & 15;
            const float coord = pr < 16 ? (float)(pos >> 6) : (float)(pos & 63);
            const float freq = fast_exp2(-(float)(2 * j) * (1.0f / 32.0f) * 13.287712379549449f);
            const float ang = coord * freq;
            float sn, cs; __sincosf(ang, &sn, &cs);
            rope[2 * idx] = cs; rope[2 * idx + 1] = sn;
        }
    }
    {
        LAS float* scr = (LAS float*)(lds + wave * 16384);
        constexpr int IT_GU = 16 * (NGU / 32), IT_DN = (DFF / 64) * 32, IT_ABIN = 16 * (ABIN / 32), IT_SQ = 16 * 32, IT_CDIN = 16 * (CDIN / 32);
        constexpr int IT_FFN = IT_GU + IT_DN, IT_AB = IT_ABIN + IT_SQ, IT_CD = IT_CDIN + IT_SQ;
        constexpr int NITEMS = 8 * IT_FFN + 2 * IT_AB + 2 * IT_CD;
        for (int it = gw; it < NITEMS; it += NGW) {
            int r = it;
            if (r < 8 * IT_FFN) {
                const int f = r / IT_FFN; r -= f * IT_FFN;
                if (r < IT_GU) {
                    const int nb = r % (NGU / 32), kb = r / (NGU / 32);
                    const int pn = nb >> 3, bj = (nb >> 2) & 1, j0 = 32 * (nb & 3);
                    const float* W = (bj ? p.in[I_WU] : p.in[I_WG]) + (size_t)f * DM * DFF + 128 * pn + j0;
                    transpose_item(W, DFF, p.in[I_FFN_NORM] + f * DM, (bf16_t*)(ws + WS_WGU + f * SZ_GU) + (size_t)(32 * nb) * DM, DM, 64 * kb, scr, lane);
                } else {
                    r -= IT_GU; const int nb = r % 32, kb = r / 32;
                    transpose_item(p.in[I_WD] + (size_t)f * DFF * DM + RESCOL(nb), DM, nullptr, (bf16_t*)(ws + WS_WDN + f * SZ_DN) + (size_t)(32 * nb) * DFF, DFF, 64 * kb, scr, lane);
                }
                continue;
            }
            r -= 8 * IT_FFN;
            if (r < 2 * IT_AB) {
                const int e = r / IT_AB; r -= e * IT_AB;
                if (r < IT_ABIN) {
                    const int nb = r % (ABIN / 32), kb = r / (ABIN / 32);
                    const int pn = nb >> 3, bj = (nb >> 2) & 1, wc = nb & 3;
                    transpose_item(p.in[I_ABIN] + (size_t)e * DM * ABIN + 256 * pn + 64 * wc + 32 * bj, ABIN, p.in[I_MIX_NORM] + (2 * e) * DM,
                                   (bf16_t*)(ws + WS_WABIN + e * SZ_ABIN) + (size_t)(32 * nb) * DM, DM, 64 * kb, scr, lane);
                } else {
                    r -= IT_ABIN; const int nb = r % 32, kb = r / 32;
                    transpose_item(p.in[I_ABOUT] + (size_t)e * DM * DM + RESCOL(nb), DM, nullptr, (bf16_t*)(ws + WS_WABOUT + e * SZ_SQ) + (size_t)(32 * nb) * DM, DM, 64 * kb, scr, lane);
                }
                continue;
            }
            r -= 2 * IT_AB;
            {
                const int e = r / IT_CD; r -= e * IT_CD;
                if (r < IT_CDIN) {
                    const int nb = r % (CDIN / 32), kb = r / (CDIN / 32);
                    const int pn = nb >> 3, bj = (nb >> 2) & 1, j0 = 32 * (nb & 3);
                    int scol;
                    if (pn < 4) scol = (bj ? 2048 : 1536) + 128 * pn + j0;
                    else if (pn < 8) scol = (bj ? 0 : 1024) + 128 * (pn - 4) + j0;
                    else scol = 512 + 256 * (pn - 8) + 128 * bj + j0;
                    transpose_item(p.in[I_CDIN] + (size_t)e * DM * CDIN + scol, CDIN, p.in[I_MIX_NORM] + (2 * e + 1) * DM,
                                   (bf16_t*)(ws + WS_WCDIN + e * SZ_CDIN) + (size_t)(32 * nb) * DM, DM, 64 * kb, scr, lane);
                } else {
                    r -= IT_CDIN; const int nb = r % 32, kb = r / 32;
                    transpose_item(p.in[I_CDOUT] + (size_t)e * DM * DM + RESCOL(nb), DM, nullptr, (bf16_t*)(ws + WS_WCDOUT + e * SZ_SQ) + (size_t)(32 * nb) * DM, DM, 64 * kb, scr, lane);
                }
            }
        }
    }
}

__device__ __forceinline__ void attn_global_phase(LAS unsigned char* lds, const bf16_t* Qa, const bf16_t* Ka, const bf16_t* Vta, const float* qg, const float* kg, bf16_t* y, int vcu, int G, int wave_s) {
    constexpr int PITCH = 144, TILEB = 64 * PITCH, BUFB = 2 * TILEB;
    float negCB;
    {
        int l_; asm volatile("v_mbcnt_lo_u32_b32 %0, -1, 0\n\tv_mbcnt_hi_u32_b32 %0, -1, %0" : "=v"(l_));
        float gq = fabsf(qg[l_]), gk = fabsf(kg[l_]);
#pragma unroll
        for (int o = 1; o < 64; o <<= 1) { gq = fmaxf(gq, __shfl_xor(gq, o)); gk = fmaxf(gk, __shfl_xor(gk, o)); }
        negCB = -(64.0f * 0.125f * LOG2E * 1.01f * gq * gk + 0.125f);
    }
    for (int un_ = vcu; un_ < 32 * 8 * 4; un_ += G) {
        const int un = 32 * 8 * 4 - 1 - un_;
        int tid_; asm volatile("v_mbcnt_lo_u32_b32 %0, -1, 0\n\tv_mbcnt_hi_u32_b32 %0, -1, %0" : "=v"(tid_)); tid_ += wave_s * 64;
        const int tid = tid_, lane = tid & 63, wid = __builtin_amdgcn_readfirstlane(tid >> 6), ql = lane & 31, hi = lane >> 5;
        const int srow = tid >> 3, sch = tid & 7;
        const int pik = (ql & 19) | ((ql & 4) << 1) | ((ql & 8) >> 1);
        const int qb = un & 3, h4 = (un >> 2) & 3, kvh = (un >> 4) & 1, b = un >> 5, h = kvh * 4 + h4;
        const int tok0 = b * SEQ + qb * 512 + wid * 64 + ql;
        const bf16_t* qp = Qa + (size_t)tok0 * 512 + h * 64 + hi * 8;
        bf16x8 qf[2][4];
#pragma unroll
        for (int t = 0; t < 2; ++t)
#pragma unroll
            for (int dc = 0; dc < 4; ++dc) qf[t][dc] = *(const bf16x8*)(qp + (size_t)t * 32 * 512 + dc * 16);
        const bf16_t* kg_ = Ka + (size_t)(b * SEQ + srow) * 128 + kvh * 64 + sch * 8;
        const bf16_t* vg_ = Vta + ((size_t)(b * 2 + kvh) * 64 + srow) * SEQ + sch * 8;
        f32x16 o[2][2];
#pragma unroll
        for (int t = 0; t < 2; ++t)
#pragma unroll
            for (int r = 0; r < 16; ++r) { o[t][0][r] = 0.f; o[t][1][r] = 0.f; }
        float lrun[2] = {0.f, 0.f};
        u32x4 kreg = *(const u32x4*)kg_, vreg = *(const u32x4*)vg_;
        __syncthreads();
        *(LAS u32x4*)(lds + srow * PITCH + sch * 16) = kreg; *(LAS u32x4*)(lds + TILEB + srow * PITCH + sch * 16) = vreg;
        __syncthreads();
        for (int kt = 0; kt < SEQ / 64; ++kt) {
            if (kt + 1 < SEQ / 64) { kreg = *(const u32x4*)(kg_ + (size_t)(kt + 1) * 64 * 128); vreg = *(const u32x4*)(vg_ + (kt + 1) * 64); }
            const LAS unsigned char* Kb_ = lds + (kt & 1) * BUFB; const LAS unsigned char* Vb_ = Kb_ + TILEB;
            f32x16 p[2][2];
#pragma unroll
            for (int t = 0; t < 2; ++t)
#pragma unroll
                for (int r = 0; r < 16; ++r) { p[t][0][r] = negCB; p[t][1][r] = negCB; }
#pragma unroll
            for (int dc = 0; dc < 4; ++dc) {
                const bf16x8 a0 = *(const LAS bf16x8*)(Kb_ + pik * PITCH + dc * 32 + hi * 16);
                const bf16x8 a1 = *(const LAS bf16x8*)(Kb_ + (32 + pik) * PITCH + dc * 32 + hi * 16);
#pragma unroll
                for (int t = 0; t < 2; ++t) {
                    p[t][0] = __builtin_amdgcn_mfma_f32_32x32x16_bf16(a0, qf[t][dc], p[t][0], 0, 0, 0);
                    p[t][1] = __builtin_amdgcn_mfma_f32_32x32x16_bf16(a1, qf[t][dc], p[t][1], 0, 0, 0);
                }
            }
            __builtin_amdgcn_sched_barrier(0);
            u32x4 pw[2][2][2];
#pragma unroll
            for (int t = 0; t < 2; ++t) {
                float sum = 0.f;
#pragma unroll
                for (int r = 0; r < 16; ++r) { p[t][0][r] = fast_exp2(p[t][0][r]); p[t][1][r] = fast_exp2(p[t][1][r]); sum += p[t][0][r] + p[t][1][r]; }
                lrun[t] += sum;
#pragma unroll
                for (int kb = 0; kb < 2; ++kb)
#pragma unroll
                    for (int c = 0; c < 2; ++c) {
                        pw[t][kb][c].x = cvt_pk_bf16(p[t][kb][8 * c + 0], p[t][kb][8 * c + 1]); pw[t][kb][c].y = cvt_pk_bf16(p[t][kb][8 * c + 2], p[t][kb][8 * c + 3]);
                        pw[t][kb][c].z = cvt_pk_bf16(p[t][kb][8 * c + 4], p[t][kb][8 * c + 5]); pw[t][kb][c].w = cvt_pk_bf16(p[t][kb][8 * c + 6], p[t][kb][8 * c + 7]);
                    }
            }
            __builtin_amdgcn_sched_barrier(0);
#pragma unroll
            for (int kb = 0; kb < 2; ++kb)
#pragma unroll
                for (int c = 0; c < 2; ++c) {
                    const bf16x8 v0 = *(const LAS bf16x8*)(Vb_ + ql * PITCH + (32 * kb + 16 * c + 8 * hi) * 2);
                    const bf16x8 v1 = *(const LAS bf16x8*)(Vb_ + (32 + ql) * PITCH + (32 * kb + 16 * c + 8 * hi) * 2);
#pragma unroll
                    for (int t = 0; t < 2; ++t) {
                        const bf16x8 pb = __builtin_bit_cast(bf16x8, pw[t][kb][c]);
                        o[t][0] = __builtin_amdgcn_mfma_f32_32x32x16_bf16(v0, pb, o[t][0], 0, 0, 0);
                        o[t][1] = __builtin_amdgcn_mfma_f32_32x32x16_bf16(v1, pb, o[t][1], 0, 0, 0);
                    }
                }
            if (kt + 1 < SEQ / 64) {
                LAS unsigned char* nb = lds + ((kt + 1) & 1) * BUFB;
                *(LAS u32x4*)(nb + srow * PITCH + sch * 16) = kreg; *(LAS u32x4*)(nb + TILEB + srow * PITCH + sch * 16) = vreg;
            }
            __syncthreads();
        }
#pragma unroll
        for (int t = 0; t < 2; ++t) {
            float l = lrun[t]; l += __shfl_xor(l, 32);
            const float inv = fast_rcp(l);
            bf16_t* yp = y + (size_t)(tok0 + 32 * t) * DM + h * 64 + 4 * hi;
#pragma unroll
            for (int g = 0; g < 4; ++g) {
                u32x2 w0, w1;
                w0.x = cvt_pk_bf16(o[t][0][4 * g] * inv, o[t][0][4 * g + 1] * inv); w0.y = cvt_pk_bf16(o[t][0][4 * g + 2] * inv, o[t][0][4 * g + 3] * inv);
                w1.x = cvt_pk_bf16(o[t][1][4 * g] * inv, o[t][1][4 * g + 1] * inv); w1.y = cvt_pk_bf16(o[t][1][4 * g + 2] * inv, o[t][1][4 * g + 3] * inv);
                *(u32x2*)(yp + 8 * g) = w0; *(u32x2*)(yp + 32 + 8 * g) = w1;
            }
        }
    }
}

constexpr int NA_TAB = 0, NA_K = 2048, NA_KP = 144, NA_V = NA_K + 576 * NA_KP, NA_VP = 1168, NA_END = NA_V + 64 * NA_VP;
__device__ __forceinline__ void attn_na_phase(LAS unsigned char* lds, const bf16_t* Qb, const bf16_t* Kb, const bf16_t* Vtb, const float* rpb, bf16_t* y, int vcu, int G, int wave_s) {
    int tid_; asm volatile("v_mbcnt_lo_u32_b32 %0, -1, 0\n\tv_mbcnt_hi_u32_b32 %0, -1, %0" : "=v"(tid_)); tid_ += wave_s * 64;
    const int tid = tid_, lane = tid & 63, wid = __builtin_amdgcn_readfirstlane(tid >> 6), ql = lane & 15, quad = lane >> 4;
    LAS float* tab = (LAS float*)(lds + NA_TAB);
    const int srow = tid >> 3, sch = tid & 7;
    u32x4 kreg[9], vreg[9];
#define NA_FETCH(unx) do { const int rp_ = (unx) & 15, h_ = ((unx) >> 4) & 7, b_ = (unx) >> 7; \
        const int rs0_ = min(max(2 * rp_ - 4, 0), 24), rs1_ = min(max(2 * rp_ - 3, 0), 24), nrows_ = rs1_ + 8 - rs0_; \
        const bf16_t* kg = Kb + (size_t)(b_ * SEQ + rs0_ * 64 + srow) * 512 + h_ * 64 + sch * 8; \
        const bf16_t* vg = Vtb + ((size_t)(b_ * 8 + h_) * 64 + srow) * SEQ + rs0_ * 64 + sch * 8; \
        _Pragma("unroll") for (int i = 0; i < 8; ++i) { kreg[i] = *(const u32x4*)(kg + (size_t)i * 64 * 512); vreg[i] = *(const u32x4*)(vg + i * 64); } \
        if (nrows_ > 8) { kreg[8] = *(const u32x4*)(kg + (size_t)8 * 64 * 512); vreg[8] = *(const u32x4*)(vg + 8 * 64); } \
        else { kreg[8] = (u32x4){0u, 0u, 0u, 0u}; vreg[8] = kreg[8]; } } while (0)
    if (vcu < 32 * 8 * 16) NA_FETCH(32 * 8 * 16 - 1 - vcu);
    for (int un_ = vcu; un_ < 32 * 8 * 16; un_ += G) {
        const int un = 32 * 8 * 16 - 1 - un_;
        const int rp = un & 15, h = (un >> 4) & 7, b = un >> 7;
        const int rs0 = min(max(2 * rp - 4, 0), 24);
        const int r = rp * 2 + (wid >> 2), n = wid & 3;
        const int rs = min(max(r - 4, 0), 24), kcol0 = min(max(16 * n - 8, 0), 32), ro = rs - rs0;
        const int qcol = 16 * n + ql, wcs = min(max(qcol - 8, 0), 48);
        const int tokq = b * SEQ + r * 64 + qcol;
        bf16x8 qf[2];
#pragma unroll
        for (int dc = 0; dc < 2; ++dc) qf[dc] = *(const bf16x8*)(Qb + (size_t)tokq * 512 + h * 64 + 32 * dc + 8 * quad);
        __syncthreads();
        for (int i = tid; i < 465; i += 512) tab[i] = rpb[h * 465 + i] * LOG2E;
#pragma unroll
        for (int i = 0; i < 9; ++i) {
            *(LAS u32x4*)(lds + NA_K + (i * 64 + srow) * NA_KP + sch * 16) = kreg[i];
            *(LAS u32x4*)(lds + NA_V + srow * NA_VP + (i * 64 + sch * 8) * 2) = vreg[i];
        }
        __syncthreads();
        if (un_ + G < 32 * 8 * 16) NA_FETCH(32 * 8 * 16 - 1 - (un_ + G));
        const int sw = wcs - kcol0;
        bool v0[4]; int cosel[4];
#pragma unroll
        for (int i = 0; i < 4; ++i) { const int x = 4 * quad + i; v0[i] = x >= sw; const int kc = kcol0 + x + (v0[i] ? 0 : 16); cosel[i] = min(max(kc - qcol + 15, 0), 30); }
        const LAS unsigned char* kbase = lds + NA_K + ((ro * 64 + kcol0 + ql) * NA_KP) + quad * 16;
        const LAS unsigned char* vbase = lds + NA_V + ql * NA_VP + (ro * 64 + kcol0 + 4 * quad) * 2;
        f32x4 s[8];
        float mx = -1e30f;
#pragma unroll
        for (int w = 0; w < 8; ++w) {
            const int rowoff = (rs + w - r + 7) * 31;
            f32x4 a[2];
#pragma unroll
            for (int ch = 0; ch < 2; ++ch) {
                const bf16x8 k0 = *(const LAS bf16x8*)(kbase + (w * 64 + 16 * ch) * NA_KP), k1 = *(const LAS bf16x8*)(kbase + (w * 64 + 16 * ch) * NA_KP + 64);
                a[ch] = (f32x4){0.f, 0.f, 0.f, 0.f};
                a[ch] = __builtin_amdgcn_mfma_f32_16x16x32_bf16(k0, qf[0], a[ch], 0, 0, 0);
                a[ch] = __builtin_amdgcn_mfma_f32_16x16x32_bf16(k1, qf[1], a[ch], 0, 0, 0);
            }
#pragma unroll
            for (int i = 0; i < 4; ++i) { const float v = (v0[i] ? a[0][i] : a[1][i]) + tab[rowoff + cosel[i]]; s[w][i] = v; mx = fmaxf(mx, v); }
        }
        mx = fmaxf(mx, __shfl_xor(mx, 16)); mx = fmaxf(mx, __shfl_xor(mx, 32));
        float l = 0.f;
#pragma unroll
        for (int w = 0; w < 8; ++w)
#pragma unroll
            for (int i = 0; i < 4; ++i) { const float e = fast_exp2(s[w][i] - mx); s[w][i] = e; l += e; }
        l += __shfl_xor(l, 16); l += __shfl_xor(l, 32);
        f32x4 o[4];
#pragma unroll
        for (int dt = 0; dt < 4; ++dt) o[dt] = (f32x4){0.f, 0.f, 0.f, 0.f};
#pragma unroll
        for (int w = 0; w < 8; ++w) {
            f32x4 p0, p1;
#pragma unroll
            for (int i = 0; i < 4; ++i) { p0[i] = v0[i] ? s[w][i] : 0.f; p1[i] = v0[i] ? 0.f : s[w][i]; }
            const bf16x8 pb = __builtin_bit_cast(bf16x8, pack8(p0, p1));
#pragma unroll
            for (int dt = 0; dt < 4; ++dt) {
                const u32x2 lo = *(const LAS u32x2*)(vbase + (16 * dt) * NA_VP + w * 128), hi2 = *(const LAS u32x2*)(vbase + (16 * dt) * NA_VP + w * 128 + 32);
                const u32x4 av = {lo.x, lo.y, hi2.x, hi2.y};
                o[dt] = __builtin_amdgcn_mfma_f32_16x16x32_bf16(__builtin_bit_cast(bf16x8, av), pb, o[dt], 0, 0, 0);
            }
        }
        const float inv = fast_rcp(l);
        bf16_t* yp = y + (size_t)tokq * DM + 512 + h * 64 + 4 * quad;
#pragma unroll
        for (int dt = 0; dt < 4; ++dt) { u32x2 w2; w2.x = cvt_pk_bf16(o[dt][0] * inv, o[dt][1] * inv); w2.y = cvt_pk_bf16(o[dt][2] * inv, o[dt][3] * inv); *(u32x2*)(yp + 16 * dt) = w2; }
    }
}

__device__ __forceinline__ float dpp_add(float v, float acc, const int ctrl, const int row_mask) { return acc; }
#define DPP_STEP(v, ctrl, rmask) (v) += __builtin_bit_cast(float, __builtin_amdgcn_update_dpp(0, __builtin_bit_cast(int, (v)), (ctrl), (rmask), 0xf, false))
__device__ __forceinline__ float wave_sum63(float v) {
    DPP_STEP(v, 0xB1, 0xf);
    DPP_STEP(v, 0x4E, 0xf);
    DPP_STEP(v, 0x114, 0xf);
    DPP_STEP(v, 0x118, 0xf);
    DPP_STEP(v, 0x142, 0xa);
    DPP_STEP(v, 0x143, 0xc);
    return v;
}
#undef NA_FETCH
template <int I> __device__ __forceinline__ void conv31_step(f32x2 (&acc)[32], const f32x2 (&wd)[31], const LAS unsigned char* base) {
    const unsigned raw = *(const LAS unsigned*)(base + I * 1024);
    const f32x2 v = {__uint_as_float(raw << 16), __uint_as_float(raw & 0xffff0000u)};
    constexpr int TLO = I - 30 > 0 ? I - 30 : 0, THI = I < 31 ? I : 31;
#pragma unroll
    for (int t = TLO; t <= THI; ++t) acc[t] += v * wd[I - t];
}
template <int... Is> __device__ __forceinline__ void conv31_all(f32x2 (&acc)[32], const f32x2 (&wd)[31], const LAS unsigned char* base, std::integer_sequence<int, Is...>) {
    (conv31_step<Is>(acc, wd, base), ...);
}
__device__ __forceinline__ void cd_core_phase(LAS unsigned char* lds, const bf16_t* E, const bf16_t* P, const bf16_t* Bc, const float* ccw, const float* dcw,
                                              const float* lng, const float* lnb, bf16_t* y, int vcu, int G, int wave_s) {
    constexpr int ROWS = 94, ROWB = 1024, PART_OFF = 96 * ROWB;
    LAS f32x2* part = (LAS f32x2*)(lds + PART_OFF);
    for (int un_ = vcu; un_ < NTOK / 64; un_ += G) {
        const int un = NTOK / 64 - 1 - un_;
        int tid_; asm volatile("v_mbcnt_lo_u32_b32 %0, -1, 0\n\tv_mbcnt_hi_u32_b32 %0, -1, %0" : "=v"(tid_)); tid_ += wave_s * 64;
        const int tid = tid_, lane = tid & 63, wid = __builtin_amdgcn_readfirstlane(tid >> 6), cp = tid & 255, th = tid >> 8, c0 = 2 * cp;
        const int t0 = un * 64, p0 = t0 & (SEQ - 1);
        __syncthreads();
        {
            u32x4 ev[12];
#pragma unroll
            for (int j = 0; j < 12; ++j) {
                const int c = tid + 512 * j, i = c >> 6, cc = c & 63, pos = p0 - 15 + i;
                ev[j] = (u32x4){0u, 0u, 0u, 0u};
                if (i < ROWS && pos >= 0 && pos < SEQ) ev[j] = *(const u32x4*)(E + (size_t)(t0 - 15 + i) * 512 + cc * 8);
            }
#pragma unroll
            for (int j = 0; j < 12; ++j) { const int c = tid + 512 * j, i = c >> 6, cc = c & 63; if (i < ROWS) *(LAS u32x4*)(lds + i * ROWB + cc * 16) = ev[j]; }
        }
        __syncthreads();
        f32x2 acc[32];
        {
            f32x2 wd[31];
#pragma unroll
            for (int k = 0; k < 31; ++k) wd[k] = *(const f32x2*)(dcw + k * 512 + c0);
#pragma unroll
            for (int t = 0; t < 32; ++t) acc[t] = (f32x2){0.f, 0.f};
            conv31_all(acc, wd, lds + (32 * th) * ROWB + cp * 4, std::make_integer_sequence<int, 62>{});
        }
        unsigned pr[34], br[32];
#pragma unroll
        for (int t = 0; t < 32; ++t) asm volatile("" : "+v"(acc[t]));
        {
            const int tokb = t0 + 32 * th, posb = p0 + 32 * th;
#pragma unroll
            for (int j = 0; j < 34; ++j) {
                const int pos = posb - 1 + j; const bool ok = (pos >= 0 && pos < SEQ);
                const unsigned v = *(const unsigned*)(P + (size_t)(ok ? tokb - 1 + j : tokb) * 512 + c0);
                pr[j] = ok ? v : 0u;
            }
#pragma unroll
            for (int j = 0; j < 32; ++j) br[j] = *(const unsigned*)(Bc + (size_t)(tokb + j) * 512 + c0);
        }
#ifdef REP_STATS
        for (int rep = 0; rep < REP_STATS; ++rep)
#endif
#pragma unroll
        for (int t = 0; t < 32; ++t) {
            float s1 = acc[t][0] + acc[t][1], s2 = acc[t][0] * acc[t][0] + acc[t][1] * acc[t][1];
            s1 = wave_sum63(s1); s2 = wave_sum63(s2);
            if (lane == 63) part[(32 * th + t) * 4 + (wid & 3)] = (f32x2){s1, s2};
        }
        __syncthreads();
        const f32x2 w0 = *(const f32x2*)(ccw + c0), w1 = *(const f32x2*)(ccw + 512 + c0), w2 = *(const f32x2*)(ccw + 1024 + c0);
        const f32x2 gg = *(const f32x2*)(lng + c0), bb = *(const f32x2*)(lnb + c0);
#pragma unroll
        for (int t = 0; t < 32; ++t) {
            const int tok = t0 + 32 * th + t;
            const f32x2 a = part[(32 * th + t) * 4 + 0], b2 = part[(32 * th + t) * 4 + 1], c2 = part[(32 * th + t) * 4 + 2], d2 = part[(32 * th + t) * 4 + 3];
            const float mean = ((a[0] + b2[0]) + (c2[0] + d2[0])) * (1.0f / 512.0f);
            const float var = ((a[1] + b2[1]) + (c2[1] + d2[1])) * (1.0f / 512.0f) - mean * mean;
            const float rstd = fast_rsq(fmaxf(var, 0.f) + EPS);
            const float z0 = (acc[t][0] - mean) * rstd * gg[0] + bb[0], z1 = (acc[t][1] - mean) * rstd * gg[1] + bb[1];
            *(unsigned*)(y + (size_t)tok * DM + 512 + c0) = cvt_pk_bf16(siluf_(z0), siluf_(z1));
            const unsigned rm = pr[t], rc = pr[t + 1], rp = pr[t + 2], rb = br[t];
            const float y0 = __uint_as_float(rb << 16) * (__uint_as_float(rm << 16) * w0[0] + __uint_as_float(rc << 16) * w1[0] + __uint_as_float(rp << 16) * w2[0]);
            const float y1 = __uint_as_float(rb & 0xffff0000u) * (__uint_as_float(rm & 0xffff0000u) * w0[1] + __uint_as_float(rc & 0xffff0000u) * w1[1] + __uint_as_float(rp & 0xffff0000u) * w2[1]);
            *(unsigned*)(y + (size_t)tok * DM + c0) = cvt_pk_bf16(y0, y1);
        }
    }
}

__device__ __forceinline__ void final_phase(float* out, const bf16_t* xb, const ss_t* ss, const float* g, int vcu, int NGW, int wave_s) {
    int tid_; asm volatile("v_mbcnt_lo_u32_b32 %0, -1, 0\n\tv_mbcnt_hi_u32_b32 %0, -1, %0" : "=v"(tid_)); tid_ += wave_s * 64;
    const int lane = tid_ & 63, gw = vcu * 8 + __builtin_amdgcn_readfirstlane(tid_ >> 6);
    f32x4 gv[2][2];
#pragma unroll
    for (int j = 0; j < 2; ++j) { gv[j][0] = *(const f32x4*)(g + 512 * j + 8 * lane); gv[j][1] = *(const f32x4*)(g + 512 * j + 8 * lane + 4); }
    for (int row0 = gw; row0 < NTOK; row0 += 2 * NGW) {
        u32x4 xv[2][2]; float r[2];
#pragma unroll
        for (int k = 0; k < 2; ++k) { const int row = row0 + k * NGW; r[k] = ss_rstd(ss + (size_t)row * 16);
#pragma unroll
            for (int j = 0; j < 2; ++j) xv[k][j] = *(const u32x4*)(xb + (size_t)row * DM + 512 * j + 8 * lane); }
#pragma unroll
        for (int k = 0; k < 2; ++k)
#pragma unroll
            for (int j = 0; j < 2; ++j) {
                const size_t off = (size_t)(row0 + k * NGW) * DM + 512 * j + 8 * lane;
                f32x4 a, b; unpack8(xv[k][j], (u32x4){0u, 0u, 0u, 0u}, a, b);
                *(f32x4*)(out + off) = a * r[k] * gv[j][0]; *(f32x4*)(out + off + 4) = b * r[k] * gv[j][1];
            }
    }
}

#ifndef GEMM_SP2
#define GEMM_SP2 true
#endif
#ifndef RES_SP2
#define RES_SP2 true
#endif
#ifndef RES_ALIGN
#define RES_ALIGN true
#endif
#ifndef REP_UP
#define REP_UP 1
#endif
#ifndef REP_ABIN
#define REP_ABIN 1
#endif
#ifndef REP_CDIN
#define REP_CDIN 1
#endif
#ifndef REP_AG
#define REP_AG 1
#endif
#ifndef REP_NA
#define REP_NA 1
#endif
#ifndef REP_CDC
#define REP_CDC 1
#endif
#ifndef REP_PRO
#define REP_PRO 1
#endif
#define XB_TMO      128
#define XB_XCNT(j)  (256  + 64 * (j))
#define XB_XSUB(j)  (1280 + 64 * (j))
#define XB_XGEN(j)  (2304 + 64 * (j))
#define XB_TOP      3328
#define XB_TOPGEN   3392
#define XCD_BAR_WORDS 3456
#define XB_SPIN_CAP (1u << 18)

__device__ __forceinline__ unsigned xb_ld(unsigned* p)              { return __hip_atomic_load(p, __ATOMIC_RELAXED, __HIP_MEMORY_SCOPE_AGENT); }
__device__ __forceinline__ unsigned xb_add(unsigned* p, unsigned v) { return __hip_atomic_fetch_add(p, v, __ATOMIC_RELAXED, __HIP_MEMORY_SCOPE_AGENT); }
__device__ __forceinline__ unsigned xb_xcc_id() { return (unsigned)__builtin_amdgcn_s_getreg((3 << 11) | 20) & 0xFu; }
#define XB_SPIN(cond, bar) do { unsigned _sp = 0; while (cond) { __builtin_amdgcn_s_sleep(1); \
    if ((++_sp & 255u) == 0u) { if (xb_ld(&(bar)[XB_TMO])) break; if (_sp > XB_SPIN_CAP) { atomicAdd(&(bar)[XB_TMO], 1u); break; } } } } while (0)

struct XcdBarrier {
    unsigned* bar; unsigned x;
    volatile LAS unsigned* st;
};

__device__ __forceinline__ XcdBarrier xcd_barrier_post(unsigned* bar, volatile LAS unsigned* st) {
    XcdBarrier b; b.bar = bar; b.x = xb_xcc_id(); b.st = st;
    if (threadIdx.x == 0) (void)xb_add(&bar[XB_XCNT(b.x)], 1u);
    return b;
}
__device__ __forceinline__ void xcd_barrier_complete(unsigned* bar, unsigned x, unsigned& nloc, unsigned& nx) {
    const unsigned G = gridDim.x * gridDim.y * gridDim.z;
    unsigned sum, cnt, mine, sp = 0u;
    for (;;) {
        sum = 0u; cnt = 0u; mine = 0u;
#pragma unroll
        for (unsigned j = 0; j < 16; ++j) { const unsigned c = xb_ld(&bar[XB_XCNT(j)]); sum += c; cnt += (c > 0u) ? 1u : 0u; mine = (j == x) ? c : mine; }
        if (sum == G) break;
        __builtin_amdgcn_s_sleep(1);
        if ((++sp & 255u) == 0u) { if (xb_ld(&bar[XB_TMO])) break; if (sp > XB_SPIN_CAP) { atomicAdd(&bar[XB_TMO], 1u); break; } }
    }
    nloc = mine > 0u ? mine : 1u; nx = cnt > 0u ? cnt : 1u;
}

__device__ __forceinline__ void xcd_barrier(const XcdBarrier& b) {
    asm volatile("s_waitcnt vmcnt(0)" ::: "memory");
    __syncthreads();
    if (threadIdx.x == 0) {
        unsigned* bar = b.bar;
        __builtin_amdgcn_s_waitcnt(0);
        unsigned nloc = b.st[0], nx = b.st[1];
        if (nloc == 0u) { xcd_barrier_complete(bar, b.x, nloc, nx); b.st[0] = nloc; b.st[1] = nx; }
        const unsigned old = xb_add(&bar[XB_XSUB(b.x)], 1u);
        const unsigned gen = old / nloc;
        if (old + 1u == (gen + 1u) * nloc) {
            __builtin_amdgcn_fence(__ATOMIC_RELEASE, "agent");
            asm volatile("s_waitcnt vmcnt(0)" ::: "memory");
            const unsigned og = xb_add(&bar[XB_TOP], 1u);
            const unsigned tg = og / nx;
            if (og + 1u == (tg + 1u) * nx) xb_add(&bar[XB_TOPGEN], 1u);
            else XB_SPIN(xb_ld(&bar[XB_TOPGEN]) == tg, bar);
            __builtin_amdgcn_fence(__ATOMIC_ACQUIRE, "agent");
            xb_add(&bar[XB_XGEN(b.x)], 1u);
            asm volatile("s_waitcnt vmcnt(0)" ::: "memory");
        } else {
            XB_SPIN(xb_ld(&bar[XB_XGEN(b.x)]) == gen, bar);
            __builtin_amdgcn_fence(__ATOMIC_ACQUIRE, "agent");
            asm volatile("s_waitcnt vmcnt(0)" ::: "memory");
        }
    }
    __syncthreads();
}

constexpr int LDS_BYTES = 163840;
static_assert(NA_END <= LDS_BYTES - 64, "NA tiles vs LDS");
__global__ void __launch_bounds__(512, 2) mega_fwd(Params p) {
    extern __shared__ __attribute__((aligned(16))) unsigned char lds_raw[];
    LAS unsigned char* lds = (LAS unsigned char*)lds_raw;
    cg::grid_group grid = cg::this_grid();
    const int G = gridDim.x, bx = blockIdx.x;
    const int wave_s = __builtin_amdgcn_readfirstlane((int)threadIdx.x >> 6);
    const int vcu = (G % 8 == 0) ? (bx % 8) * (G / 8) + bx / 8 : bx;
    const int NGW = G * 8;
    unsigned char* ws = p.ws;
    ss_t* ss = (ss_t*)(ws + WS_SS);
    bf16_t* xb = (bf16_t*)(ws + WS_XB); bf16_t* yb = (bf16_t*)(ws + WS_Y); bf16_t* act = (bf16_t*)(ws + WS_ACT);
    const float* rope = (const float*)(ws + WS_ROPE);
    volatile LAS unsigned* bst = (volatile LAS unsigned*)(lds + LDS_BYTES - 64);
    if (threadIdx.x < 2) bst[threadIdx.x] = 0u;
    __syncthreads();
    XcdBarrier xbar = xcd_barrier_post((unsigned*)(ws + WS_BAR), bst);
    int ph = 0;
#define PHASE_BEGIN if (ph >= p.ph_lo && ph < p.ph_hi) {
#define PHASE_END   if (ph + 1 < p.ph_hi) { if (p.ph_lo < 0) { asm volatile("s_waitcnt vmcnt(0)" ::: "memory"); grid.sync(); __builtin_amdgcn_fence(__ATOMIC_ACQUIRE, "agent"); asm volatile("s_waitcnt vmcnt(0)" ::: "memory"); } else xcd_barrier(xbar); } } ++ph;

    PHASE_BEGIN
#ifndef NO_PRO
    for (int rep = 0; rep < REP_PRO; ++rep)
    prologue_phase(p, lds, vcu, NGW, wave_s);
#endif
    PHASE_END

    for (int l = 0; l < 4; ++l) {
        for (int half = 0; half < 2; ++half) {
            const int f = 2 * l + half;
            const ss_t* ssin = ss + (size_t)(3 * l + 2 * half) * NTOK * 16;
            ss_t* ssmid = ss + (size_t)(3 * l + 2 * half + 1) * NTOK * 16;
            PHASE_BEGIN {
                pg8::Gemm g{xb, (const bf16_t*)(ws + WS_WGU + f * SZ_GU), NTOK, NGU, DM}; pg8::StaticOrder S; S.init(NTOK, NGU, G, bx);
                fill_rstd_table(lds, ssin, bx, wave_s);
                EpiUp E{act, (const LAS float*)(lds + RS_OFF)};

#ifndef NO_UP
                for (int rep = 0; rep < REP_UP; ++rep)
                pg8::gemm_phase<EpiUp, pg8::StaticOrder, true, GEMM_SP2>(lds, g, S, E, wave_s);
#endif

            } PHASE_END
            PHASE_BEGIN {
                pg8::Gemm g{act, (const bf16_t*)(ws + WS_WDN + f * SZ_DN), NTOK, DM, DFF}; RevOrder S; S.S.init(NTOK, DM, G, bx); S.n = (NTOK / 256) * (DM / 256) / G;
#ifdef REP_DNULL
                { EpiNull EN{(float*)(ws + WS_ROPE)}; pg8::gemm_phase<EpiNull, pg8::StaticOrder, true, true>(lds, g, S, EN, wave_s); }
#endif
                EpiRes E{xb, ssmid, 0.5f};

#ifndef NO_RES
                pg8::gemm_phase<EpiRes, RevOrder, RES_ALIGN, RES_SP2>(lds, g, S, E, wave_s);
#endif

            } PHASE_END
#ifdef SKIP_MIX
            if (false) {
#else
            if (half == 0) {
#endif
                const int e = l >> 1;
                const ss_t* ssmix = ssmid;
                ss_t* ssout = ss + (size_t)(3 * l + 2) * NTOK * 16;
                if ((l & 1) == 0) {
                    PHASE_BEGIN {
                        pg8::Gemm g{xb, (const bf16_t*)(ws + WS_WABIN + e * SZ_ABIN), NTOK, ABIN, DM}; pg8::StaticOrder S; S.init(NTOK, ABIN, G, bx);
                        fill_rstd_table(lds, ssmix, bx, wave_s);
                        EpiAB E{(const LAS float*)(lds + RS_OFF), p.in[I_QN] + e * 64, p.in[I_KN] + e * 64, rope, act};

#ifndef NO_AB
                for (int rep = 0; rep < REP_ABIN; ++rep)
                pg8::gemm_phase<EpiAB, pg8::StaticOrder, true, GEMM_SP2>(lds, g, S, E, wave_s);
#endif

                    } PHASE_END
                    PHASE_BEGIN {

#ifndef NO_AG
                        for (int rep = 0; rep < REP_AG; ++rep)
                        attn_global_phase(lds, act + U_QA, act + U_KA, act + U_VTA, p.in[I_QN] + e * 64, p.in[I_KN] + e * 64, yb, vcu, G, wave_s);
#endif
#ifndef NO_NA
                        for (int rep = 0; rep < REP_NA; ++rep)
                        attn_na_phase(lds, act + U_QB, act + U_KB, act + U_VTB, p.in[I_RPB] + (size_t)e * 8 * 465, yb, vcu, G, wave_s);
#endif

                    } PHASE_END
                } else {
                    PHASE_BEGIN {
                        pg8::Gemm g{xb, (const bf16_t*)(ws + WS_WCDIN + e * SZ_CDIN), NTOK, CDIN, DM}; pg8::StaticOrder S; S.init(NTOK, CDIN, G, bx);
                        fill_rstd_table(lds, ssmix, bx, wave_s);
                        EpiCD E{(const LAS float*)(lds + RS_OFF), act};

#ifndef NO_CDG
                for (int rep = 0; rep < REP_CDIN; ++rep)
                pg8::gemm_phase<EpiCD, pg8::StaticOrder, true, GEMM_SP2>(lds, g, S, E, wave_s);
#endif

                    } PHASE_END
                    PHASE_BEGIN {

#ifndef NO_CD
                        for (int rep = 0; rep < REP_CDC; ++rep)
                        cd_core_phase(lds, act + U_E, act + U_P, act + U_BC, p.in[I_CCW] + (size_t)e * 3 * 512, p.in[I_DCW] + (size_t)e * 31 * 512,
                                      p.in[I_DNG] + e * 512, p.in[I_DNB] + e * 512, yb, vcu, G, wave_s);
#endif

                    } PHASE_END
                }
                PHASE_BEGIN {
                    const size_t woff = (l & 1) ? (WS_WCDOUT + e * SZ_SQ) : (WS_WABOUT + e * SZ_SQ);
                    pg8::Gemm g{yb, (const bf16_t*)(ws + woff), NTOK, DM, DM}; RevOrder S; S.S.init(NTOK, DM, G, bx); S.n = (NTOK / 256) * (DM / 256) / G;
#ifdef REP_OUTFAKE
                    { EpiRes EF{xb, ss + (size_t)13 * NTOK * 16, 1.0f}; pg8::gemm_phase<EpiRes, RevOrder, true, true>(lds, g, S, EF, wave_s); }
#endif
                    EpiRes E{xb, ssout, 1.0f};

#ifndef NO_RES
                pg8::gemm_phase<EpiRes, RevOrder, RES_ALIGN, RES_SP2>(lds, g, S, E, wave_s);
#endif

                } PHASE_END
            }
        }
    }
#ifdef REP_SYNC
    for (int rep = 0; rep < REP_SYNC; ++rep) xcd_barrier(xbar);
#endif
    PHASE_BEGIN final_phase(p.out, xb, ss + (size_t)12 * NTOK * 16, p.in[I_FINAL], vcu, NGW, wave_s); PHASE_END
#undef PHASE_BEGIN
#undef PHASE_END
}

extern "C" void kernel_launch(void* const* d_in, const int* in_sizes, int n_in, void* d_out, int out_size, void* d_ws, size_t ws_size, hipStream_t stream) {
    static int grid = 0;
    if (grid == 0) {
        if (n_in != 18 || in_sizes[0] != NTOK * DM || out_size != NTOK * DM || ws_size < WS_END) {
            fprintf(stderr, "kernel_launch: unexpected shapes (n_in %d, in0 %d, out %d, ws %zu); nothing launched\n", n_in, n_in > 0 ? in_sizes[0] : -1, out_size, ws_size); grid = -1; return; }
        int dev = 0, cus = 0, per_cu = 0;
        hipGetDevice(&dev);
        hipDeviceGetAttribute(&cus, hipDeviceAttributeMultiprocessorCount, dev);
        hipFuncSetAttribute((const void*)mega_fwd, hipFuncAttributeMaxDynamicSharedMemorySize, LDS_BYTES);
        hipOccupancyMaxActiveBlocksPerMultiprocessor(&per_cu, (const void*)mega_fwd, 512, LDS_BYTES);
        if (per_cu < 1) per_cu = 1;
        grid = cus * (per_cu > 1 ? 1 : per_cu);
        if (grid != 256) { fprintf(stderr, "kernel_launch: built for a 256-CU device (got %d workgroups); nothing launched\n", grid); grid = -1; return; }
        (void)hipGetLastError();
    }
    if (grid < 0) return;
    Params p{};
    for (int i = 0; i < 18; ++i) p.in[i] = (const float*)d_in[i];
    p.out = (float*)d_out; p.ws = (unsigned char*)d_ws; p.ph_lo = 0; p.ph_hi = 1000;
    if (hipMemsetAsync((char*)d_ws + WS_BAR, 0, 16384, stream) != hipSuccess) { fprintf(stderr, "kernel_launch: memset of the barrier words failed\n"); return; }
    void* args[] = {&p};
    hipError_t e = hipLaunchCooperativeKernel((const void*)mega_fwd, dim3(grid), dim3(512), args, LDS_BYTES, stream);
    if (e != hipSuccess) fprintf(stderr, "cooperative launch failed: %s (grid %d)\n", hipGetErrorString(e), grid);
}
```

```cpp
#include <hip/hip_runtime.h>
#include <hip/hip_cooperative_groups.h>
#include <cstdio>
#include <cstdint>
#include <utility>
namespace cg = cooperative_groups;
#ifndef PG8_WGM
#define PG8_WGM 8
#endif
namespace pg8 {
#define PG8_LAS __attribute__((address_space(3)))
typedef unsigned short bf16_t;
typedef short bf16x8 __attribute__((ext_vector_type(8)));
typedef float f32x4 __attribute__((ext_vector_type(4)));
typedef unsigned u32x4 __attribute__((ext_vector_type(4)));
constexpr int BM = 256, BK = 64, HALF = 128, HTB = HALF * BK * 2  , STAGE_BYTES = 8 * HTB, NXCD = 8, WGM = PG8_WGM;

__host__ __device__ __forceinline__ int lds_byte(int r, int c) { const int st = (r >> 4) * 2 + (c >> 5), rr = r & 15, cc = c & 31, ob = rr * 64 + cc * 2; return st * 1024 + (ob ^ (((ob >> 9) & 1) << 5)); }
__host__ __device__ __forceinline__ void stage_rc(int b, int& R, int& C) { const int st = b / 1024, sb = b % 1024, swz = sb ^ (((sb >> 9) & 1) << 5); R = (st >> 1) * 16 + swz / 64; C = (st & 1) * 32 + (swz % 64) / 2; }
__host__ __device__ __forceinline__ int perm32(int rho) { const int n = rho >> 4, i = rho & 15; return 8 * (i >> 2) + 4 * n + (i & 3); }

struct Unit { int pm, pn; };
struct Gemm { const bf16_t* A; const bf16_t* Bt; int M, N, K; };

struct StaticOrder {
    int nM, nN, nwg, G, c;
    __host__ __device__ void init(int M, int N, int G_, int c_) { nM = M / BM; nN = N / BM; nwg = nM * nN; G = G_; c = c_; }
    __host__ __device__ bool next(int i, Unit& u) const {
        const long L = (long)i * G + c; if (L >= nwg) return false;
        int wgid = (int)L; { const int q = nwg / NXCD, r = nwg % NXCD, xcd = wgid % NXCD, off = wgid / NXCD; wgid = (xcd < r ? xcd * (q + 1) : r * (q + 1) + (xcd - r) * q) + off; }
        const int nig = WGM * nN, gid = wgid / nig, fm = gid * WGM, gsz = (nM - fm) < WGM ? (nM - fm) : WGM;
        u.pm = fm + ((wgid % nig) % gsz); u.pn = (wgid % nig) / gsz; return true;
    }
    __device__ __forceinline__ void a_ready(const Unit&) const {}
    __device__ __forceinline__ void done(const Unit&) const {}
};

__device__ __forceinline__ unsigned cvt_pk_bf16(float lo, float hi) { unsigned r; asm volatile("v_cvt_pk_bf16_f32 %0, %1, %2" : "=v"(r) : "v"(lo), "v"(hi)); return r; }
typedef float f32x2 __attribute__((ext_vector_type(2)));
template <class Epi, class Sched, bool ALIGN_EPI = false, bool SP2 = false>
__device__ __forceinline__ void gemm_phase(PG8_LAS unsigned char* lds, const Gemm g, const Sched& S, const Epi& E, int wave_s) {
    int tid_; asm volatile("v_mbcnt_lo_u32_b32 %0, -1, 0\n\tv_mbcnt_hi_u32_b32 %0, -1, %0" : "=v"(tid_)); tid_ += wave_s * 64;
    const int tid = tid_, wid = __builtin_amdgcn_readfirstlane(tid >> 6), lane = tid & 63, wr = wid >> 2, wc = wid & 3, fr = lane & 15, fq = lane >> 4;
    const int K = g.K, nt = K / BK;
    unsigned voffA[2], voffB[2];
#pragma unroll
    for (int i = 0; i < 2; ++i) { int R, C; stage_rc(tid * 16 + i * 8192, R, C); const int Rb = Epi::PERM ? ((R & ~31) + perm32(R & 31)) : R;
        voffA[i] = (unsigned)(R * K + C) * 2u; voffB[i] = (unsigned)(Rb * K + C) * 2u; }
    const size_t kstep = (size_t)(BK * 2);
    const size_t hstep = (size_t)HALF * K * 2;
    const size_t tstep = 2 * hstep;
    const unsigned ldsw = (unsigned)wid * 1024u;
    const int aoff = lds_byte(wr * 64 + fr, fq * 8), boff = lds_byte(wc * 32 + fr, fq * 8);
#define PG8_SA(b, h) (((b) * 2 + (h)) * HTB)
#define PG8_SB(b, h) ((4 + (b) * 2 + (h)) * HTB)
#define PG8_STAGE(bufoff, gbase, voff) do { _Pragma("unroll") for (int _i = 0; _i < 2; ++_i) \
        __builtin_amdgcn_global_load_lds((const unsigned*)((const char*)(gbase) + (voff)[_i]), (PG8_LAS unsigned*)(lds + (bufoff) + ldsw + _i * 8192), 16, 0, 0); } while (0)
#define PG8_LDA(dst, b, h) do { _Pragma("unroll") for (int m = 0; m < 4; ++m) _Pragma("unroll") for (int k = 0; k < 2; ++k) dst[m][k] = *(const PG8_LAS bf16x8*)(lds + PG8_SA(b, h) + aoff + m * 2048 + k * 1024); } while (0)
#define PG8_LDB(dst, b, h) do { _Pragma("unroll") for (int n = 0; n < 2; ++n) _Pragma("unroll") for (int k = 0; k < 2; ++k) dst[n][k] = *(const PG8_LAS bf16x8*)(lds + PG8_SB(b, h) + boff + n * 2048 + k * 1024); } while (0)
#define PG8_MMA(ai, bj, At, Bt) do { __builtin_amdgcn_s_setprio(1); _Pragma("unroll") for (int m = 0; m < 4; ++m) _Pragma("unroll") for (int n = 0; n < 2; ++n) _Pragma("unroll") for (int k = 0; k < 2; ++k) \
        acc[ai][bj][m][n] = __builtin_amdgcn_mfma_f32_16x16x32_bf16(Bt[n][k], At[m][k], acc[ai][bj][m][n], 0, 0, 0); __builtin_amdgcn_s_setprio(0); } while (0)
#define PG8_WAIT_V(n) asm volatile("s_waitcnt vmcnt(" #n ")" ::: "memory")
#define PG8_WAIT_L(n) asm volatile("s_waitcnt lgkmcnt(" #n ")" ::: "memory")
#define PG8_BAR __builtin_amdgcn_s_barrier()
#define PG8_SCHED __builtin_amdgcn_sched_barrier(0)
    Unit cur, nxt; int ui = 0;
    if (!S.next(0, cur)) return;
    f32x4 acc[2][2][4][2];
#pragma unroll
    for (int a = 0; a < 2; ++a)
#pragma unroll
        for (int b = 0; b < 2; ++b)
#pragma unroll
            for (int m = 0; m < 4; ++m)
#pragma unroll
                for (int n = 0; n < 2; ++n) acc[a][b][m][n] = (f32x4){0.f, 0.f, 0.f, 0.f};
    bf16x8 At[4][2], B0[2][2], B1[2][2];
    const char* cA = (const char*)g.A + (size_t)cur.pm * tstep; const char* cB = (const char*)g.Bt + (size_t)cur.pn * tstep;
    S.a_ready(cur);
    if constexpr (SP2) {
        PG8_STAGE(PG8_SB(0, 0), cB, voffB); PG8_STAGE(PG8_SB(0, 1), cB + hstep, voffB); PG8_STAGE(PG8_SA(0, 0), cA, voffA); PG8_STAGE(PG8_SA(0, 1), cA + hstep, voffA);
        if (wr == 1) PG8_BAR;
        PG8_WAIT_V(2); PG8_BAR;
        PG8_STAGE(PG8_SB(1, 0), cB + kstep, voffB); PG8_STAGE(PG8_SA(1, 0), cA + kstep, voffA); PG8_STAGE(PG8_SB(1, 1), cB + hstep + kstep, voffB);
        PG8_WAIT_V(6); PG8_BAR;
    } else {
        PG8_STAGE(PG8_SB(0, 0), cB, voffB); PG8_STAGE(PG8_SA(0, 0), cA, voffA); PG8_STAGE(PG8_SB(0, 1), cB + hstep, voffB); PG8_STAGE(PG8_SA(0, 1), cA + hstep, voffA);
        if (wr == 1) PG8_BAR;
        PG8_WAIT_V(4); PG8_BAR;
        PG8_STAGE(PG8_SB(1, 0), cB + kstep, voffB); PG8_STAGE(PG8_SA(1, 0), cA + kstep, voffA); PG8_STAGE(PG8_SB(1, 1), cB + hstep + kstep, voffB);
        PG8_WAIT_V(6); PG8_BAR;
    }
    for (;;) {
        const bool has_next = S.next(ui + 1, nxt);
        const char* nA = has_next ? (const char*)g.A + (size_t)nxt.pm * tstep : cA; const char* nB = has_next ? (const char*)g.Bt + (size_t)nxt.pn * tstep : cB;
        for (int t = 0; t < nt; t += 2) {
            const bool last = (t == nt - 2);
            const char* a1 = cA + (size_t)(t + 1) * kstep;
            const char* a2 = last ? nA : cA + (size_t)(t + 2) * kstep; const char* b2 = last ? nB : cB + (size_t)(t + 2) * kstep;
            const char* a3 = a2 + kstep; const char* b3 = b2 + kstep;
            if (last && has_next) S.a_ready(nxt);
            if constexpr (SP2) {
            PG8_LDB(B0, 0, 0); PG8_LDB(B1, 0, 1); PG8_SCHED; PG8_LDA(At, 0, 0); PG8_STAGE(PG8_SA(1, 1), a1 + hstep, voffA);
            PG8_WAIT_V(8); PG8_WAIT_L(0); PG8_BAR; PG8_MMA(0, 0, At, B0); PG8_MMA(0, 1, At, B1); PG8_BAR; PG8_SCHED;
            PG8_LDA(At, 0, 1); PG8_STAGE(PG8_SB(0, 0), b2, voffB); PG8_STAGE(PG8_SB(0, 1), b2 + hstep, voffB); PG8_STAGE(PG8_SA(0, 0), a2, voffA);
            PG8_WAIT_V(8); PG8_WAIT_L(0); PG8_BAR; PG8_MMA(1, 0, At, B0); PG8_MMA(1, 1, At, B1); PG8_BAR; PG8_SCHED;
            PG8_LDB(B0, 1, 0); PG8_LDB(B1, 1, 1); PG8_SCHED; PG8_LDA(At, 1, 0); PG8_STAGE(PG8_SA(0, 1), a2 + hstep, voffA);
            PG8_WAIT_V(8); PG8_WAIT_L(0); PG8_BAR; PG8_MMA(0, 0, At, B0); PG8_MMA(0, 1, At, B1); PG8_BAR; PG8_SCHED;
            PG8_LDA(At, 1, 1); PG8_STAGE(PG8_SB(1, 0), b3, voffB); PG8_STAGE(PG8_SB(1, 1), b3 + hstep, voffB); PG8_STAGE(PG8_SA(1, 0), a3, voffA);
            PG8_WAIT_V(8); PG8_WAIT_L(0); PG8_BAR; PG8_MMA(1, 0, At, B0); PG8_MMA(1, 1, At, B1); PG8_BAR; PG8_SCHED;
            } else {
            PG8_LDB(B0, 0, 0); PG8_SCHED; PG8_LDA(At, 0, 0); PG8_STAGE(PG8_SA(1, 1), a1 + hstep, voffA);
            PG8_WAIT_L(8); PG8_BAR; PG8_WAIT_L(0); PG8_MMA(0, 0, At, B0); PG8_BAR; PG8_SCHED;
            PG8_LDB(B1, 0, 1); PG8_STAGE(PG8_SB(0, 0), b2, voffB);
            PG8_BAR; PG8_WAIT_L(0); PG8_MMA(0, 1, At, B1); PG8_BAR;
            PG8_LDA(At, 0, 1); PG8_STAGE(PG8_SA(0, 0), a2, voffA);
            PG8_BAR; PG8_WAIT_L(0); PG8_MMA(1, 0, At, B0); PG8_BAR; PG8_SCHED;
            PG8_STAGE(PG8_SB(0, 1), b2 + hstep, voffB);
            PG8_WAIT_V(6); PG8_BAR; PG8_MMA(1, 1, At, B1); PG8_BAR;
            PG8_LDB(B0, 1, 0); PG8_SCHED; PG8_LDA(At, 1, 0); PG8_STAGE(PG8_SA(0, 1), a2 + hstep, voffA);
            PG8_WAIT_L(8); PG8_BAR; PG8_WAIT_L(0); PG8_MMA(0, 0, At, B0); PG8_BAR; PG8_SCHED;
            PG8_LDB(B1, 1, 1); PG8_STAGE(PG8_SB(1, 0), b3, voffB);
            PG8_BAR; PG8_WAIT_L(0); PG8_MMA(0, 1, At, B1); PG8_BAR;
            PG8_LDA(At, 1, 1); PG8_STAGE(PG8_SA(1, 0), a3, voffA);
            PG8_BAR; PG8_WAIT_L(0); PG8_MMA(1, 0, At, B0); PG8_BAR; PG8_SCHED;
            PG8_STAGE(PG8_SB(1, 1), b3 + hstep, voffB);
            PG8_WAIT_V(6); PG8_BAR; PG8_MMA(1, 1, At, B1); PG8_BAR;
            }
        }
        if constexpr (ALIGN_EPI) { if (wr == 0) PG8_BAR; }
        if constexpr (!Epi::AFTER_DRAIN) { E(acc, cur, wr, wc, fr, fq); S.done(cur); }
        if (!has_next) break;
#pragma unroll
        for (int a = 0; a < 2; ++a)
#pragma unroll
            for (int b = 0; b < 2; ++b)
#pragma unroll
                for (int m = 0; m < 4; ++m)
#pragma unroll
                    for (int n = 0; n < 2; ++n) acc[a][b][m][n] = (f32x4){0.f, 0.f, 0.f, 0.f};
        cur = nxt; cA = nA; cB = nB; ++ui;
        if constexpr (ALIGN_EPI) { if (wr == 1) PG8_BAR; }
    }
    PG8_WAIT_V(0);
    if constexpr (!ALIGN_EPI) { if (wr == 0) PG8_BAR; }
    PG8_BAR;
    if constexpr (Epi::AFTER_DRAIN) { E.fused(acc, cur, wr, wc, fr, fq, lds, wid, lane); S.done(cur); }
#undef PG8_SA
#undef PG8_SB
#undef PG8_STAGE
#undef PG8_LDA
#undef PG8_LDB
#undef PG8_MMA
#undef PG8_WAIT_V
#undef PG8_WAIT_L
#undef PG8_BAR
#undef PG8_SCHED
}
}

struct RevOrder {
    pg8::StaticOrder S; int n;
    __device__ bool next(int i, pg8::Unit& u) const { return i < n && S.next(n - 1 - i, u); }
    __device__ __forceinline__ void a_ready(const pg8::Unit&) const {}
    __device__ __forceinline__ void done(const pg8::Unit&) const {}
};

#define LAS __attribute__((address_space(3)))
using pg8::bf16_t; using pg8::bf16x8; using pg8::f32x4; using pg8::u32x4; using pg8::Unit; using pg8::cvt_pk_bf16;
typedef float f32x16 __attribute__((ext_vector_type(16)));
typedef float f32x2 __attribute__((ext_vector_type(2)));
typedef unsigned u32x2 __attribute__((ext_vector_type(2)));

constexpr int NTOK = 65536, DM = 1024, SEQ = 2048, DFF = 2816, NGU = 2 * DFF, ABIN = 2304, CDIN = 2560;
constexpr float EPS = 1e-6f, LOG2E = 1.4426950408889634f;
constexpr size_t MiB = 1u << 20;
constexpr size_t WS_SS = 784 * MiB;
constexpr size_t WS_ROPE = 7 * MiB;
constexpr size_t WS_BAR = 7 * MiB + 512 * 1024;
constexpr size_t WS_W = 8 * MiB;
constexpr size_t SZ_GU = (size_t)NGU * DM * 2, SZ_DN = (size_t)DM * DFF * 2, SZ_ABIN = (size_t)ABIN * DM * 2, SZ_SQ = (size_t)DM * DM * 2, SZ_CDIN = (size_t)CDIN * DM * 2;
constexpr size_t WS_WGU = WS_W, WS_WDN = WS_WGU + 8 * SZ_GU, WS_WABIN = WS_WDN + 8 * SZ_DN, WS_WABOUT = WS_WABIN + 2 * SZ_ABIN,
                 WS_WCDIN = WS_WABOUT + 2 * SZ_SQ, WS_WCDOUT = WS_WCDIN + 2 * SZ_CDIN, WS_WEND = WS_WCDOUT + 2 * SZ_SQ;
static_assert(WS_WEND <= 176 * MiB, "weights");
constexpr size_t WS_XB = 176 * MiB;
constexpr size_t WS_Y = 304 * MiB;
constexpr size_t WS_ACT = 432 * MiB;
constexpr size_t WS_XLO = 784 * MiB;
constexpr size_t WS_END = 912 * MiB;
constexpr size_t U_QA = 0, U_KA = U_QA + (size_t)NTOK * 512, U_VTA = U_KA + (size_t)NTOK * 128, U_QB = U_VTA + (size_t)NTOK * 128,
                 U_KB = U_QB + (size_t)NTOK * 512, U_VTB = U_KB + (size_t)NTOK * 512;
constexpr size_t U_E = 0, U_P = (size_t)NTOK * 512, U_BC = 2 * (size_t)NTOK * 512;

__device__ __forceinline__ float fast_rcp(float x) { return __builtin_amdgcn_rcpf(x); }
__device__ __forceinline__ float fast_exp2(float x) { return __builtin_amdgcn_exp2f(x); }
#ifdef NO_SS
__device__ __forceinline__ float fast_rsq(float x) { return x > 1e30f ? 0.f : 1.0f; }
#else
__device__ __forceinline__ float fast_rsq(float x) { return __builtin_amdgcn_rsqf(x); }
#endif
typedef float ss_t;
constexpr float SS_SCALE = 65536.0f, SS_INV = 1.0f / (65536.0f * 1024.0f);
__device__ __forceinline__ ss_t ss_fix(float q) { return (ss_t)(q * SS_SCALE); }
__device__ __forceinline__ float ss_rstd(const ss_t* rowp) {
    const f32x4 a = *(const f32x4*)rowp, b = *(const f32x4*)(rowp + 4), c = *(const f32x4*)(rowp + 8), d = *(const f32x4*)(rowp + 12);
    const f32x4 t = (a + b) + (c + d);
    return fast_rsq(((t[0] + t[1]) + (t[2] + t[3])) * (1.0f / DM) + 1e-6f);
}
__device__ __forceinline__ float sigmoidf_(float v) { return fast_rcp(1.0f + fast_exp2(-v * LOG2E)); }
__device__ __forceinline__ float siluf_(float v) { return v * sigmoidf_(v); }
__device__ __forceinline__ float bf2f(unsigned short b) { return __uint_as_float(((unsigned)b) << 16); }
__device__ __forceinline__ unsigned short f2bf(float f) { return (unsigned short)(cvt_pk_bf16(f, 0.f) & 0xffffu); }
__device__ __forceinline__ u32x4 pack8(f32x4 a, f32x4 b) { u32x4 w; w.x = cvt_pk_bf16(a[0], a[1]); w.y = cvt_pk_bf16(a[2], a[3]); w.z = cvt_pk_bf16(b[0], b[1]); w.w = cvt_pk_bf16(b[2], b[3]); return w; }

#define EPI_ROW(ai, m) (u.pm * 256 + wr * 64 + fr + (ai) * 128 + (m) * 16)

constexpr int RS_OFF = 131072;
__device__ __forceinline__ void fill_rstd_table(LAS unsigned char* lds, const ss_t* ss, int bx, int wave_s) {
    int tid_; asm volatile("v_mbcnt_lo_u32_b32 %0, -1, 0\n\tv_mbcnt_hi_u32_b32 %0, -1, %0" : "=v"(tid_)); tid_ += wave_s * 64;
    LAS float* tab = (LAS float*)(lds + RS_OFF);
    constexpr int NPAN = 32 / pg8::WGM;
#pragma unroll
    for (int k = 0; k < NPAN / 2; ++k) {
        const int idx = tid_ + 512 * k, j = idx >> 8, rr = idx & 255, pm = pg8::WGM * (NPAN * (bx & 7) + j) + ((bx >> 3) & (pg8::WGM - 1));
        tab[idx] = ss_rstd(ss + (size_t)(pm * 256 + rr) * 16);
    }
    __syncthreads();
}
#define EPI_RS(ai, m) (rs[((u.pm / pg8::WGM) & (32 / pg8::WGM - 1)) * 256 + wr * 64 + fr + (ai) * 128 + (m) * 16])

struct EpiUp {
    static constexpr bool PERM = true, AFTER_DRAIN = false;
    bf16_t* act; const LAS float* rs;
    __device__ __forceinline__ void operator()(const f32x4 (&acc)[2][2][4][2], const Unit& u, int wr, int wc, int fr, int fq) const {
        const unsigned e0 = (unsigned)(u.pm * 256 + wr * 64 + fr) * (unsigned)DFF + (unsigned)(u.pn * 128 + wc * 32 + 8 * fq);
        char* pa = (char*)act;
#pragma unroll
        for (int ai = 0; ai < 2; ++ai)
#pragma unroll
            for (int m = 0; m < 4; ++m) {
                const float r = EPI_RS(ai, m), c1 = -r * LOG2E, r2 = r * r;
                f32x4 h[2];
#pragma unroll
                for (int n = 0; n < 2; ++n) {
                    const f32x4 g = acc[ai][0][m][n], up = acc[ai][1][m][n];
                    const f32x4 ea = g * c1, gu = (g * up) * r2;
                    f32x4 d;
#pragma unroll
                    for (int i = 0; i < 4; ++i) d[i] = fast_exp2(ea[i]);
                    d = d + 1.0f;
#pragma unroll
                    for (int i = 0; i < 4; ++i) d[i] = fast_rcp(d[i]);
                    h[n] = gu * d;
                }
#ifdef ACT_SC1
                { const u32x4 hv = pack8(h[0], h[1]); const char* ap = pa + (size_t)((e0 + (unsigned)((ai * 128 + m * 16) * DFF)) * 2u);
                  asm volatile("global_store_dwordx4 %0, %1, off sc1" :: "v"(ap), "v"(hv) : "memory"); }
#else
                *(u32x4*)(pa + (e0 + (unsigned)((ai * 128 + m * 16) * DFF)) * 2u) = pack8(h[0], h[1]);
#endif
            }
    }
};

__device__ __forceinline__ void unpack8(u32x4 h, u32x4 l, f32x4& a, f32x4& b) {
    a[0] = __uint_as_float(h.x << 16) + __uint_as_float(l.x << 16); a[1] = __uint_as_float(h.x & 0xffff0000u) + __uint_as_float(l.x & 0xffff0000u);
    a[2] = __uint_as_float(h.y << 16) + __uint_as_float(l.y << 16); a[3] = __uint_as_float(h.y & 0xffff0000u) + __uint_as_float(l.y & 0xffff0000u);
    b[0] = __uint_as_float(h.z << 16) + __uint_as_float(l.z << 16); b[1] = __uint_as_float(h.z & 0xffff0000u) + __uint_as_float(l.z & 0xffff0000u);
    b[2] = __uint_as_float(h.w << 16) + __uint_as_float(l.w << 16); b[3] = __uint_as_float(h.w & 0xffff0000u) + __uint_as_float(l.w & 0xffff0000u);
}
__device__ __forceinline__ void split8(f32x4 a, f32x4 b, u32x4& h, u32x4& l) {
    h = pack8(a, b);
    f32x4 ra, rb;
    ra[0] = a[0] - __uint_as_float(h.x << 16); ra[1] = a[1] - __uint_as_float(h.x & 0xffff0000u); ra[2] = a[2] - __uint_as_float(h.y << 16); ra[3] = a[3] - __uint_as_float(h.y & 0xffff0000u);
    rb[0] = b[0] - __uint_as_float(h.z << 16); rb[1] = b[1] - __uint_as_float(h.z & 0xffff0000u); rb[2] = b[2] - __uint_as_float(h.w << 16); rb[3] = b[3] - __uint_as_float(h.w & 0xffff0000u);
    l = pack8(ra, rb);
}
struct EpiRes {
    static constexpr bool PERM = true, AFTER_DRAIN = false;
    bf16_t* xb; ss_t* ss; float alpha;
    __device__ __forceinline__ void operator()(const f32x4 (&acc)[2][2][4][2], const Unit& u, int wr, int wc, int fr, int fq) const {
        const unsigned row0 = (unsigned)(u.pm * 256 + wr * 64 + fr);
        const unsigned e0 = row0 * (unsigned)DM + (unsigned)(u.pn * 256 + wc * 64 + 8 * fq);
        char* ph = (char*)xb;
        u32x4 ch[2], nh[2];
        float qs[8];
#define RES_LOAD(dh, g) do { _Pragma("unroll") for (int bj = 0; bj < 2; ++bj) { const unsigned eo = e0 + (unsigned)((((g) >> 2) * 128 + ((g) & 3) * 16) * DM + bj * 32); \
            dh[bj] = *(const u32x4*)(ph + eo * 2u); } } while (0)
        RES_LOAD(ch, 0);
#pragma unroll
        for (int g = 0; g < 8; ++g) {
            const int ai = g >> 2, m = g & 3;
            if (g < 7) RES_LOAD(nh, g + 1);
            float q = 0.f;
#pragma unroll
            for (int bj = 0; bj < 2; ++bj) {
                const unsigned eo = e0 + (unsigned)((ai * 128 + m * 16) * DM + bj * 32);
                f32x4 x0, x1; unpack8(ch[bj], (u32x4){0u, 0u, 0u, 0u}, x0, x1);
                const f32x4 o0 = x0 + acc[ai][bj][m][0] * alpha, o1 = x1 + acc[ai][bj][m][1] * alpha;
                *(u32x4*)(ph + eo * 2u) = pack8(o0, o1);
                q += (o0[0] * o0[0] + o0[1] * o0[1]) + (o0[2] * o0[2] + o0[3] * o0[3]) + (o1[0] * o1[0] + o1[1] * o1[1]) + (o1[2] * o1[2] + o1[3] * o1[3]);
            }
            q += __shfl_xor(q, 16); q += __shfl_xor(q, 32);
            qs[g] = q;
            asm volatile("" ::: "memory");
#pragma unroll
            for (int bj = 0; bj < 2; ++bj) ch[bj] = nh[bj];
        }
#undef RES_LOAD
        if (fq == 0) {
#pragma unroll
            for (int g = 0; g < 8; ++g) *(float*)((char*)ss + ((row0 + (unsigned)((g >> 2) * 128 + (g & 3) * 16)) * 16u + (unsigned)(u.pn * 4 + wc)) * 4u) = qs[g];
        }
    }
};

struct EpiNull {
    static constexpr bool PERM = true, AFTER_DRAIN = false;
    float* sink;
    __device__ __forceinline__ void operator()(const f32x4 (&acc)[2][2][4][2], const Unit& u, int wr, int wc, int fr, int fq) const {
        float t = 0.f;
#pragma unroll
        for (int ai = 0; ai < 2; ++ai)
#pragma unroll
            for (int bj = 0; bj < 2; ++bj)
#pragma unroll
                for (int m = 0; m < 4; ++m)
#pragma unroll
                    for (int n = 0; n < 2; ++n) t += acc[ai][bj][m][n][0] + acc[ai][bj][m][n][1] + acc[ai][bj][m][n][2] + acc[ai][bj][m][n][3];
        if (t == 1.2345e-30f) sink[0] = t;
    }
};

struct EpiAB {
    static constexpr bool PERM = true, AFTER_DRAIN = false;
    const LAS float* rs; const float* qg; const float* kg; const float* rope; bf16_t* ub;
    __device__ __forceinline__ void operator()(const f32x4 (&acc)[2][2][4][2], const Unit& u, int wr, int wc, int fr, int fq) const {
        const int pn = u.pn;
        int kind, head;
        if (pn < 2) { kind = 0; head = 4 * pn + wc; }
        else if (pn == 2) { if (wc < 2) { kind = 1; head = wc; } else { kind = 2; head = wc - 2; } }
        else if (pn < 5) { kind = 3; head = 4 * (pn - 3) + wc; }
        else if (pn < 7) { kind = 4; head = 4 * (pn - 5) + wc; }
        else { kind = 5; head = 4 * (pn - 7) + wc; }
        if (kind <= 1) {
            const float* g = kind == 0 ? qg : kg;
            f32x4 gv[2][2];
#pragma unroll
            for (int bj = 0; bj < 2; ++bj)
#pragma unroll
                for (int n = 0; n < 2; ++n) gv[bj][n] = *(const f32x4*)(g + 32 * bj + 8 * fq + 4 * n);
            const float osc = kind == 0 ? 0.125f * LOG2E : 1.0f;
            bf16_t* dst = ub + (kind == 0 ? U_QA : U_KA);
            const int ldo = kind == 0 ? 512 : 128;
#pragma unroll
            for (int ai = 0; ai < 2; ++ai)
#pragma unroll
                for (int m = 0; m < 4; ++m) {
                    const int row = EPI_ROW(ai, m);
                    const float r = EPI_RS(ai, m);
                    f32x4 v[2][2]; float q = 0.f;
#pragma unroll
                    for (int bj = 0; bj < 2; ++bj)
#pragma unroll
                        for (int n = 0; n < 2; ++n) { v[bj][n] = acc[ai][bj][m][n] * r; const f32x4 t = v[bj][n]; q += (t[0] * t[0] + t[1] * t[1]) + (t[2] * t[2] + t[3] * t[3]); }
                    q += __shfl_xor(q, 16); q += __shfl_xor(q, 32);
                    const float rn = fast_rsq(q * (1.0f / 64.0f) + EPS) * osc;
                    const int pos = row & (SEQ - 1);
#pragma unroll
                    for (int bj = 0; bj < 2; ++bj) {
                        f32x4 o[2];
#pragma unroll
                        for (int n = 0; n < 2; ++n) {
                            const f32x4 t = v[bj][n] * gv[bj][n] * rn;
                            const f32x4 cs = *(const f32x4*)(rope + ((size_t)pos * 32 + 16 * bj + 4 * fq + 2 * n) * 2);
                            o[n][0] = t[0] * cs[0] - t[1] * cs[1]; o[n][1] = t[0] * cs[1] + t[1] * cs[0];
                            o[n][2] = t[2] * cs[2] - t[3] * cs[3]; o[n][3] = t[2] * cs[3] + t[3] * cs[2];
                        }
                        *(u32x4*)(dst + (size_t)row * ldo + head * 64 + 32 * bj + 8 * fq) = pack8(o[0], o[1]);
                    }
                    asm volatile("" ::: "memory");
                }
        } else if (kind == 3 || kind == 4) {
            const float osc = kind == 3 ? 0.125f * LOG2E : 1.0f;
            bf16_t* dst = ub + (kind == 3 ? U_QB : U_KB);
#pragma unroll
            for (int ai = 0; ai < 2; ++ai)
#pragma unroll
                for (int m = 0; m < 4; ++m) {
                    const int row = EPI_ROW(ai, m);
                    const float r = EPI_RS(ai, m) * osc;
#pragma unroll
                    for (int bj = 0; bj < 2; ++bj)
                        *(u32x4*)(dst + (size_t)row * 512 + head * 64 + 32 * bj + 8 * fq) = pack8(acc[ai][bj][m][0] * r, acc[ai][bj][m][1] * r);
                }
        } else {
            const int nh = kind == 2 ? 2 : 8;
            bf16_t* dst = ub + (kind == 2 ? U_VTA : U_VTB);
#pragma unroll
            for (int ai = 0; ai < 2; ++ai)
#pragma unroll
                for (int m = 0; m < 4; ++m) {
                    const int row = EPI_ROW(ai, m);
                    const float r = EPI_RS(ai, m);
                    const int b = row >> 11, pos = row & (SEQ - 1);
                    bf16_t* base = dst + ((size_t)(b * nh + head) * 64) * SEQ + pos;
#pragma unroll
                    for (int bj = 0; bj < 2; ++bj)
#pragma unroll
                        for (int n = 0; n < 2; ++n) {
                            const f32x4 t = acc[ai][bj][m][n] * r;
                            const unsigned w0 = cvt_pk_bf16(t[0], t[1]), w1 = cvt_pk_bf16(t[2], t[3]);
                            const int d = 32 * bj + 8 * fq + 4 * n;
                            base[(size_t)(d + 0) * SEQ] = (bf16_t)(w0 & 0xffffu); base[(size_t)(d + 1) * SEQ] = (bf16_t)(w0 >> 16);
                            base[(size_t)(d + 2) * SEQ] = (bf16_t)(w1 & 0xffffu); base[(size_t)(d + 3) * SEQ] = (bf16_t)(w1 >> 16);
                        }
                }
        }
    }
};

struct EpiCD {
    static constexpr bool PERM = true, AFTER_DRAIN = false;
    const LAS float* rs; bf16_t* ub;
    __device__ __forceinline__ void operator()(const f32x4 (&acc)[2][2][4][2], const Unit& u, int wr, int wc, int fr, int fq) const {
        const int pn = u.pn;
        const unsigned row0 = (unsigned)(u.pm * 256 + wr * 64 + fr);
        if (pn < 8) {
            char* dst = (char*)(ub + (pn < 4 ? U_E : U_P));
            const unsigned e0 = row0 * 512u + (unsigned)((pn & 3) * 128 + wc * 32 + 8 * fq);
            const bool gate = pn < 4;
#pragma unroll
            for (int ai = 0; ai < 2; ++ai)
#pragma unroll
                for (int m = 0; m < 4; ++m) {
                    const float r = EPI_RS(ai, m);
                    f32x4 h[2];
#pragma unroll
                    for (int n = 0; n < 2; ++n) {
                        const f32x4 a = acc[ai][0][m][n] * r, g = acc[ai][1][m][n] * r;
#pragma unroll
                        for (int i = 0; i < 4; ++i) h[n][i] = a[i] * (gate ? sigmoidf_(g[i]) : g[i]);
                    }
                    *(u32x4*)(dst + (e0 + (unsigned)((ai * 128 + m * 16) * 512)) * 2u) = pack8(h[0], h[1]);
                    asm volatile("" ::: "memory");
                }
        } else {
            char* dst = (char*)(ub + U_BC);
            const unsigned e0 = row0 * 512u + (unsigned)((pn - 8) * 256 + wc * 32 + 8 * fq);
#pragma unroll
            for (int ai = 0; ai < 2; ++ai)
#pragma unroll
                for (int m = 0; m < 4; ++m) {
                    const float r = EPI_RS(ai, m);
#pragma unroll
                    for (int bj = 0; bj < 2; ++bj)
                        *(u32x4*)(dst + (e0 + (unsigned)((ai * 128 + m * 16) * 512 + bj * 128)) * 2u) = pack8(acc[ai][bj][m][0] * r, acc[ai][bj][m][1] * r);
                    asm volatile("" ::: "memory");
                }
        }
    }
};

__device__ __forceinline__ float wave_sum(float v) {
#pragma unroll
    for (int o = 1; o < 64; o <<= 1) v += __shfl_xor(v, o);
    return v;
}
__device__ __forceinline__ void transpose_item(const float* src, int ldw, const float* gain, bf16_t* dst, int K, int k0, LAS float* scr, int lane) {
    float tv[32];
#pragma unroll
    for (int i = 0; i < 32; ++i) { const int kk = 2 * i + (lane >> 5); tv[i] = src[(size_t)(k0 + kk) * ldw + (lane & 31)]; }
#pragma unroll
    for (int i = 0; i < 32; ++i) { const int kk = 2 * i + (lane >> 5); float v = tv[i]; if (gain) v *= gain[k0 + kk]; scr[kk * 33 + (lane & 31)] = v; }
    asm volatile("s_waitcnt lgkmcnt(0)" ::: "memory");
    const int c = lane & 7;
#pragma unroll
    for (int j = 0; j < 4; ++j) { const int n = (lane >> 3) + 8 * j; const LAS float* s = scr + (8 * c) * 33 + n;
        u32x4 o; o.x = cvt_pk_bf16(s[0 * 33], s[1 * 33]); o.y = cvt_pk_bf16(s[2 * 33], s[3 * 33]); o.z = cvt_pk_bf16(s[4 * 33], s[5 * 33]); o.w = cvt_pk_bf16(s[6 * 33], s[7 * 33]);
        *(u32x4*)(dst + (size_t)n * K + k0 + 8 * c) = o; }
    asm volatile("s_waitcnt lgkmcnt(0)" ::: "memory");
}

struct Params {
    const float* in[18];
    float* out; unsigned char* ws;
    int ph_lo, ph_hi;
};
enum { I_X = 0, I_FFN_NORM, I_MIX_NORM, I_WG, I_WU, I_WD, I_ABIN, I_ABOUT, I_QN, I_KN, I_RPB, I_CDIN, I_CDOUT, I_CCW, I_DCW, I_DNG, I_DNB, I_FINAL };

#define RESCOL(nb) (256 * ((nb) >> 3) + 64 * ((nb) & 3) + 32 * (((nb) >> 2) & 1))
__device__ __forceinline__ void prologue_phase(const Params& p, LAS unsigned char* lds, int vcu, int NGW, int wave_s) {
    int tid_; asm volatile("v_mbcnt_lo_u32_b32 %0, -1, 0\n\tv_mbcnt_hi_u32_b32 %0, -1, %0" : "=v"(tid_)); tid_ += wave_s * 64;
    const int lane = tid_ & 63, wave = __builtin_amdgcn_readfirstlane(tid_ >> 6), gw = vcu * 8 + wave;
    unsigned char* ws = p.ws;
    ss_t* ss = (ss_t*)(ws + WS_SS);
    {
        const float* x = p.in[I_X]; bf16_t* xb = (bf16_t*)(ws + WS_XB);
        for (int row0 = gw; row0 < NTOK; row0 += 2 * NGW) {
            f32x4 v[2][4]; float sq[2];
#pragma unroll
            for (int k = 0; k < 2; ++k) { const f32x4* xr = (const f32x4*)(x + (size_t)(row0 + k * NGW) * DM) + lane;
#pragma unroll
                for (int j = 0; j < 4; ++j) v[k][j] = xr[64 * j]; }
#pragma unroll
            for (int k = 0; k < 2; ++k) {
                const int row = row0 + k * NGW; float s = 0.f;
#pragma unroll
                for (int j = 0; j < 4; ++j) s += (v[k][j][0] * v[k][j][0] + v[k][j][1] * v[k][j][1]) + (v[k][j][2] * v[k][j][2] + v[k][j][3] * v[k][j][3]);
                sq[k] = wave_sum(s);
                u32x2* o = (u32x2*)(xb + (size_t)row * DM) + lane;
#pragma unroll
                for (int j = 0; j < 4; ++j) { u32x2 w; w.x = cvt_pk_bf16(v[k][j][0], v[k][j][1]); w.y = cvt_pk_bf16(v[k][j][2], v[k][j][3]); o[64 * j] = w; }
                if (lane < 16) ss[(size_t)row * 16 + lane] = lane == 0 ? sq[k] : 0.f;
            }
        }
    }
    {
        float* rope = (float*)(ws + WS_ROPE);
        for (int idx = gw * 64 + lane; idx < SEQ * 32; idx += NGW * 64) {
            const int pos = idx >> 5, pr = idx & 31, j = pr & 15;
            const float coord = pr < 16 ? (float)(pos >> 6) : (float)(pos & 63);
            const float freq = fast_exp2(-(float)(2 * j) * (1.0f / 32.0f) * 13.287712379549449f);
            const float ang = coord * freq;
            float sn, cs; __sincosf(ang, &sn, &cs);
            rope[2 * idx] = cs; rope[2 * idx + 1] = sn;
        }
    }
    {
        LAS float* scr = (LAS float*)(lds + wave * 16384);
        constexpr int IT_GU = 16 * (NGU / 32), IT_DN = (DFF / 64) * 32, IT_ABIN = 16 * (ABIN / 32), IT_SQ = 16 * 32, IT_CDIN = 16 * (CDIN / 32);
        constexpr int IT_FFN = IT_GU + IT_DN, IT_AB = IT_ABIN + IT_SQ, IT_CD = IT_CDIN + IT_SQ;
        constexpr int NITEMS = 8 * IT_FFN + 2 * IT_AB + 2 * IT_CD;
        for (int it = gw; it < NITEMS; it += NGW) {
            int r = it;
            if (r < 8 * IT_FFN) {
                const int f = r / IT_FFN; r -= f * IT_FFN;
                if (r < IT_GU) {
                    const int nb = r % (NGU / 32), kb = r / (NGU / 32);
                    const int pn = nb >> 3, bj = (nb >> 2) & 1, j0 = 32 * (nb & 3);
                    const float* W = (bj ? p.in[I_WU] : p.in[I_WG]) + (size_t)f * DM * DFF + 128 * pn + j0;
                    transpose_item(W, DFF, p.in[I_FFN_NORM] + f * DM, (bf16_t*)(ws + WS_WGU + f * SZ_GU) + (size_t)(32 * nb) * DM, DM, 64 * kb, scr, lane);
                } else {
                    r -= IT_GU; const int nb = r % 32, kb = r / 32;
                    transpose_item(p.in[I_WD] + (size_t)f * DFF * DM + RESCOL(nb), DM, nullptr, (bf16_t*)(ws + WS_WDN + f * SZ_DN) + (size_t)(32 * nb) * DFF, DFF, 64 * kb, scr, lane);
                }
                continue;
            }
            r -= 8 * IT_FFN;
            if (r < 2 * IT_AB) {
                const int e = r / IT_AB; r -= e * IT_AB;
                if (r < IT_ABIN) {
                    const int nb = r % (ABIN / 32), kb = r / (ABIN / 32);
                    const int pn = nb >> 3, bj = (nb >> 2) & 1, wc = nb & 3;
                    transpose_item(p.in[I_ABIN] + (size_t)e * DM * ABIN + 256 * pn + 64 * wc + 32 * bj, ABIN, p.in[I_MIX_NORM] + (2 * e) * DM,
                                   (bf16_t*)(ws + WS_WABIN + e * SZ_ABIN) + (size_t)(32 * nb) * DM, DM, 64 * kb, scr, lane);
                } else {
                    r -= IT_ABIN; const int nb = r % 32, kb = r / 32;
                    transpose_item(p.in[I_ABOUT] + (size_t)e * DM * DM + RESCOL(nb), DM, nullptr, (bf16_t*)(ws + WS_WABOUT + e * SZ_SQ) + (size_t)(32 * nb) * DM, DM, 64 * kb, scr, lane);
                }
                continue;
            }
            r -= 2 * IT_AB;
            {
                const int e = r / IT_CD; r -= e * IT_CD;
                if (r < IT_CDIN) {
                    const int nb = r % (CDIN / 32), kb = r / (CDIN / 32);
                    const int pn = nb >> 3, bj = (nb >> 2) & 1, j0 = 32 * (nb & 3);
                    int scol;
                    if (pn < 4) scol = (bj ? 2048 : 1536) + 128 * pn + j0;
                    else if (pn < 8) scol = (bj ? 0 : 1024) + 128 * (pn - 4) + j0;
                    else scol = 512 + 256 * (pn - 8) + 128 * bj + j0;
                    transpose_item(p.in[I_CDIN] + (size_t)e * DM * CDIN + scol, CDIN, p.in[I_MIX_NORM] + (2 * e + 1) * DM,
                                   (bf16_t*)(ws + WS_WCDIN + e * SZ_CDIN) + (size_t)(32 * nb) * DM, DM, 64 * kb, scr, lane);
                } else {
                    r -= IT_CDIN; const int nb = r % 32, kb = r / 32;
                    transpose_item(p.in[I_CDOUT] + (size_t)e * DM * DM + RESCOL(nb), DM, nullptr, (bf16_t*)(ws + WS_WCDOUT + e * SZ_SQ) + (size_t)(32 * nb) * DM, DM, 64 * kb, scr, lane);
                }
            }
        }
    }
}

__device__ __forceinline__ void attn_global_phase(LAS unsigned char* lds, const bf16_t* Qa, const bf16_t* Ka, const bf16_t* Vta, const float* qg, const float* kg, bf16_t* y, int vcu, int G, int wave_s) {
    constexpr int PITCH = 144, TILEB = 64 * PITCH, BUFB = 2 * TILEB;
    float negCB;
    {
        int l_; asm volatile("v_mbcnt_lo_u32_b32 %0, -1, 0\n\tv_mbcnt_hi_u32_b32 %0, -1, %0" : "=v"(l_));
        float gq = fabsf(qg[l_]), gk = fabsf(kg[l_]);
#pragma unroll
        for (int o = 1; o < 64; o <<= 1) { gq = fmaxf(gq, __shfl_xor(gq, o)); gk = fmaxf(gk, __shfl_xor(gk, o)); }
        negCB = -(64.0f * 0.125f * LOG2E * 1.01f * gq * gk + 0.125f);
    }
    for (int un_ = vcu; un_ < 32 * 8 * 4; un_ += G) {
        const int un = 32 * 8 * 4 - 1 - un_;
        int tid_; asm volatile("v_mbcnt_lo_u32_b32 %0, -1, 0\n\tv_mbcnt_hi_u32_b32 %0, -1, %0" : "=v"(tid_)); tid_ += wave_s * 64;
        const int tid = tid_, lane = tid & 63, wid = __builtin_amdgcn_readfirstlane(tid >> 6), ql = lane & 31, hi = lane >> 5;
        const int srow = tid >> 3, sch = tid & 7;
        const int pik = (ql & 19) | ((ql & 4) << 1) | ((ql & 8) >> 1);
        const int qb = un & 3, h4 = (un >> 2) & 3, kvh = (un >> 4) & 1, b = un >> 5, h = kvh * 4 + h4;
        const int tok0 = b * SEQ + qb * 512 + wid * 64 + ql;
        const bf16_t* qp = Qa + (size_t)tok0 * 512 + h * 64 + hi * 8;
        bf16x8 qf[2][4];
#pragma unroll
        for (int t = 0; t < 2; ++t)
#pragma unroll
            for (int dc = 0; dc < 4; ++dc) qf[t][dc] = *(const bf16x8*)(qp + (size_t)t * 32 * 512 + dc * 16);
        const bf16_t* kg_ = Ka + (size_t)(b * SEQ + srow) * 128 + kvh * 64 + sch * 8;
        const bf16_t* vg_ = Vta + ((size_t)(b * 2 + kvh) * 64 + srow) * SEQ + sch * 8;
        f32x16 o[2][2];
#pragma unroll
        for (int t = 0; t < 2; ++t)
#pragma unroll
            for (int r = 0; r < 16; ++r) { o[t][0][r] = 0.f; o[t][1][r] = 0.f; }
        float lrun[2] = {0.f, 0.f};
        u32x4 kreg = *(const u32x4*)kg_, vreg = *(const u32x4*)vg_;
        __syncthreads();
        *(LAS u32x4*)(lds + srow * PITCH + sch * 16) = kreg; *(LAS u32x4*)(lds + TILEB + srow * PITCH + sch * 16) = vreg;
        __syncthreads();
        for (int kt = 0; kt < SEQ / 64; ++kt) {
            if (kt + 1 < SEQ / 64) { kreg = *(const u32x4*)(kg_ + (size_t)(kt + 1) * 64 * 128); vreg = *(const u32x4*)(vg_ + (kt + 1) * 64); }
            const LAS unsigned char* Kb_ = lds + (kt & 1) * BUFB; const LAS unsigned char* Vb_ = Kb_ + TILEB;
            f32x16 p[2][2];
#pragma unroll
            for (int t = 0; t < 2; ++t)
#pragma unroll
                for (int r = 0; r < 16; ++r) { p[t][0][r] = negCB; p[t][1][r] = negCB; }
#pragma unroll
            for (int dc = 0; dc < 4; ++dc) {
                const bf16x8 a0 = *(const LAS bf16x8*)(Kb_ + pik * PITCH + dc * 32 + hi * 16);
                const bf16x8 a1 = *(const LAS bf16x8*)(Kb_ + (32 + pik) * PITCH + dc * 32 + hi * 16);
#pragma unroll
                for (int t = 0; t < 2; ++t) {
                    p[t][0] = __builtin_amdgcn_mfma_f32_32x32x16_bf16(a0, qf[t][dc], p[t][0], 0, 0, 0);
                    p[t][1] = __builtin_amdgcn_mfma_f32_32x32x16_bf16(a1, qf[t][dc], p[t][1], 0, 0, 0);
                }
            }
            __builtin_amdgcn_sched_barrier(0);
            u32x4 pw[2][2][2];
#pragma unroll
            for (int t = 0; t < 2; ++t) {
                float sum = 0.f;
#pragma unroll
                for (int r = 0; r < 16; ++r) { p[t][0][r] = fast_exp2(p[t][0][r]); p[t][1][r] = fast_exp2(p[t][1][r]); sum += p[t][0][r] + p[t][1][r]; }
                lrun[t] += sum;
#pragma unroll
                for (int kb = 0; kb < 2; ++kb)
#pragma unroll
                    for (int c = 0; c < 2; ++c) {
                        pw[t][kb][c].x = cvt_pk_bf16(p[t][kb][8 * c + 0], p[t][kb][8 * c + 1]); pw[t][kb][c].y = cvt_pk_bf16(p[t][kb][8 * c + 2], p[t][kb][8 * c + 3]);
                        pw[t][kb][c].z = cvt_pk_bf16(p[t][kb][8 * c + 4], p[t][kb][8 * c + 5]); pw[t][kb][c].w = cvt_pk_bf16(p[t][kb][8 * c + 6], p[t][kb][8 * c + 7]);
                    }
            }
            __builtin_amdgcn_sched_barrier(0);
#pragma unroll
            for (int kb = 0; kb < 2; ++kb)
#pragma unroll
                for (int c = 0; c < 2; ++c) {
                    const bf16x8 v0 = *(const LAS bf16x8*)(Vb_ + ql * PITCH + (32 * kb + 16 * c + 8 * hi) * 2);
                    const bf16x8 v1 = *(const LAS bf16x8*)(Vb_ + (32 + ql) * PITCH + (32 * kb + 16 * c + 8 * hi) * 2);
#pragma unroll
                    for (int t = 0; t < 2; ++t) {
                        const bf16x8 pb = __builtin_bit_cast(bf16x8, pw[t][kb][c]);
                        o[t][0] = __builtin_amdgcn_mfma_f32_32x32x16_bf16(v0, pb, o[t][0], 0, 0, 0);
                        o[t][1] = __builtin_amdgcn_mfma_f32_32x32x16_bf16(v1, pb, o[t][1], 0, 0, 0);
                    }
                }
            if (kt + 1 < SEQ / 64) {
                LAS unsigned char* nb = lds + ((kt + 1) & 1) * BUFB;
                *(LAS u32x4*)(nb + srow * PITCH + sch * 16) = kreg; *(LAS u32x4*)(nb + TILEB + srow * PITCH + sch * 16) = vreg;
            }
            __syncthreads();
        }
#pragma unroll
        for (int t = 0; t < 2; ++t) {
            float l = lrun[t]; l += __shfl_xor(l, 32);
            const float inv = fast_rcp(l);
            bf16_t* yp = y + (size_t)(tok0 + 32 * t) * DM + h * 64 + 4 * hi;
#pragma unroll
            for (int g = 0; g < 4; ++g) {
                u32x2 w0, w1;
                w0.x = cvt_pk_bf16(o[t][0][4 * g] * inv, o[t][0][4 * g + 1] * inv); w0.y = cvt_pk_bf16(o[t][0][4 * g + 2] * inv, o[t][0][4 * g + 3] * inv);
                w1.x = cvt_pk_bf16(o[t][1][4 * g] * inv, o[t][1][4 * g + 1] * inv); w1.y = cvt_pk_bf16(o[t][1][4 * g + 2] * inv, o[t][1][4 * g + 3] * inv);
                *(u32x2*)(yp + 8 * g) = w0; *(u32x2*)(yp + 32 + 8 * g) = w1;
            }
        }
    }
}

constexpr int NA_TAB = 0, NA_K = 2048, NA_KP = 144, NA_V = NA_K + 576 * NA_KP, NA_VP = 1168, NA_END = NA_V + 64 * NA_VP;
__device__ __forceinline__ void attn_na_phase(LAS unsigned char* lds, const bf16_t* Qb, const bf16_t* Kb, const bf16_t* Vtb, const float* rpb, bf16_t* y, int vcu, int G, int wave_s) {
    int tid_; asm volatile("v_mbcnt_lo_u32_b32 %0, -1, 0\n\tv_mbcnt_hi_u32_b32 %0, -1, %0" : "=v"(tid_)); tid_ += wave_s * 64;
    const int tid = tid_, lane = tid & 63, wid = __builtin_amdgcn_readfirstlane(tid >> 6), ql = lane & 15, quad = lane >> 4;
    LAS float* tab = (LAS float*)(lds + NA_TAB);
    const int srow = tid >> 3, sch = tid & 7;
    u32x4 kreg[9], vreg[9];
#define NA_FETCH(unx) do { const int rp_ = (unx) & 15, h_ = ((unx) >> 4) & 7, b_ = (unx) >> 7; \
        const int rs0_ = min(max(2 * rp_ - 4, 0), 24), rs1_ = min(max(2 * rp_ - 3, 0), 24), nrows_ = rs1_ + 8 - rs0_; \
        const bf16_t* kg = Kb + (size_t)(b_ * SEQ + rs0_ * 64 + srow) * 512 + h_ * 64 + sch * 8; \
        const bf16_t* vg = Vtb + ((size_t)(b_ * 8 + h_) * 64 + srow) * SEQ + rs0_ * 64 + sch * 8; \
        _Pragma("unroll") for (int i = 0; i < 8; ++i) { kreg[i] = *(const u32x4*)(kg + (size_t)i * 64 * 512); vreg[i] = *(const u32x4*)(vg + i * 64); } \
        if (nrows_ > 8) { kreg[8] = *(const u32x4*)(kg + (size_t)8 * 64 * 512); vreg[8] = *(const u32x4*)(vg + 8 * 64); } \
        else { kreg[8] = (u32x4){0u, 0u, 0u, 0u}; vreg[8] = kreg[8]; } } while (0)
    if (vcu < 32 * 8 * 16) NA_FETCH(32 * 8 * 16 - 1 - vcu);
    for (int un_ = vcu; un_ < 32 * 8 * 16; un_ += G) {
        const int un = 32 * 8 * 16 - 1 - un_;
        const int rp = un & 15, h = (un >> 4) & 7, b = un >> 7;
        const int rs0 = min(max(2 * rp - 4, 0), 24);
        const int r = rp * 2 + (wid >> 2), n = wid & 3;
        const int rs = min(max(r - 4, 0), 24), kcol0 = min(max(16 * n - 8, 0), 32), ro = rs - rs0;
        const int qcol = 16 * n + ql, wcs = min(max(qcol - 8, 0), 48);
        const int tokq = b * SEQ + r * 64 + qcol;
        bf16x8 qf[2];
#pragma unroll
        for (int dc = 0; dc < 2; ++dc) qf[dc] = *(const bf16x8*)(Qb + (size_t)tokq * 512 + h * 64 + 32 * dc + 8 * quad);
        __syncthreads();
        for (int i = tid; i < 465; i += 512) tab[i] = rpb[h * 465 + i] * LOG2E;
#pragma unroll
        for (int i = 0; i < 9; ++i) {
            *(LAS u32x4*)(lds + NA_K + (i * 64 + srow) * NA_KP + sch * 16) = kreg[i];
            *(LAS u32x4*)(lds + NA_V + srow * NA_VP + (i * 64 + sch * 8) * 2) = vreg[i];
        }
        __syncthreads();
        if (un_ + G < 32 * 8 * 16) NA_FETCH(32 * 8 * 16 - 1 - (un_ + G));
        const int sw = wcs - kcol0;
        bool v0[4]; int cosel[4];
#pragma unroll
        for (int i = 0; i < 4; ++i) { const int x = 4 * quad + i; v0[i] = x >= sw; const int kc = kcol0 + x + (v0[i] ? 0 : 16); cosel[i] = min(max(kc - qcol + 15, 0), 30); }
        const LAS unsigned char* kbase = lds + NA_K + ((ro * 64 + kcol0 + ql) * NA_KP) + quad * 16;
        const LAS unsigned char* vbase = lds + NA_V + ql * NA_VP + (ro * 64 + kcol0 + 4 * quad) * 2;
        f32x4 s[8];
        float mx = -1e30f;
#pragma unroll
        for (int w = 0; w < 8; ++w) {
            const int rowoff = (rs + w - r + 7) * 31;
            f32x4 a[2];
#pragma unroll
            for (int ch = 0; ch < 2; ++ch) {
                const bf16x8 k0 = *(const LAS bf16x8*)(kbase + (w * 64 + 16 * ch) * NA_KP), k1 = *(const LAS bf16x8*)(kbase + (w * 64 + 16 * ch) * NA_KP + 64);
                a[ch] = (f32x4){0.f, 0.f, 0.f, 0.f};
                a[ch] = __builtin_amdgcn_mfma_f32_16x16x32_bf16(k0, qf[0], a[ch], 0, 0, 0);
                a[ch] = __builtin_amdgcn_mfma_f32_16x16x32_bf16(k1, qf[1], a[ch], 0, 0, 0);
            }
#pragma unroll
            for (int i = 0; i < 4; ++i) { const float v = (v0[i] ? a[0][i] : a[1][i]) + tab[rowoff + cosel[i]]; s[w][i] = v; mx = fmaxf(mx, v); }
        }
        mx = fmaxf(mx, __shfl_xor(mx, 16)); mx = fmaxf(mx, __shfl_xor(mx, 32));
        float l = 0.f;
#pragma unroll
        for (int w = 0; w < 8; ++w)
#pragma unroll
            for (int i = 0; i < 4; ++i) { const float e = fast_exp2(s[w][i] - mx); s[w][i] = e; l += e; }
        l += __shfl_xor(l, 16); l += __shfl_xor(l, 32);
        f32x4 o[4];
#pragma unroll
        for (int dt = 0; dt < 4; ++dt) o[dt] = (f32x4){0.f, 0.f, 0.f, 0.f};
#pragma unroll
        for (int w = 0; w < 8; ++w) {
            f32x4 p0, p1;
#pragma unroll
            for (int i = 0; i < 4; ++i) { p0[i] = v0[i] ? s[w][i] : 0.f; p1[i] = v0[i] ? 0.f : s[w][i]; }
            const bf16x8 pb = __builtin_bit_cast(bf16x8, pack8(p0, p1));
#pragma unroll
            for (int dt = 0; dt < 4; ++dt) {
                const u32x2 lo = *(const LAS u32x2*)(vbase + (16 * dt) * NA_VP + w * 128), hi2 = *(const LAS u32x2*)(vbase + (16 * dt) * NA_VP + w * 128 + 32);
                const u32x4 av = {lo.x, lo.y, hi2.x, hi2.y};
                o[dt] = __builtin_amdgcn_mfma_f32_16x16x32_bf16(__builtin_bit_cast(bf16x8, av), pb, o[dt], 0, 0, 0);
            }
        }
        const float inv = fast_rcp(l);
        bf16_t* yp = y + (size_t)tokq * DM + 512 + h * 64 + 4 * quad;
#pragma unroll
        for (int dt = 0; dt < 4; ++dt) { u32x2 w2; w2.x = cvt_pk_bf16(o[dt][0] * inv, o[dt][1] * inv); w2.y = cvt_pk_bf16(o[dt][2] * inv, o[dt][3] * inv); *(u32x2*)(yp + 16 * dt) = w2; }
    }
}

__device__ __forceinline__ float dpp_add(float v, float acc, const int ctrl, const int row_mask) { return acc; }
#define DPP_STEP(v, ctrl, rmask) (v) += __builtin_bit_cast(float, __builtin_amdgcn_update_dpp(0, __builtin_bit_cast(int, (v)), (ctrl), (rmask), 0xf, false))
__device__ __forceinline__ float wave_sum63(float v) {
    DPP_STEP(v, 0xB1, 0xf);
    DPP_STEP(v, 0x4E, 0xf);
    DPP_STEP(v, 0x114, 0xf);
    DPP_STEP(v, 0x118, 0xf);
    DPP_STEP(v, 0x142, 0xa);
    DPP_STEP(v, 0x143, 0xc);
    return v;
}
#undef NA_FETCH
template <int I> __device__ __forceinline__ void conv31_step(f32x2 (&acc)[32], const f32x2 (&wd)[31], const LAS unsigned char* base) {
    const unsigned raw = *(const LAS unsigned*)(base + I * 1024);
    const f32x2 v = {__uint_as_float(raw << 16), __uint_as_float(raw & 0xffff0000u)};
    constexpr int TLO = I - 30 > 0 ? I - 30 : 0, THI = I < 31 ? I : 31;
#pragma unroll
    for (int t = TLO; t <= THI; ++t) acc[t] += v * wd[I - t];
}
template <int... Is> __device__ __forceinline__ void conv31_all(f32x2 (&acc)[32], const f32x2 (&wd)[31], const LAS unsigned char* base, std::integer_sequence<int, Is...>) {
    (conv31_step<Is>(acc, wd, base), ...);
}
__device__ __forceinline__ void cd_core_phase(LAS unsigned char* lds, const bf16_t* E, const bf16_t* P, const bf16_t* Bc, const float* ccw, const float* dcw,
                                              const float* lng, const float* lnb, bf16_t* y, int vcu, int G, int wave_s) {
    constexpr int ROWS = 94, ROWB = 1024, PART_OFF = 96 * ROWB;
    LAS f32x2* part = (LAS f32x2*)(lds + PART_OFF);
    for (int un_ = vcu; un_ < NTOK / 64; un_ += G) {
        const int un = NTOK / 64 - 1 - un_;
        int tid_; asm volatile("v_mbcnt_lo_u32_b32 %0, -1, 0\n\tv_mbcnt_hi_u32_b32 %0, -1, %0" : "=v"(tid_)); tid_ += wave_s * 64;
        const int tid = tid_, lane = tid & 63, wid = __builtin_amdgcn_readfirstlane(tid >> 6), cp = tid & 255, th = tid >> 8, c0 = 2 * cp;
        const int t0 = un * 64, p0 = t0 & (SEQ - 1);
        __syncthreads();
        {
            u32x4 ev[12];
#pragma unroll
            for (int j = 0; j < 12; ++j) {
                const int c = tid + 512 * j, i = c >> 6, cc = c & 63, pos = p0 - 15 + i;
                ev[j] = (u32x4){0u, 0u, 0u, 0u};
                if (i < ROWS && pos >= 0 && pos < SEQ) ev[j] = *(const u32x4*)(E + (size_t)(t0 - 15 + i) * 512 + cc * 8);
            }
#pragma unroll
            for (int j = 0; j < 12; ++j) { const int c = tid + 512 * j, i = c >> 6, cc = c & 63; if (i < ROWS) *(LAS u32x4*)(lds + i * ROWB + cc * 16) = ev[j]; }
        }
        __syncthreads();
        f32x2 acc[32];
        {
            f32x2 wd[31];
#pragma unroll
            for (int k = 0; k < 31; ++k) wd[k] = *(const f32x2*)(dcw + k * 512 + c0);
#pragma unroll
            for (int t = 0; t < 32; ++t) acc[t] = (f32x2){0.f, 0.f};
            conv31_all(acc, wd, lds + (32 * th) * ROWB + cp * 4, std::make_integer_sequence<int, 62>{});
        }
        __syncthreads();
#pragma unroll
        for (int t = 0; t < 32; ++t) *(LAS f32x2*)(lds + ((32 * th + t) * 512 + c0) * 4) = acc[t];
        __syncthreads();
        {
            const int cb = 8 * lane;
            f32x4 w3[3][2], gam[2], bet[2];
#pragma unroll
            for (int j = 0; j < 2; ++j) {
#pragma unroll
                for (int k = 0; k < 3; ++k) w3[k][j] = *(const f32x4*)(ccw + k * 512 + cb + 4 * j);
                gam[j] = *(const f32x4*)(lng + cb + 4 * j); bet[j] = *(const f32x4*)(lnb + cb + 4 * j);
            }
#pragma unroll 2
            for (int k = 0; k < 8; ++k) {
                const int tl = wid * 8 + k, tok = t0 + tl, pos = p0 + tl;
                const u32x4 pc = *(const u32x4*)(P + (size_t)tok * 512 + cb), bc = *(const u32x4*)(Bc + (size_t)tok * 512 + cb);
                u32x4 pm = *(const u32x4*)(P + (size_t)(pos > 0 ? tok - 1 : tok) * 512 + cb), pp = *(const u32x4*)(P + (size_t)(pos < SEQ - 1 ? tok + 1 : tok) * 512 + cb);
                if (pos == 0) pm = (u32x4){0u, 0u, 0u, 0u};
                if (pos == SEQ - 1) pp = (u32x4){0u, 0u, 0u, 0u};
                f32x4 z[2];
                z[0] = *(const LAS f32x4*)(lds + (tl * 512 + cb) * 4); z[1] = *(const LAS f32x4*)(lds + (tl * 512 + cb) * 4 + 16);
                float s1 = ((z[0][0] + z[0][1]) + (z[0][2] + z[0][3])) + ((z[1][0] + z[1][1]) + (z[1][2] + z[1][3]));
                float s2 = ((z[0][0] * z[0][0] + z[0][1] * z[0][1]) + (z[0][2] * z[0][2] + z[0][3] * z[0][3])) + ((z[1][0] * z[1][0] + z[1][1] * z[1][1]) + (z[1][2] * z[1][2] + z[1][3] * z[1][3]));
                s1 = wave_sum63(s1); s2 = wave_sum63(s2);
                s1 = __builtin_bit_cast(float, __builtin_amdgcn_readlane(__builtin_bit_cast(int, s1), 63)); s2 = __builtin_bit_cast(float, __builtin_amdgcn_readlane(__builtin_bit_cast(int, s2), 63));
                const float mean = s1 * (1.0f / 512.0f), var = s2 * (1.0f / 512.0f) - mean * mean, rstd = fast_rsq(fmaxf(var, 0.f) + EPS);
                f32x4 yd[2], yc[2], fm[2], fc[2], fp[2], fb[2];
                unpack8(pm, (u32x4){0u, 0u, 0u, 0u}, fm[0], fm[1]); unpack8(pc, (u32x4){0u, 0u, 0u, 0u}, fc[0], fc[1]);
                unpack8(pp, (u32x4){0u, 0u, 0u, 0u}, fp[0], fp[1]); unpack8(bc, (u32x4){0u, 0u, 0u, 0u}, fb[0], fb[1]);
#pragma unroll
                for (int j = 0; j < 2; ++j) {
                    const f32x4 zn = (z[j] - mean) * rstd * gam[j] + bet[j];
#pragma unroll
                    for (int i = 0; i < 4; ++i) yd[j][i] = siluf_(zn[i]);
                    yc[j] = fb[j] * (fm[j] * w3[0][j] + fc[j] * w3[1][j] + fp[j] * w3[2][j]);
                }
                *(u32x4*)(y + (size_t)tok * DM + cb) = pack8(yc[0], yc[1]);
                *(u32x4*)(y + (size_t)tok * DM + 512 + cb) = pack8(yd[0], yd[1]);
            }
        }
    }
}

__device__ __forceinline__ void final_phase(float* out, const bf16_t* xb, const ss_t* ss, const float* g, int vcu, int NGW, int wave_s) {
    int tid_; asm volatile("v_mbcnt_lo_u32_b32 %0, -1, 0\n\tv_mbcnt_hi_u32_b32 %0, -1, %0" : "=v"(tid_)); tid_ += wave_s * 64;
    const int lane = tid_ & 63, gw = vcu * 8 + __builtin_amdgcn_readfirstlane(tid_ >> 6);
    f32x4 gv[2][2];
#pragma unroll
    for (int j = 0; j < 2; ++j) { gv[j][0] = *(const f32x4*)(g + 512 * j + 8 * lane); gv[j][1] = *(const f32x4*)(g + 512 * j + 8 * lane + 4); }
    for (int row0 = gw; row0 < NTOK; row0 += 2 * NGW) {
        u32x4 xv[2][2]; float r[2];
#pragma unroll
        for (int k = 0; k < 2; ++k) { const int row = row0 + k * NGW; r[k] = ss_rstd(ss + (size_t)row * 16);
#pragma unroll
            for (int j = 0; j < 2; ++j) xv[k][j] = *(const u32x4*)(xb + (size_t)row * DM + 512 * j + 8 * lane); }
#pragma unroll
        for (int k = 0; k < 2; ++k)
#pragma unroll
            for (int j = 0; j < 2; ++j) {
                const size_t off = (size_t)(row0 + k * NGW) * DM + 512 * j + 8 * lane;
                f32x4 a, b; unpack8(xv[k][j], (u32x4){0u, 0u, 0u, 0u}, a, b);
                *(f32x4*)(out + off) = a * r[k] * gv[j][0]; *(f32x4*)(out + off + 4) = b * r[k] * gv[j][1];
            }
    }
}

#ifndef GEMM_SP2
#define GEMM_SP2 true
#endif
#ifndef RES_SP2
#define RES_SP2 true
#endif
#ifndef RES_ALIGN
#define RES_ALIGN true
#endif
#ifndef REP_UP
#define REP_UP 1
#endif
#ifndef REP_ABIN
#define REP_ABIN 1
#endif
#ifndef REP_CDIN
#define REP_CDIN 1
#endif
#ifndef REP_AG
#define REP_AG 1
#endif
#ifndef REP_NA
#define REP_NA 1
#endif
#ifndef REP_CDC
#define REP_CDC 1
#endif
#ifndef REP_PRO
#define REP_PRO 1
#endif
#define XB_TMO      128
#define XB_XCNT(j)  (256  + 64 * (j))
#define XB_XSUB(j)  (1280 + 64 * (j))
#define XB_XGEN(j)  (2304 + 64 * (j))
#define XB_TOP      3328
#define XB_TOPGEN   3392
#define XCD_BAR_WORDS 3456
#define XB_SPIN_CAP (1u << 18)

__device__ __forceinline__ unsigned xb_ld(unsigned* p)              { return __hip_atomic_load(p, __ATOMIC_RELAXED, __HIP_MEMORY_SCOPE_AGENT); }
__device__ __forceinline__ unsigned xb_add(unsigned* p, unsigned v) { return __hip_atomic_fetch_add(p, v, __ATOMIC_RELAXED, __HIP_MEMORY_SCOPE_AGENT); }
__device__ __forceinline__ unsigned xb_xcc_id() { return (unsigned)__builtin_amdgcn_s_getreg((3 << 11) | 20) & 0xFu; }
#define XB_SPIN(cond, bar) do { unsigned _sp = 0; while (cond) { __builtin_amdgcn_s_sleep(1); \
    if ((++_sp & 255u) == 0u) { if (xb_ld(&(bar)[XB_TMO])) break; if (_sp > XB_SPIN_CAP) { atomicAdd(&(bar)[XB_TMO], 1u); break; } } } } while (0)

struct XcdBarrier {
    unsigned* bar; unsigned x;
    volatile LAS unsigned* st;
};

__device__ __forceinline__ XcdBarrier xcd_barrier_post(unsigned* bar, volatile LAS unsigned* st) {
    XcdBarrier b; b.bar = bar; b.x = xb_xcc_id(); b.st = st;
    if (threadIdx.x == 0) (void)xb_add(&bar[XB_XCNT(b.x)], 1u);
    return b;
}
__device__ __forceinline__ void xcd_barrier_complete(unsigned* bar, unsigned x, unsigned& nloc, unsigned& nx) {
    const unsigned G = gridDim.x * gridDim.y * gridDim.z;
    unsigned sum, cnt, mine, sp = 0u;
    for (;;) {
        sum = 0u; cnt = 0u; mine = 0u;
#pragma unroll
        for (unsigned j = 0; j < 16; ++j) { const unsigned c = xb_ld(&bar[XB_XCNT(j)]); sum += c; cnt += (c > 0u) ? 1u : 0u; mine = (j == x) ? c : mine; }
        if (sum == G) break;
        __builtin_amdgcn_s_sleep(1);
        if ((++sp & 255u) == 0u) { if (xb_ld(&bar[XB_TMO])) break; if (sp > XB_SPIN_CAP) { atomicAdd(&bar[XB_TMO], 1u); break; } }
    }
    nloc = mine > 0u ? mine : 1u; nx = cnt > 0u ? cnt : 1u;
}

__device__ __forceinline__ void xcd_barrier(const XcdBarrier& b) {
    asm volatile("s_waitcnt vmcnt(0)" ::: "memory");
    __syncthreads();
    if (threadIdx.x == 0) {
        unsigned* bar = b.bar;
        __builtin_amdgcn_s_waitcnt(0);
        unsigned nloc = b.st[0], nx = b.st[1];
        if (nloc == 0u) { xcd_barrier_complete(bar, b.x, nloc, nx); b.st[0] = nloc; b.st[1] = nx; }
        const unsigned old = xb_add(&bar[XB_XSUB(b.x)], 1u);
        const unsigned gen = old / nloc;
        if (old + 1u == (gen + 1u) * nloc) {
            __builtin_amdgcn_fence(__ATOMIC_RELEASE, "agent");
            asm volatile("s_waitcnt vmcnt(0)" ::: "memory");
            const unsigned og = xb_add(&bar[XB_TOP], 1u);
            const unsigned tg = og / nx;
            if (og + 1u == (tg + 1u) * nx) xb_add(&bar[XB_TOPGEN], 1u);
            else XB_SPIN(xb_ld(&bar[XB_TOPGEN]) == tg, bar);
            __builtin_amdgcn_fence(__ATOMIC_ACQUIRE, "agent");
            xb_add(&bar[XB_XGEN(b.x)], 1u);
            asm volatile("s_waitcnt vmcnt(0)" ::: "memory");
        } else {
            XB_SPIN(xb_ld(&bar[XB_XGEN(b.x)]) == gen, bar);
            __builtin_amdgcn_fence(__ATOMIC_ACQUIRE, "agent");
            asm volatile("s_waitcnt vmcnt(0)" ::: "memory");
        }
    }
    __syncthreads();
}

constexpr int LDS_BYTES = 163840;
static_assert(NA_END <= LDS_BYTES - 64, "NA tiles vs LDS");
__global__ void __launch_bounds__(512, 2) mega_fwd(Params p) {
    extern __shared__ __attribute__((aligned(16))) unsigned char lds_raw[];
    LAS unsigned char* lds = (LAS unsigned char*)lds_raw;
    cg::grid_group grid = cg::this_grid();
    const int G = gridDim.x, bx = blockIdx.x;
    const int wave_s = __builtin_amdgcn_readfirstlane((int)threadIdx.x >> 6);
    const int vcu = (G % 8 == 0) ? (bx % 8) * (G / 8) + bx / 8 : bx;
    const int NGW = G * 8;
    unsigned char* ws = p.ws;
    ss_t* ss = (ss_t*)(ws + WS_SS);
    bf16_t* xb = (bf16_t*)(ws + WS_XB); bf16_t* yb = (bf16_t*)(ws + WS_Y); bf16_t* act = (bf16_t*)(ws + WS_ACT);
    const float* rope = (const float*)(ws + WS_ROPE);
    volatile LAS unsigned* bst = (volatile LAS unsigned*)(lds + LDS_BYTES - 64);
    if (threadIdx.x < 2) bst[threadIdx.x] = 0u;
    __syncthreads();
    XcdBarrier xbar = xcd_barrier_post((unsigned*)(ws + WS_BAR), bst);
    int ph = 0;
#define PHASE_BEGIN if (ph >= p.ph_lo && ph < p.ph_hi) {
#define PHASE_END   if (ph + 1 < p.ph_hi) { if (p.ph_lo < 0) { asm volatile("s_waitcnt vmcnt(0)" ::: "memory"); grid.sync(); __builtin_amdgcn_fence(__ATOMIC_ACQUIRE, "agent"); asm volatile("s_waitcnt vmcnt(0)" ::: "memory"); } else xcd_barrier(xbar); } } ++ph;

    PHASE_BEGIN
#ifndef NO_PRO
    for (int rep = 0; rep < REP_PRO; ++rep)
    prologue_phase(p, lds, vcu, NGW, wave_s);
#endif
    PHASE_END

    for (int l = 0; l < 4; ++l) {
        for (int half = 0; half < 2; ++half) {
            const int f = 2 * l + half;
            const ss_t* ssin = ss + (size_t)(3 * l + 2 * half) * NTOK * 16;
            ss_t* ssmid = ss + (size_t)(3 * l + 2 * half + 1) * NTOK * 16;
            PHASE_BEGIN {
                pg8::Gemm g{xb, (const bf16_t*)(ws + WS_WGU + f * SZ_GU), NTOK, NGU, DM}; pg8::StaticOrder S; S.init(NTOK, NGU, G, bx);
                fill_rstd_table(lds, ssin, bx, wave_s);
                EpiUp E{act, (const LAS float*)(lds + RS_OFF)};

#ifndef NO_UP
                for (int rep = 0; rep < REP_UP; ++rep)
                pg8::gemm_phase<EpiUp, pg8::StaticOrder, true, GEMM_SP2>(lds, g, S, E, wave_s);
#endif

            } PHASE_END
            PHASE_BEGIN {
                pg8::Gemm g{act, (const bf16_t*)(ws + WS_WDN + f * SZ_DN), NTOK, DM, DFF}; RevOrder S; S.S.init(NTOK, DM, G, bx); S.n = (NTOK / 256) * (DM / 256) / G;
#ifdef REP_DNULL
                { EpiNull EN{(float*)(ws + WS_ROPE)}; pg8::gemm_phase<EpiNull, pg8::StaticOrder, true, true>(lds, g, S, EN, wave_s); }
#endif
                EpiRes E{xb, ssmid, 0.5f};

#ifndef NO_RES
                pg8::gemm_phase<EpiRes, RevOrder, RES_ALIGN, RES_SP2>(lds, g, S, E, wave_s);
#endif

            } PHASE_END
#ifdef SKIP_MIX
            if (false) {
#else
            if (half == 0) {
#endif
                const int e = l >> 1;
                const ss_t* ssmix = ssmid;
                ss_t* ssout = ss + (size_t)(3 * l + 2) * NTOK * 16;
                if ((l & 1) == 0) {
                    PHASE_BEGIN {
                        pg8::Gemm g{xb, (const bf16_t*)(ws + WS_WABIN + e * SZ_ABIN), NTOK, ABIN, DM}; pg8::StaticOrder S; S.init(NTOK, ABIN, G, bx);
                        fill_rstd_table(lds, ssmix, bx, wave_s);
                        EpiAB E{(const LAS float*)(lds + RS_OFF), p.in[I_QN] + e * 64, p.in[I_KN] + e * 64, rope, act};

#ifndef NO_AB
                for (int rep = 0; rep < REP_ABIN; ++rep)
                pg8::gemm_phase<EpiAB, pg8::StaticOrder, true, GEMM_SP2>(lds, g, S, E, wave_s);
#endif

                    } PHASE_END
                    PHASE_BEGIN {

#ifndef NO_AG
                        for (int rep = 0; rep < REP_AG; ++rep)
                        attn_global_phase(lds, act + U_QA, act + U_KA, act + U_VTA, p.in[I_QN] + e * 64, p.in[I_KN] + e * 64, yb, vcu, G, wave_s);
#endif
#ifndef NO_NA
                        for (int rep = 0; rep < REP_NA; ++rep)
                        attn_na_phase(lds, act + U_QB, act + U_KB, act + U_VTB, p.in[I_RPB] + (size_t)e * 8 * 465, yb, vcu, G, wave_s);
#endif

                    } PHASE_END
                } else {
                    PHASE_BEGIN {
                        pg8::Gemm g{xb, (const bf16_t*)(ws + WS_WCDIN + e * SZ_CDIN), NTOK, CDIN, DM}; pg8::StaticOrder S; S.init(NTOK, CDIN, G, bx);
                        fill_rstd_table(lds, ssmix, bx, wave_s);
                        EpiCD E{(const LAS float*)(lds + RS_OFF), act};

#ifndef NO_CDG
                for (int rep = 0; rep < REP_CDIN; ++rep)
                pg8::gemm_phase<EpiCD, pg8::StaticOrder, true, GEMM_SP2>(lds, g, S, E, wave_s);
#endif

                    } PHASE_END
                    PHASE_BEGIN {

#ifndef NO_CD
                        for (int rep = 0; rep < REP_CDC; ++rep)
                        cd_core_phase(lds, act + U_E, act + U_P, act + U_BC, p.in[I_CCW] + (size_t)e * 3 * 512, p.in[I_DCW] + (size_t)e * 31 * 512,
                                      p.in[I_DNG] + e * 512, p.in[I_DNB] + e * 512, yb, vcu, G, wave_s);
#endif

                    } PHASE_END
                }
                PHASE_BEGIN {
                    const size_t woff = (l & 1) ? (WS_WCDOUT + e * SZ_SQ) : (WS_WABOUT + e * SZ_SQ);
                    pg8::Gemm g{yb, (const bf16_t*)(ws + woff), NTOK, DM, DM}; RevOrder S; S.S.init(NTOK, DM, G, bx); S.n = (NTOK / 256) * (DM / 256) / G;
#ifdef REP_OUTFAKE
                    { EpiRes EF{xb, ss + (size_t)13 * NTOK * 16, 1.0f}; pg8::gemm_phase<EpiRes, RevOrder, true, true>(lds, g, S, EF, wave_s); }
#endif
                    EpiRes E{xb, ssout, 1.0f};

#ifndef NO_RES
                pg8::gemm_phase<EpiRes, RevOrder, RES_ALIGN, RES_SP2>(lds, g, S, E, wave_s);
#endif

                } PHASE_END
            }
        }
    }
#ifdef REP_SYNC
    for (int rep = 0; rep < REP_SYNC; ++rep) xcd_barrier(xbar);
#endif
    PHASE_BEGIN final_phase(p.out, xb, ss + (size_t)12 * NTOK * 16, p.in[I_FINAL], vcu, NGW, wave_s); PHASE_END
#undef PHASE_BEGIN
#undef PHASE_END
}

extern "C" void kernel_launch(void* const* d_in, const int* in_sizes, int n_in, void* d_out, int out_size, void* d_ws, size_t ws_size, hipStream_t stream) {
    static int grid = 0;
    if (grid == 0) {
        if (n_in != 18 || in_sizes[0] != NTOK * DM || out_size != NTOK * DM || ws_size < WS_END) {
            fprintf(stderr, "kernel_launch: unexpected shapes (n_in %d, in0 %d, out %d, ws %zu); nothing launched\n", n_in, n_in > 0 ? in_sizes[0] : -1, out_size, ws_size); grid = -1; return; }
        int dev = 0, cus = 0, per_cu = 0;
        hipGetDevice(&dev);
        hipDeviceGetAttribute(&cus, hipDeviceAttributeMultiprocessorCount, dev);
        hipFuncSetAttribute((const void*)mega_fwd, hipFuncAttributeMaxDynamicSharedMemorySize, LDS_BYTES);
        hipOccupancyMaxActiveBlocksPerMultiprocessor(&per_cu, (const void*)mega_fwd, 512, LDS_BYTES);
        if (per_cu < 1) per_cu = 1;
        grid = cus * (per_cu > 1 ? 1 : per_cu);
        if (grid != 256) { fprintf(stderr, "kernel_launch: built for a 256-CU device (got %d workgroups); nothing launched\n", grid); grid = -1; return; }
        (void)hipGetLastError();
    }
    if (grid < 0) return;
    Params p{};
    for (int i = 0; i < 18; ++i) p.in[i] = (const float*)d_in[i];
    p.out = (float*)d_out; p.ws = (unsigned char*)d_ws; p.ph_lo = 0; p.ph_hi = 1000;
    if (hipMemsetAsync((char*)d_ws + WS_BAR, 0, 16384, stream) != hipSuccess) { fprintf(stderr, "kernel_launch: memset of the barrier words failed\n"); return; }
    void* args[] = {&p};
    hipError_t e = hipLaunchCooperativeKernel((const void*)mega_fwd, dim3(grid), dim3(512), args, LDS_BYTES, stream);
    if (e != hipSuccess) fprintf(stderr, "cooperative launch failed: %s (grid %d)\n", hipGetErrorString(e), grid);
}
```
